# Optimizing an MI355X kernel written in HIP

```python
import math
import jax
import jax.numpy as jnp
from jax import lax
import numpy as np

D_MODEL = 1024
BATCH = 8
SEQ = 4096
DEPTH = 2

MIX = D_MODEL
GROUP = MIX // 4
FOX_HEADS = 4
FOX_HD = GROUP // FOX_HEADS
HG_HEADS = 4
HG_DK = 128
HG_DV = GROUP // HG_HEADS
HG_CHUNK = 64
DIFF_HEADS = 4
DIFF_DV = GROUP // DIFF_HEADS
DIFF_D = DIFF_DV // 2
S5_CH = 16
S5_GROUPS = GROUP // S5_CH
S5_N = 64
ROPE_THETA = 500000.0
ROPE_FRACTION = 4
Q_BLOCK = 128
N_EXPERTS = 32
TOP_K = 4
D_FF = D_MODEL
SWIGLU_LIMIT = 7.0
SWIGLU_ALPHA = 1.702
EPS = 1e-6
COL_SIZES = (GROUP, GROUP, GROUP, FOX_HEADS,
             HG_HEADS * HG_DK, HG_HEADS * HG_DK, GROUP, GROUP,
             GROUP, GROUP, GROUP,
             GROUP)
IN_COLS = sum(COL_SIZES)

kernel_name = 'hybrid_fox_hgrn2_diff_s5_moe'


def rmsnorm(x, g):
    xf = x.astype(jnp.float32)
    y = xf * lax.rsqrt(jnp.mean(xf * xf, axis=-1, keepdims=True) + EPS)
    return (y * g.astype(jnp.float32)).astype(x.dtype)


def split_cols(p):
    offs = np.cumsum((0,) + COL_SIZES)
    return [p[..., int(offs[i]):int(offs[i + 1])] for i in range(len(COL_SIZES))]


def partial_rope(x, pos):
    dh = x.shape[-1]
    rd = dh // ROPE_FRACTION
    half = rd // 2
    inv = ROPE_THETA ** (-jnp.arange(half, dtype=jnp.float32) / half)
    ang = pos.astype(jnp.float32)[..., None] * inv
    cos = jnp.cos(ang)[:, :, None, :]
    sin = jnp.sin(ang)[:, :, None, :]
    xr = x[..., :rd].astype(jnp.float32)
    x1, x2 = xr[..., :half], xr[..., half:]
    rot = jnp.concatenate([x1 * cos - x2 * sin, x2 * cos + x1 * sin], axis=-1)
    return jnp.concatenate([rot.astype(x.dtype), x[..., rd:]], axis=-1)


def forgetting_attention(q, k, v, logf):
    B, S, H, Dh = q.shape
    nb = S // Q_BLOCK
    cum = jnp.cumsum(logf.astype(jnp.float32), axis=1).transpose(0, 2, 1)
    scale = Dh ** -0.5
    kpos = jnp.arange(S)
    qb = q.reshape(B, nb, Q_BLOCK, H, Dh).transpose(1, 0, 2, 3, 4)
    cb = cum.reshape(B, H, nb, Q_BLOCK).transpose(2, 0, 1, 3)

    def block(args):
        i, qi, ci = args
        s = jnp.einsum('bqhd,bkhd->bhqk', qi, k).astype(jnp.float32) * scale
        s = s + ci[..., :, None] - cum[:, :, None, :]
        qpos = i * Q_BLOCK + jnp.arange(Q_BLOCK)
        s = jnp.where(kpos[None, :] <= qpos[:, None], s, -jnp.inf)
        p = jax.nn.softmax(s, axis=-1).astype(v.dtype)
        return jnp.einsum('bhqk,bkhd->bqhd', p, v)

    out = lax.map(block, (jnp.arange(nb), qb, cb))
    return out.transpose(1, 0, 2, 3, 4).reshape(B, S, H, Dh)


def differential_attention(q1, q2, k1, k2, v, lam):
    B, S, H, d = q1.shape
    nb = S // Q_BLOCK
    scale = d ** -0.5
    kpos = jnp.arange(S)
    q1b = q1.reshape(B, nb, Q_BLOCK, H, d).transpose(1, 0, 2, 3, 4)
    q2b = q2.reshape(B, nb, Q_BLOCK, H, d).transpose(1, 0, 2, 3, 4)

    def block(args):
        i, a1, a2 = args
        qpos = i * Q_BLOCK + jnp.arange(Q_BLOCK)
        mask = kpos[None, :] <= qpos[:, None]
        s1 = jnp.einsum('bqhd,bkhd->bhqk', a1, k1).astype(jnp.float32) * scale
        s2 = jnp.einsum('bqhd,bkhd->bhqk', a2, k2).astype(jnp.float32) * scale
        p = (jax.nn.softmax(jnp.where(mask, s1, -jnp.inf), axis=-1)
             - lam * jax.nn.softmax(jnp.where(mask, s2, -jnp.inf), axis=-1))
        return jnp.einsum('bhqk,bkhd->bqhd', p.astype(v.dtype), v)

    out = lax.map(block, (jnp.arange(nb), q1b, q2b))
    return out.transpose(1, 0, 2, 3, 4).reshape(B, S, H, v.shape[-1])


def hgrn2_recurrence(q, logf, k, v):
    B, S, H, K = q.shape
    V = v.shape[-1]
    C = HG_CHUNK
    nc = S // C

    def to_chunks(a):
        return a.reshape(B, nc, C, H, a.shape[-1]).transpose(1, 0, 3, 2, 4)

    causal = jnp.tril(jnp.ones((C, C), dtype=bool))[:, :, None]

    def step(state, inp):
        qi, gi, ki, vi = inp
        G = jnp.cumsum(gi, axis=2)
        diff = G[:, :, :, None, :] - G[:, :, None, :, :]
        decay = jnp.exp(jnp.where(causal, diff, -jnp.inf))
        A = jnp.einsum('bhtk,bhsk,bhtsk->bhts', qi, ki, decay)
        o = (jnp.einsum('bhts,bhsv->bhtv', A, vi)
             + jnp.einsum('bhtk,bhkv->bhtv', qi * jnp.exp(G), state))
        g_last = G[:, :, -1]
        kdec = ki * jnp.exp(g_last[:, :, None, :] - G)
        new_state = jnp.exp(g_last)[..., None] * state + jnp.einsum('bhsk,bhsv->bhkv', kdec, vi)
        return new_state, o

    s0 = jnp.zeros((B, H, K, V), jnp.float32)
    _, o = lax.scan(step, s0, (to_chunks(q), to_chunks(logf), to_chunks(k), to_chunks(v)))
    return o.transpose(1, 0, 3, 2, 4).reshape(B, S, H, V)


def s5_ssm(u, a_re, a_im, log_step, b_re, b_im, c_re, c_im, d_skip):
    uf = u.astype(jnp.float32)
    lr = jnp.minimum(a_re.astype(jnp.float32), -1e-4)
    li = a_im.astype(jnp.float32)
    dt = jnp.exp(log_step.astype(jnp.float32))[:, None]
    mag = jnp.exp(lr * dt)
    ar = mag * jnp.cos(li * dt)
    ai = mag * jnp.sin(li * dt)
    den = lr * lr + li * li
    zr = ((ar - 1.0) * lr + ai * li) / den
    zi = (ai * lr - (ar - 1.0) * li) / den
    br = b_re.astype(jnp.float32)
    bi = b_im.astype(jnp.float32)
    bbr = zr[..., None] * br - zi[..., None] * bi
    bbi = zr[..., None] * bi + zi[..., None] * br
    bur = jnp.einsum('bsgh,gnh->bsgn', uf, bbr)
    bui = jnp.einsum('bsgh,gnh->bsgn', uf, bbi)
    arr = jnp.broadcast_to(ar, bur.shape)
    aii = jnp.broadcast_to(ai, bur.shape)

    def combine(e1, e2):
        a1r, a1i, b1r, b1i = e1
        a2r, a2i, b2r, b2i = e2
        return (a2r * a1r - a2i * a1i,
                a2r * a1i + a2i * a1r,
                a2r * b1r - a2i * b1i + b2r,
                a2r * b1i + a2i * b1r + b2i)

    _, _, xr, xi = lax.associative_scan(combine, (arr, aii, bur, bui), axis=1)
    y = (jnp.einsum('bsgn,ghn->bsgh', xr, c_re.astype(jnp.float32))
         - jnp.einsum('bsgn,ghn->bsgh', xi, c_im.astype(jnp.float32))
         + d_skip.astype(jnp.float32) * uf)
    return y


def token_mixer(h, pos, layer, lb, w_in, w_out, fox_fb, hg_norm_g, lam_q1, lam_k1, lam_q2, lam_k2,
                diff_subln_g, a_re, a_im, log_step, b_re, b_im, c_re, c_im, d_skip, glu_w):
    B, S, _ = h.shape
    fq, fk, fv, ff, hq, hf, hi, hg, dq, dk, dv, su = split_cols(h @ w_in)
    fox_logf = jax.nn.log_sigmoid((ff + fox_fb).astype(jnp.float32))
    y_fox = forgetting_attention(fq.reshape(B, S, FOX_HEADS, FOX_HD),
                                 fk.reshape(B, S, FOX_HEADS, FOX_HD),
                                 fv.reshape(B, S, FOX_HEADS, FOX_HD), fox_logf)
    y_fox = y_fox.reshape(B, S, GROUP).astype(jnp.float32)
    lbh = lb.reshape(HG_HEADS, HG_DK)
    f = lbh + (1.0 - lbh) * jax.nn.sigmoid(hf.reshape(B, S, HG_HEADS, HG_DK).astype(jnp.float32))
    y_hg = hgrn2_recurrence(jax.nn.silu(hq.reshape(B, S, HG_HEADS, HG_DK).astype(jnp.float32)),
                            jnp.log(f), 1.0 - f,
                            hi.reshape(B, S, HG_HEADS, HG_DV).astype(jnp.float32))
    y_hg = rmsnorm(y_hg, hg_norm_g).reshape(B, S, GROUP) * jax.nn.silu(hg.astype(jnp.float32))
    q = partial_rope(dq.reshape(B, S, 2 * DIFF_HEADS, DIFF_D), pos).reshape(B, S, DIFF_HEADS, 2, DIFF_D)
    k = partial_rope(dk.reshape(B, S, 2 * DIFF_HEADS, DIFF_D), pos).reshape(B, S, DIFF_HEADS, 2, DIFF_D)
    lam_init = 0.8 - 0.6 * math.exp(-0.3 * layer)
    lam = (jnp.exp(jnp.sum(lam_q1.astype(jnp.float32) * lam_k1.astype(jnp.float32)))
           - jnp.exp(jnp.sum(lam_q2.astype(jnp.float32) * lam_k2.astype(jnp.float32))) + lam_init)
    y_diff = differential_attention(q[..., 0, :], q[..., 1, :], k[..., 0, :], k[..., 1, :],
                                    dv.reshape(B, S, DIFF_HEADS, DIFF_DV), lam)
    y_diff = (rmsnorm(y_diff.astype(jnp.float32), diff_subln_g) * (1.0 - lam_init)).reshape(B, S, GROUP)
    y_s5 = s5_ssm(su.reshape(B, S, S5_GROUPS, S5_CH), a_re, a_im, log_step, b_re, b_im, c_re, c_im, d_skip)
    z = jax.nn.gelu(y_s5.reshape(B, S, GROUP)).astype(h.dtype) @ glu_w
    y_s5 = (z[..., :GROUP] * jax.nn.sigmoid(z[..., GROUP:])).astype(jnp.float32)
    y = jnp.concatenate([y_fox, y_hg, y_diff, y_s5], axis=-1).astype(h.dtype)
    return y @ w_out


def moe_ffn(h, router_w, router_b, w1, b1, w2, b2):
    B, S, D = h.shape
    t = h.reshape(B * S, D)
    logits = (t @ router_w + router_b).astype(jnp.float32)
    vals, idx = lax.top_k(logits, TOP_K)
    wts = jax.nn.softmax(vals, axis=-1)
    gates = jnp.einsum('tk,tke->te', wts, jax.nn.one_hot(idx, N_EXPERTS, dtype=jnp.float32))
    out = jnp.zeros((B * S, D), jnp.float32)
    for e in range(N_EXPERTS):
        hh = t @ w1[e] + b1[e]
        glu = jnp.minimum(hh[..., ::2], SWIGLU_LIMIT)
        lin = jnp.clip(hh[..., 1::2], -SWIGLU_LIMIT, SWIGLU_LIMIT)
        act = glu * jax.nn.sigmoid(SWIGLU_ALPHA * glu) * (lin + 1.0)
        out = out + gates[:, e:e + 1] * (act @ w2[e] + b2[e]).astype(jnp.float32)
    return out.astype(h.dtype).reshape(B, S, D)


def setup_inputs(seed: int = 0) -> dict:
    key = jax.random.key(seed)
    ks = iter(jax.random.split(key, 48))
    f32 = jnp.float32

    def nrm(shape, s):
        return s * jax.random.normal(next(ks), shape, f32)

    x = nrm((BATCH, SEQ, D_MODEL), 1.0)
    c = nrm((BATCH, D_MODEL), 1.0)
    positions = (jax.random.randint(next(ks), (BATCH, 1), 0, SEQ, dtype=jnp.int32)
                 + jnp.arange(SEQ, dtype=jnp.int32)[None, :])
    return {
        'x': x,
        'c': c,
        'positions': positions,
        'ada_w': nrm((DEPTH, D_MODEL, 6 * D_MODEL), 0.5 * D_MODEL ** -0.5),
        'ada_b': nrm((DEPTH, 6 * D_MODEL), 0.02),
        'pre_norm_g': 1.0 + nrm((DEPTH, 2, D_MODEL), 0.02),
        'post_norm_g': 1.0 + nrm((DEPTH, 2, D_MODEL), 0.02),
        'w_in': nrm((DEPTH, D_MODEL, IN_COLS), D_MODEL ** -0.5),
        'w_out': nrm((DEPTH, MIX, D_MODEL), MIX ** -0.5),
        'fox_fb': 2.0 + nrm((DEPTH, FOX_HEADS), 0.1),
        'hg_lower': nrm((DEPTH, HG_HEADS * HG_DK), 0.1),
        'hg_norm_g': 1.0 + nrm((DEPTH, HG_DV), 0.02),
        'diff_lam_q1': nrm((DEPTH, DIFF_D), 0.1),
        'diff_lam_k1': nrm((DEPTH, DIFF_D), 0.1),
        'diff_lam_q2': nrm((DEPTH, DIFF_D), 0.1),
        'diff_lam_k2': nrm((DEPTH, DIFF_D), 0.1),
        'diff_subln_g': 1.0 + nrm((DEPTH, DIFF_DV), 0.02),
        's5_a_re': -0.5 + nrm((DEPTH, S5_GROUPS, S5_N), 0.01),
        's5_a_im': math.pi * jnp.arange(S5_N, dtype=f32) + nrm((DEPTH, S5_GROUPS, S5_N), 0.01),
        's5_log_step': jax.random.uniform(next(ks), (DEPTH, S5_GROUPS), f32,
                                          math.log(1e-3), math.log(1e-1)),
        's5_b_re': nrm((DEPTH, S5_GROUPS, S5_N, S5_CH), (2 * S5_CH) ** -0.5),
        's5_b_im': nrm((DEPTH, S5_GROUPS, S5_N, S5_CH), (2 * S5_CH) ** -0.5),
        's5_c_re': nrm((DEPTH, S5_GROUPS, S5_CH, S5_N), S5_N ** -0.5),
        's5_c_im': nrm((DEPTH, S5_GROUPS, S5_CH, S5_N), S5_N ** -0.5),
        's5_d': nrm((DEPTH, S5_GROUPS, S5_CH), 1.0),
        's5_glu_w': nrm((DEPTH, GROUP, 2 * GROUP), GROUP ** -0.5),
        'router_w': nrm((DEPTH, D_MODEL, N_EXPERTS), D_MODEL ** -0.5),
        'router_b': nrm((DEPTH, N_EXPERTS), 0.01),
        'exp_w1': nrm((DEPTH, N_EXPERTS, D_MODEL, 2 * D_FF), D_MODEL ** -0.5),
        'exp_b1': nrm((DEPTH, N_EXPERTS, 2 * D_FF), 0.01),
        'exp_w2': nrm((DEPTH, N_EXPERTS, D_FF, D_MODEL), D_FF ** -0.5),
        'exp_b2': nrm((DEPTH, N_EXPERTS, D_MODEL), 0.01),
    }


def reference(x, c, positions, ada_w, ada_b, pre_norm_g, post_norm_g, w_in, w_out, fox_fb, hg_lower,
              hg_norm_g, diff_lam_q1, diff_lam_k1, diff_lam_q2, diff_lam_k2, diff_subln_g, s5_a_re,
              s5_a_im, s5_log_step, s5_b_re, s5_b_im, s5_c_re, s5_c_im, s5_d, s5_glu_w, router_w,
              router_b, exp_w1, exp_b1, exp_w2, exp_b2):
    lb_all = jnp.cumsum(jax.nn.softmax(hg_lower.astype(jnp.float32), axis=0), axis=0)
    lb_all = lb_all - lb_all[0:1]
    cs = jax.nn.silu(c)
    for l in range(DEPTH):
        mod = cs @ ada_w[l] + ada_b[l]
        sh1, sc1, g1, sh2, sc2, g2 = jnp.split(mod, 6, axis=-1)
        h = rmsnorm(x, pre_norm_g[l, 0]) * (1.0 + sc1[:, None, :]) + sh1[:, None, :]
        y = token_mixer(h, positions, l, lb_all[l], w_in[l], w_out[l], fox_fb[l], hg_norm_g[l],
                        diff_lam_q1[l], diff_lam_k1[l], diff_lam_q2[l], diff_lam_k2[l], diff_subln_g[l],
                        s5_a_re[l], s5_a_im[l], s5_log_step[l], s5_b_re[l], s5_b_im[l], s5_c_re[l],
                        s5_c_im[l], s5_d[l], s5_glu_w[l])
        x = x + g1[:, None, :] * rmsnorm(y, post_norm_g[l, 0])
        h = rmsnorm(x, pre_norm_g[l, 1]) * (1.0 + sc2[:, None, :]) + sh2[:, None, :]
        y = moe_ffn(h, router_w[l], router_b[l], exp_w1[l], exp_b1[l], exp_w2[l], exp_b2[l])
        x = x + g2[:, None, :] * rmsnorm(y, post_norm_g[l, 1])
    return x
```

```cpp
#include <hip/hip_runtime.h>
#include <cstdio>
#include <cstdint>
#include <cmath>

#ifndef MK_ONE_LAUNCH
#define MK_ONE_LAUNCH 1
#endif

#define GAS __attribute__((address_space(1)))
#define LAS __attribute__((address_space(3)))
typedef unsigned short bf16;
typedef short bf16x8 __attribute__((ext_vector_type(8)));
typedef short s16x4 __attribute__((ext_vector_type(4)));
typedef float f32x2 __attribute__((ext_vector_type(2)));
typedef float f32x4 __attribute__((ext_vector_type(4)));
typedef float f32x16 __attribute__((ext_vector_type(16)));
typedef unsigned u32x2 __attribute__((ext_vector_type(2)));
typedef unsigned u32x4 __attribute__((ext_vector_type(4)));

constexpr int NB = 8, SEQ = 4096, DM = 1024, NT = NB * SEQ, DEPTH = 2;
constexpr int NPROJ = 3328, INCOLS = 3332;
constexpr int C_FQ = 0, C_FK = 256, C_FV = 512, C_HQ = 768, C_HF = 1280, C_HI = 1792, C_HG = 2048, C_DQ = 2304, C_DK = 2560, C_DV = 2816, C_SU = 3072;
constexpr int NEXP = 32, TOPK = 4;
constexpr float EPS = 1e-6f;
constexpr float LOG2E = 1.4426950408889634f;
constexpr int NWAVES = 8, NTHR = 512;
constexpr int S5L = 32, S5ROWS = NT / S5L;
constexpr int HGC = 64, HGUNITS = NB * 4 * (SEQ / HGC);

constexpr size_t MiB = 1u << 20;
constexpr size_t WS_CTL = 0, CTL_BYTES = 1 * MiB;
constexpr size_t WS_WIN = 2 * MiB;
constexpr size_t WS_WOUT = 16 * MiB;
constexpr size_t WS_GLU = 20 * MiB;
constexpr size_t WS_MOD = 21 * MiB;
constexpr size_t WS_KTAU = 22 * MiB;
constexpr size_t WS_LOGF = 23 * MiB;
constexpr size_t WS_FBIAS = 24 * MiB;
constexpr size_t WS_HDEC = 25 * MiB;
constexpr size_t WS_TOKPOS = 26 * MiB;
constexpr size_t WS_XIN = 27 * MiB;
constexpr size_t WS_XLOC = 32 * MiB;
constexpr size_t WS_LISTS = 40 * MiB;
constexpr size_t WS_WSLOT = 44 * MiB;
constexpr size_t WS_S5E = 48 * MiB;
constexpr size_t WS_S5F = 56 * MiB;
constexpr size_t WS_S5M = 64 * MiB;
constexpr size_t WS_YGELU = 96 * MiB;
constexpr size_t WS_H = 112 * MiB;
constexpr size_t WS_YCAT = 176 * MiB;
constexpr size_t WS_Y2 = 240 * MiB;
constexpr size_t WS_HST = 304 * MiB;
constexpr size_t WS_PROJ = 368 * MiB;
constexpr size_t WS_W1T = 576 * MiB;
constexpr size_t WS_W2T = 832 * MiB;
constexpr size_t WS_ACT = 960 * MiB;
constexpr size_t WS_YK = 1220 * MiB;
constexpr size_t WS_X1 = 1480 * MiB;
constexpr size_t WS_X2 = 1544 * MiB;
constexpr size_t WS_HST2 = 1608 * MiB;
constexpr size_t WS_H8 = 1672 * MiB;
constexpr size_t WS_KTAU4 = 1704 * MiB;
constexpr size_t WS_END = 1708 * MiB;
constexpr int CW_CNT_DUMMY = 1024;
constexpr int CW_BAR = 4096;
constexpr int CW_QKN = 768;
constexpr int CW_HGQ = 640;
constexpr int CW_CNT = 256;

constexpr int LDS_RING = 131072;
constexpr int LDSCTL_OFF = 139264;
constexpr int LDS_BYTES = 163840;
constexpr int LDS_STASH = LDSCTL_OFF + 4096;

__device__ __forceinline__ unsigned f2bf(float f) { unsigned u = __builtin_bit_cast(unsigned, f); return (u + 0x7fffu + ((u >> 16) & 1u)) >> 16; }
__device__ __forceinline__ unsigned pk2(float lo, float hi) { unsigned r; asm("v_cvt_pk_bf16_f32 %0, %1, %2" : "=v"(r) : "v"(lo), "v"(hi)); return r; }
__device__ __forceinline__ float bflo(unsigned w) { return __builtin_bit_cast(float, w << 16); }
__device__ __forceinline__ float bfhi(unsigned w) { return __builtin_bit_cast(float, w & 0xffff0000u); }
__device__ __forceinline__ float bf2f(bf16 v) { return __builtin_bit_cast(float, (unsigned)v << 16); }
#define DPP_F(old, v, ctrl, rm) __builtin_bit_cast(float, __builtin_amdgcn_update_dpp(__builtin_bit_cast(int, (float)(old)), __builtin_bit_cast(int, (float)(v)), (ctrl), (rm), 0xf, false))
__device__ __forceinline__ float wave_sum(float v) {
    v += DPP_F(0.f, v, 0xB1, 0xf);
    v += DPP_F(0.f, v, 0x4E, 0xf);
    v += DPP_F(0.f, v, 0x141, 0xf);
    v += DPP_F(0.f, v, 0x140, 0xf);
    v += DPP_F(0.f, v, 0x142, 0xa);
    v += DPP_F(0.f, v, 0x143, 0xc);
    return __builtin_bit_cast(float, __builtin_amdgcn_readlane(__builtin_bit_cast(int, v), 63));
}
__device__ __forceinline__ float wave_max(float v) {
    v = fmaxf(v, DPP_F(v, v, 0xB1, 0xf));
    v = fmaxf(v, DPP_F(v, v, 0x4E, 0xf));
    v = fmaxf(v, DPP_F(v, v, 0x141, 0xf));
    v = fmaxf(v, DPP_F(v, v, 0x140, 0xf));
    v = fmaxf(v, DPP_F(v, v, 0x142, 0xa));
    v = fmaxf(v, DPP_F(v, v, 0x143, 0xc));
    return __builtin_bit_cast(float, __builtin_amdgcn_readlane(__builtin_bit_cast(int, v), 63));
}
__device__ __forceinline__ float sigmoidf_(float x) { return __builtin_amdgcn_rcpf(1.0f + __expf(-x)); }
__device__ __forceinline__ float siluf_(float x) { return x * __builtin_amdgcn_rcpf(1.0f + __expf(-x)); }
__device__ __forceinline__ float gelu_tanh(float x) { const float u = 0.7978845608028654f * (x + 0.044715f * x * x * x); return x * __builtin_amdgcn_rcpf(1.0f + __expf(-2.0f * u)); }
__device__ __forceinline__ float clamp448(float x) { return __builtin_amdgcn_fmed3f(x, -448.0f, 448.0f); }
__device__ __forceinline__ unsigned pk4_fp8_nc(float a, float b, float c, float d) {
    int w = 0; w = __builtin_amdgcn_cvt_pk_fp8_f32(a, b, w, false); w = __builtin_amdgcn_cvt_pk_fp8_f32(c, d, w, true); return (unsigned)w; }
__device__ __forceinline__ unsigned pk4_fp8(float a, float b, float c, float d) {
    int w = 0; w = __builtin_amdgcn_cvt_pk_fp8_f32(clamp448(a), clamp448(b), w, false); w = __builtin_amdgcn_cvt_pk_fp8_f32(clamp448(c), clamp448(d), w, true); return (unsigned)w; }
constexpr float F8_SW = 256.0f, F8_SH = 16.0f, F8_SA = 4.0f, F8_SY = 64.0f;
#define LDS_WAIT() asm volatile("s_waitcnt lgkmcnt(0)" ::: "memory")
#define VM_WAIT() asm volatile("s_waitcnt vmcnt(0)" ::: "memory")

#define XB_TMO      128
#define XB_XCNT(j)  (256  + 64 * (j))
#define XB_XSUB(j)  (1280 + 64 * (j))
#define XB_XGEN(j)  (2304 + 64 * (j))
#define XB_TOP      3328
#define XB_TOPGEN   3392
#define XCD_BAR_WORDS 3456
#define XB_SPIN_CAP (1u << 18)
__device__ __forceinline__ unsigned xb_ld(unsigned* p)              { return __hip_atomic_load(p, __ATOMIC_RELAXED, __HIP_MEMORY_SCOPE_AGENT); }
__device__ __forceinline__ unsigned xb_add(unsigned* p, unsigned v) { return __hip_atomic_fetch_add(p, v, __ATOMIC_RELAXED, __HIP_MEMORY_SCOPE_AGENT); }
__device__ __forceinline__ unsigned xb_xcc_id() { return (unsigned)__builtin_amdgcn_s_getreg((3 << 11) | 20) & 0xFu; }
#define XB_SPIN(cond, bar) do { unsigned _sp = 0; while (cond) { __builtin_amdgcn_s_sleep(1); \
    if ((++_sp & 255u) == 0u) { if (xb_ld(&(bar)[XB_TMO])) break; if (_sp > XB_SPIN_CAP) { atomicAdd(&(bar)[XB_TMO], 1u); break; } } } } while (0)
struct XcdBarrier { unsigned* bar; unsigned x; volatile LAS unsigned* st; };
__device__ __forceinline__ XcdBarrier xcd_barrier_post(unsigned* bar, volatile LAS unsigned* st) {
    XcdBarrier b; b.bar = bar; b.x = xb_xcc_id(); b.st = st;
    if (threadIdx.x == 0) (void)xb_add(&bar[XB_XCNT(b.x)], 1u);
    return b;
}
__device__ __forceinline__ void xcd_barrier_complete(unsigned* bar, unsigned x, unsigned& nloc, unsigned& nx) {
    const unsigned G = gridDim.x * gridDim.y * gridDim.z;
    unsigned sum, cnt, mine, sp = 0u;
    for (;;) {
        sum = 0u; cnt = 0u; mine = 0u;
#pragma unroll
        for (unsigned j = 0; j < 16; ++j) { const unsigned c = xb_ld(&bar[XB_XCNT(j)]); sum += c; cnt += (c > 0u) ? 1u : 0u; mine = (j == x) ? c : mine; }
        if (sum == G) break;
        __builtin_amdgcn_s_sleep(1);
        if ((++sp & 255u) == 0u) { if (xb_ld(&bar[XB_TMO])) break; if (sp > XB_SPIN_CAP) { atomicAdd(&bar[XB_TMO], 1u); break; } }
    }
    nloc = mine > 0u ? mine : 1u; nx = cnt > 0u ? cnt : 1u;
}
__device__ __forceinline__ void xcd_barrier(const XcdBarrier& b) {
    asm volatile("s_waitcnt vmcnt(0)" ::: "memory");
    __syncthreads();
    if (threadIdx.x == 0) {
        unsigned* bar = b.bar;
        __builtin_amdgcn_s_waitcnt(0);
        unsigned nloc = b.st[0], nx = b.st[1];
        if (nloc == 0u) { xcd_barrier_complete(bar, b.x, nloc, nx); b.st[0] = nloc; b.st[1] = nx; }
        const unsigned old = xb_add(&bar[XB_XSUB(b.x)], 1u);
        const unsigned gen = old / nloc;
        if (old + 1u == (gen + 1u) * nloc) {
            __builtin_amdgcn_fence(__ATOMIC_RELEASE, "agent");
            asm volatile("s_waitcnt vmcnt(0)" ::: "memory");
            const unsigned og = xb_add(&bar[XB_TOP], 1u);
            const unsigned tg = og / nx;
            if (og + 1u == (tg + 1u) * nx) xb_add(&bar[XB_TOPGEN], 1u);
            else XB_SPIN(xb_ld(&bar[XB_TOPGEN]) == tg, bar);
            __builtin_amdgcn_fence(__ATOMIC_ACQUIRE, "agent");
            xb_add(&bar[XB_XGEN(b.x)], 1u);
            asm volatile("s_waitcnt vmcnt(0)" ::: "memory");
        } else {
            XB_SPIN(xb_ld(&bar[XB_XGEN(b.x)]) == gen, bar);
            __builtin_amdgcn_fence(__ATOMIC_ACQUIRE, "agent");
            asm volatile("s_waitcnt vmcnt(0)" ::: "memory");
        }
    }
    __syncthreads();
}

struct Args { const void* in[32]; float* out; unsigned char* ws; int ph_lo, ph_hi, pad0, pad1; };
struct Frame {
    LAS unsigned char* lds; volatile LAS unsigned* CTL; unsigned* ctl;
    int tid, lane, wave, vcu, G;
    unsigned char* ws;
};

__device__ __forceinline__ const void* karg(int k) { asm volatile("" : "+s"(k)); typedef const void* cvp_t; return ((const __attribute__((address_space(4))) cvp_t*)__builtin_amdgcn_kernarg_segment_ptr())[k]; }
#define REFRESH() do { F.ws = (unsigned char*)karg(33); int t_ = threadIdx.x; asm volatile("" : "+v"(t_)); F.tid = t_; F.lane = t_ & 63; F.wave = __builtin_amdgcn_readfirstlane(t_ >> 6); F.ctl = (unsigned*)(F.ws + WS_CTL); } while (0)

namespace gk {
constexpr int BM = 256, BK = 64, HALF = 128, HTB = HALF * BK * 2, STAGE_BYTES = 8 * HTB;
__host__ __device__ __forceinline__ int lds_byte(int r, int c) { const int st = (r >> 4) * 2 + (c >> 5), rr = r & 15, cc = c & 31, ob = rr * 64 + cc * 2; return st * 1024 + (ob ^ (((ob >> 9) & 1) << 5)); }
__host__ __device__ __forceinline__ void stage_rc(int b, int& R, int& C) { const int st = b / 1024, sb = b % 1024, swz = sb ^ (((sb >> 9) & 1) << 5); R = (st >> 1) * 16 + swz / 64; C = (st & 1) * 32 + (swz % 64) / 2; }
__host__ __device__ __forceinline__ int perm32(int rho) { const int n = rho >> 4, i = rho & 15; return 8 * (i >> 2) + 4 * n + (i & 3); }
struct Unit { int pm, pn, e, rows, nt, epi, rt, kind; };
typedef f32x4 Acc[2][2][4][2];
__device__ __forceinline__ unsigned cvt_pk_bf16(float lo, float hi) { unsigned r; asm volatile("v_cvt_pk_bf16_f32 %0, %1, %2" : "=v"(r) : "v"(lo), "v"(hi)); return r; }

template <int OFF> __device__ __forceinline__ void dma16(const char* sbase, unsigned voff, unsigned ldsbase) {
    asm volatile("s_add_u32 m0, %2, %3\n\ts_nop 0\n\tglobal_load_lds_dwordx4 %0, %1" :: "v"(voff), "s"(sbase), "s"(ldsbase), "i"(OFF) : "memory", "scc", "m0"); }
__device__ __forceinline__ void stage_coords(int tid, int i, int& R, int& C, int& Rb) { int t2 = tid; asm volatile("" : "+v"(t2)); stage_rc(t2 * 16 + i * 8192, R, C); Rb = (R & ~31) + perm32(R & 31); }
typedef int v4i_t __attribute__((ext_vector_type(4)));
typedef int v8i_t __attribute__((ext_vector_type(8)));
__device__ __forceinline__ v8i_t cat8(bf16x8 lo, bf16x8 hi) { const v4i_t a = __builtin_bit_cast(v4i_t, lo), b = __builtin_bit_cast(v4i_t, hi); return __builtin_shufflevector(a, b, 0, 1, 2, 3, 4, 5, 6, 7); }
template <class P, bool F8 = false>
__device__ __forceinline__ void run(LAS unsigned char* lds, const P& pr, const int xmode = 0) {
    int tid_ = threadIdx.x; asm volatile("" : "+v"(tid_));
    const int tid = tid_, wid = __builtin_amdgcn_readfirstlane(tid >> 6), lane = tid & 63, wr = wid >> 2, wc = wid & 3, fr = lane & 15, fq = lane >> 4;
    const unsigned ldsbw = (unsigned)(uintptr_t)lds + (unsigned)wid * 1024u;
    volatile LAS unsigned* stash = (volatile LAS unsigned*)(lds + LDS_STASH) + tid;
    const int aoff = lds_byte(wr * 64 + fr, fq * 8), boff = lds_byte(wc * 32 + fr, fq * 8);
#define GK_SA(b, h) (((b) * 2 + (h)) * HTB)
#define GK_SB(b, h) ((4 + (b) * 2 + (h)) * HTB)
#define GK_STAGE(bufoff, gbase, v0, v1) do { if (xmode != 3) { dma16<(bufoff)>((const char*)(gbase), (v0), ldsbw); dma16<(bufoff) + 8192>((const char*)(gbase), (v1), ldsbw); } } while (0)
#define GK_LDA(dst, b, h) do { if constexpr (F8) { _Pragma("unroll") for (int m = 0; m < 4; ++m) dst##8[m] = cat8(*(const LAS bf16x8*)(lds + GK_SA(b, h) + aoff + m * 2048), *(const LAS bf16x8*)(lds + GK_SA(b, h) + aoff + m * 2048 + 1024)); } \
        else { _Pragma("unroll") for (int m = 0; m < 4; ++m) _Pragma("unroll") for (int k = 0; k < 2; ++k) dst[m][k] = *(const LAS bf16x8*)(lds + GK_SA(b, h) + aoff + m * 2048 + k * 1024); } } while (0)
#define GK_LDB(dst, b, h) do { if constexpr (F8) { _Pragma("unroll") for (int n = 0; n < 2; ++n) dst##8[n] = cat8(*(const LAS bf16x8*)(lds + GK_SB(b, h) + boff + n * 2048), *(const LAS bf16x8*)(lds + GK_SB(b, h) + boff + n * 2048 + 1024)); } \
        else { _Pragma("unroll") for (int n = 0; n < 2; ++n) _Pragma("unroll") for (int k = 0; k < 2; ++k) dst[n][k] = *(const LAS bf16x8*)(lds + GK_SB(b, h) + boff + n * 2048 + k * 1024); } } while (0)
#define GK_MMA(ai, bj, At, Bt) do { if (xmode == 2) break; __builtin_amdgcn_s_setprio(1); \
        if constexpr (F8) { _Pragma("unroll") for (int m = 0; m < 4; ++m) _Pragma("unroll") for (int n = 0; n < 2; ++n) \
            asm volatile("v_mfma_f32_16x16x128_f8f6f4 %0, %1, %2, %0" : "+v"(acc[ai][bj][m][n]) : "v"(Bt##8[n]), "v"(At##8[m])); } \
        else { _Pragma("unroll") for (int m = 0; m < 4; ++m) _Pragma("unroll") for (int n = 0; n < 2; ++n) _Pragma("unroll") for (int k = 0; k < 2; ++k) \
            acc[ai][bj][m][n] = __builtin_amdgcn_mfma_f32_16x16x32_bf16(Bt[n][k], At[m][k], acc[ai][bj][m][n], 0, 0, 0); } \
        __builtin_amdgcn_s_setprio(0); } while (0)
#define GK_WAIT_V(n) asm volatile("s_waitcnt vmcnt(" #n ")" ::: "memory")
#define GK_WAIT_L(n) asm volatile("s_waitcnt lgkmcnt(" #n ")" ::: "memory")
#define GK_BAR __builtin_amdgcn_s_barrier()
#define GK_SCHED __builtin_amdgcn_sched_barrier(0)
#define GK_ZERO() do { _Pragma("unroll") for (int a = 0; a < 2; ++a) _Pragma("unroll") for (int b = 0; b < 2; ++b) _Pragma("unroll") for (int m = 0; m < 4; ++m) _Pragma("unroll") for (int n = 0; n < 2; ++n) acc[a][b][m][n] = (f32x4){0.f, 0.f, 0.f, 0.f}; } while (0)
    Unit cur, nxt; int ui = 0;
    if (!pr.next(0, cur)) return;
    Acc acc; GK_ZERO();
    bf16x8 At[4][2], B0[2][2], B1[2][2]; v8i_t At8[4], B08[2], B18[2];
    (void)At; (void)B0; (void)B1; (void)At8; (void)B08; (void)B18;
    const char *cA, *cB; unsigned cvA[2][2], cvB[2]; unsigned ckA, ckB, chB;
    pr.setupA(cur, tid, cA, cvA, ckA); pr.setupB(cur, tid, cB, cvB, ckB, chB);
    GK_STAGE(GK_SB(0, 0), cB, cvB[0], cvB[1]); GK_STAGE(GK_SB(0, 1), cB + chB, cvB[0], cvB[1]); GK_STAGE(GK_SA(0, 0), cA, cvA[0][0], cvA[0][1]); GK_STAGE(GK_SA(0, 1), cA, cvA[1][0], cvA[1][1]);
    if (wr == 1) GK_BAR;
    GK_WAIT_V(2); GK_BAR;
    GK_STAGE(GK_SB(1, 0), cB + ckB, cvB[0], cvB[1]); GK_STAGE(GK_SA(1, 0), cA + ckA, cvA[0][0], cvA[0][1]); GK_STAGE(GK_SB(1, 1), cB + chB + ckB, cvB[0], cvB[1]);
    GK_WAIT_V(6); GK_BAR;
    for (;;) {
        const bool has_next = pr.next(ui + 1, nxt);
        const char *nA = cA, *nB = cB; unsigned nkA = ckA, nkB = ckB, nhB = chB;
        {
            unsigned nvA[2][2] = {{cvA[0][0], cvA[0][1]}, {cvA[1][0], cvA[1][1]}}, nvB[2] = {cvB[0], cvB[1]};
            if (has_next) { pr.setupA(nxt, tid, nA, nvA, nkA); pr.setupB(nxt, tid, nB, nvB, nkB, nhB); }
            stash[0] = nvA[0][0]; stash[512] = nvA[0][1]; stash[1024] = nvA[1][0]; stash[1536] = nvA[1][1]; stash[2048] = nvB[0]; stash[2560] = nvB[1];
        }
        const int nt = cur.nt;
        for (int t = 0; t < nt; t += 2) {
            const bool last = (t == nt - 2);
            const char* a1 = cA + (size_t)((unsigned)(t + 1) * ckA);
            const char* a2 = last ? nA : cA + (size_t)((unsigned)(t + 2) * ckA); const char* b2 = last ? nB : cB + (size_t)((unsigned)(t + 2) * ckB);
            const unsigned k2A = last ? nkA : ckA, k2B = last ? nkB : ckB, h2B = last ? nhB : chB;
            const char* a3 = a2 + k2A; const char* b3 = b2 + k2B;
            unsigned wA00 = cvA[0][0], wA01 = cvA[0][1], wA10 = cvA[1][0], wA11 = cvA[1][1], wB0 = cvB[0], wB1 = cvB[1];
            if (last) { wA00 = stash[0]; wA01 = stash[512]; wA10 = stash[1024]; wA11 = stash[1536]; wB0 = stash[2048]; wB1 = stash[2560]; }
            GK_LDB(B0, 0, 0); GK_LDB(B1, 0, 1); GK_SCHED; GK_LDA(At, 0, 0); GK_STAGE(GK_SA(1, 1), a1, cvA[1][0], cvA[1][1]);
            GK_WAIT_V(8); GK_WAIT_L(0); GK_BAR; GK_MMA(0, 0, At, B0); GK_MMA(0, 1, At, B1); GK_BAR; GK_SCHED;
            GK_LDA(At, 0, 1); GK_STAGE(GK_SB(0, 0), b2, wB0, wB1); GK_STAGE(GK_SB(0, 1), b2 + h2B, wB0, wB1); GK_STAGE(GK_SA(0, 0), a2, wA00, wA01);
            GK_WAIT_V(8); GK_WAIT_L(0); GK_BAR; GK_MMA(1, 0, At, B0); GK_MMA(1, 1, At, B1); GK_BAR; GK_SCHED;
            GK_LDB(B0, 1, 0); GK_LDB(B1, 1, 1); GK_SCHED; GK_LDA(At, 1, 0); GK_STAGE(GK_SA(0, 1), a2, wA10, wA11);
            GK_WAIT_V(8); GK_WAIT_L(0); GK_BAR; GK_MMA(0, 0, At, B0); GK_MMA(0, 1, At, B1); GK_BAR; GK_SCHED;
            GK_LDA(At, 1, 1); GK_STAGE(GK_SB(1, 0), b3, wB0, wB1); GK_STAGE(GK_SB(1, 1), b3 + h2B, wB0, wB1); GK_STAGE(GK_SA(1, 0), a3, wA00, wA01);
            GK_WAIT_V(8); GK_WAIT_L(0); GK_BAR; GK_MMA(1, 0, At, B0); GK_MMA(1, 1, At, B1); GK_BAR; GK_SCHED;
        }
        if constexpr (F8) asm volatile("s_nop 15\n\ts_nop 15" ::: "memory");
        if (cur.epi) { if (wr == 0) GK_BAR; if (xmode != 1) pr.epi(acc, cur, wr, wc, fr, fq); }
        if (!has_next) break;
        if (cur.epi) GK_ZERO();
        const int had_epi = cur.epi;
        cur = nxt; cA = nA; cB = nB; ckA = nkA; ckB = nkB; chB = nhB;
        cvA[0][0] = stash[0]; cvA[0][1] = stash[512]; cvA[1][0] = stash[1024]; cvA[1][1] = stash[1536]; cvB[0] = stash[2048]; cvB[1] = stash[2560];
        ++ui;
        if (had_epi) { if (wr == 1) GK_BAR; }
    }
    GK_WAIT_V(0);
    if (!cur.epi) { if (wr == 0) GK_BAR; }
    GK_BAR;
}
}

__device__ __forceinline__ bool reg_order(int i, int G, int c, int nM, int nN, int& pm, int& pn) {
    const long L = (long)i * G + c; if (L >= (long)nM * nN) return false;
    const int nig = 8 * nN, gid = (int)(L / nig), r = (int)(L % nig); pm = gid * 8 + (r % 8); pn = r / 8; return true;
}
struct RegAB {
    const bf16* A; const bf16* Bt; int pitchA, pitchB;
    __device__ __forceinline__ void setupA(const gk::Unit& u, int tid, const char*& base, unsigned (&vo)[2][2], unsigned& kstep) const {
        base = (const char*)A + (size_t)u.pm * 256 * pitchA * 2; kstep = 128;
#pragma unroll
        for (int h = 0; h < 2; ++h)
#pragma unroll
            for (int i = 0; i < 2; ++i) { int R_, C_, Rb_; gk::stage_coords(tid, i, R_, C_, Rb_); (void)R_; (void)Rb_; vo[h][i] = (unsigned)((h * 128 + R_) * pitchA + C_) * 2u; }
    }
    __device__ __forceinline__ void setupB(const gk::Unit& u, int tid, const char*& base, unsigned (&vo)[2], unsigned& kstep, unsigned& hstep) const {
        base = (const char*)Bt + (size_t)u.pn * 256 * pitchB * 2; kstep = 128; hstep = 128u * pitchB * 2u;
#pragma unroll
        for (int i = 0; i < 2; ++i) { int R_, C_, Rb_; gk::stage_coords(tid, i, R_, C_, Rb_); (void)R_; (void)Rb_; vo[i] = (unsigned)(Rb_ * pitchB + C_) * 2u; }
    }
};

struct ProjProb {
    const unsigned char* A; const unsigned char* Bt; bf16* O; const int* pos; int G, c;
    __device__ __forceinline__ bool next(int i, gk::Unit& u) const { int n8 = 8; asm volatile("" : "+s"(n8)); u.nt = n8; u.epi = 1; u.e = 0; u.rows = 256; u.rt = 0; u.kind = 0; return reg_order(i, G, c, NT / 256, NPROJ / 256, u.pm, u.pn); }
    __device__ __forceinline__ void setupA(const gk::Unit& u, int tid, const char*& base, unsigned (&vo)[2][2], unsigned& kstep) const {
        base = (const char*)A + (size_t)u.pm * 256 * DM; kstep = 128;
#pragma unroll
        for (int h = 0; h < 2; ++h)
#pragma unroll
            for (int i = 0; i < 2; ++i) { int R_, C_, Rb_; gk::stage_coords(tid, i, R_, C_, Rb_); (void)Rb_; vo[h][i] = (unsigned)((h * 128 + R_) * DM + C_ * 2); }
    }
    __device__ __forceinline__ void setupB(const gk::Unit& u, int tid, const char*& base, unsigned (&vo)[2], unsigned& kstep, unsigned& hstep) const {
        base = (const char*)Bt + (size_t)u.pn * 256 * DM; kstep = 128; hstep = 128u * DM;
#pragma unroll
        for (int i = 0; i < 2; ++i) { int R_, C_, Rb_; gk::stage_coords(tid, i, R_, C_, Rb_); (void)R_; vo[i] = (unsigned)(Rb_ * DM + C_ * 2); }
    }
    __device__ __forceinline__ void epi(const gk::Acc& acc, const gk::Unit& u, int wr, int wc, int fr, int fq) const {
        int row0 = u.pm * 256 + wr * 64 + fr, col0 = u.pn * 256 + wc * 32 + 8 * fq; asm volatile("" : "+v"(row0), "+v"(col0));
        const bool rope = (u.pn == 9 || u.pn == 10) && (fq == 0);
        const float sc = ((u.pn == 0) ? 0.125f * LOG2E : ((u.pn == 9) ? 0.17677669529663687f * LOG2E : 1.0f)) * (1.0f / (F8_SW * F8_SH));
#pragma unroll
        for (int ai = 0; ai < 2; ++ai)
#pragma unroll
            for (int m = 0; m < 4; ++m) {
                const int row = row0 + ai * 128 + m * 16;
                float cs[4], sn[4];
                if (u.pn == 9 || u.pn == 10) {
                    const float p = (float)pos[row];
#pragma unroll
                    for (int j = 0; j < 4; ++j) { const float inv = (j == 0) ? 1.0f : (j == 1 ? 0.03760603093086394f : (j == 2 ? 0.0014142135623730951f : 5.318295896944989e-05f)); sincosf(p * inv, &sn[j], &cs[j]); }
                }
                bf16* rowp = O + (size_t)row * NPROJ + col0;
#pragma unroll
                for (int bj = 0; bj < 2; ++bj) {
                    f32x4 v0 = acc[ai][bj][m][0], v1 = acc[ai][bj][m][1];
                    if (rope) {
#pragma unroll
                        for (int j = 0; j < 4; ++j) { const float x1 = v0[j], x2 = v1[j]; v0[j] = x1 * cs[j] - x2 * sn[j]; v1[j] = x2 * cs[j] + x1 * sn[j]; }
                    }
                    v0 = v0 * sc; v1 = v1 * sc;
                    u32x4 w; w.x = gk::cvt_pk_bf16(v0[0], v0[1]); w.y = gk::cvt_pk_bf16(v0[2], v0[3]); w.z = gk::cvt_pk_bf16(v1[0], v1[1]); w.w = gk::cvt_pk_bf16(v1[2], v1[3]);
                    *(u32x4*)(rowp + bj * 128) = w;
                }
            }
    }
};
struct PlainProb : RegAB {
    bf16* O; int ldc, nM, nN, G, c;
    __device__ __forceinline__ bool next(int i, gk::Unit& u) const { u.nt = pitchA / 64; u.epi = 1; u.e = 0; u.rows = 256; u.rt = 0; u.kind = 0; return reg_order(i, G, c, nM, nN, u.pm, u.pn); }
    __device__ __forceinline__ void epi(const gk::Acc& acc, const gk::Unit& u, int wr, int wc, int fr, int fq) const {
        int row0 = u.pm * 256 + wr * 64 + fr, col0 = u.pn * 256 + wc * 32 + 8 * fq; asm volatile("" : "+v"(row0), "+v"(col0));
#pragma unroll
        for (int ai = 0; ai < 2; ++ai)
#pragma unroll
            for (int m = 0; m < 4; ++m) {
                bf16* rowp = O + (size_t)(row0 + ai * 128 + m * 16) * ldc + col0;
#pragma unroll
                for (int bj = 0; bj < 2; ++bj) {
                    const f32x4 v0 = acc[ai][bj][m][0], v1 = acc[ai][bj][m][1];
                    u32x4 w; w.x = gk::cvt_pk_bf16(v0[0], v0[1]); w.y = gk::cvt_pk_bf16(v0[2], v0[3]); w.z = gk::cvt_pk_bf16(v1[0], v1[1]); w.w = gk::cvt_pk_bf16(v1[2], v1[3]);
                    *(u32x4*)(rowp + bj * 128) = w;
                }
            }
    }
};
struct GluProb : RegAB {
    bf16* O; int G, c;
    __device__ __forceinline__ bool next(int i, gk::Unit& u) const { int n4 = 4; asm volatile("" : "+s"(n4)); u.nt = n4; u.epi = 1; u.e = 0; u.rows = 256; u.rt = 0; u.kind = 0; return reg_order(i, G, c, NT / 256, 2, u.pm, u.pn); }
    __device__ __forceinline__ void epi(const gk::Acc& acc, const gk::Unit& u, int wr, int wc, int fr, int fq) const {
        int row0 = u.pm * 256 + wr * 64 + fr, col0 = u.pn * 256 + wc * 32 + 8 * fq; asm volatile("" : "+v"(row0), "+v"(col0));
#pragma unroll
        for (int ai = 0; ai < 2; ++ai)
#pragma unroll
            for (int m = 0; m < 4; ++m) {
                bf16* rowp = O + (size_t)(row0 + ai * 128 + m * 16) * DM + 768 + (col0 >> 1);
#pragma unroll
                for (int bj = 0; bj < 2; ++bj) {
                    const f32x4 v0 = acc[ai][bj][m][0], v1 = acc[ai][bj][m][1];
                    u32x2 w; w.x = pk2(v0[0] * sigmoidf_(v0[1]), v0[2] * sigmoidf_(v0[3])); w.y = pk2(v1[0] * sigmoidf_(v1[1]), v1[2] * sigmoidf_(v1[3]));
                    *(u32x2*)(rowp + bj * 64) = w;
                }
                __builtin_amdgcn_sched_barrier(0);
            }
    }
};
__device__ __forceinline__ void s5_setupA(const bf16* proj, int pair, int pm, int tid, const char*& base, unsigned (&vo)[2][2], unsigned& kstep) {
    base = (const char*)proj + ((size_t)pm * 256 * S5L * NPROJ + C_SU + pair * 32) * 2; kstep = 2u * NPROJ * 2u;
#pragma unroll
    for (int h = 0; h < 2; ++h)
#pragma unroll
        for (int i = 0; i < 2; ++i) { int R_, C_, Rb_; gk::stage_coords(tid, i, R_, C_, Rb_); (void)R_; (void)Rb_; vo[h][i] = (unsigned)(((h * 128 + R_) * S5L + (C_ >> 5)) * NPROJ + (C_ & 31)) * 2u; }
}
struct S5EProb {
    const bf16* proj; const bf16* Ebt; float* xloc; int G, c;
    __device__ __forceinline__ bool next(int i, gk::Unit& u) const { const int L = i * G + c; if (L >= 32) return false; u.e = L >> 2; u.pm = L & 3; u.pn = 0; u.nt = 16; u.epi = 1; u.rows = 256; u.rt = 0; u.kind = 0; return true; }
    __device__ __forceinline__ void setupA(const gk::Unit& u, int tid, const char*& base, unsigned (&vo)[2][2], unsigned& kstep) const { s5_setupA(proj, u.e, u.pm, tid, base, vo, kstep); }
    __device__ __forceinline__ void setupB(const gk::Unit& u, int tid, const char*& base, unsigned (&vo)[2], unsigned& kstep, unsigned& hstep) const {
        base = (const char*)Ebt + (size_t)u.e * 256 * 1024 * 2; kstep = 128; hstep = 128u * 1024u * 2u;
#pragma unroll
        for (int i = 0; i < 2; ++i) { int R_, C_, Rb_; gk::stage_coords(tid, i, R_, C_, Rb_); (void)R_; (void)Rb_; vo[i] = (unsigned)(Rb_ * 1024 + C_) * 2u; }
    }
    __device__ __forceinline__ void epi(const gk::Acc& acc, const gk::Unit& u, int wr, int wc, int fr, int fq) const {
        int row0 = u.pm * 256 + wr * 64 + fr, col0 = wc * 32 + 8 * fq; asm volatile("" : "+v"(row0), "+v"(col0));
#pragma unroll
        for (int ai = 0; ai < 2; ++ai)
#pragma unroll
            for (int m = 0; m < 4; ++m) {
                float* rowp = xloc + (size_t)(row0 + ai * 128 + m * 16) * 2048 + u.e * 256 + col0;
#pragma unroll
                for (int bj = 0; bj < 2; ++bj) { *(f32x4*)(rowp + bj * 128) = acc[ai][bj][m][0]; *(f32x4*)(rowp + bj * 128 + 4) = acc[ai][bj][m][1]; }
            }
    }
};
struct S5FMProb {
    const bf16* proj; const bf16* xin; const bf16* Fbt; const bf16* Mbt; bf16* ygelu; int G, c;
    __device__ __forceinline__ bool next(int i, gk::Unit& u) const {
        const int L = (i >> 1) * G + c; if (L >= 128) return false;
        u.e = L >> 4; u.pm = (L >> 2) & 3; u.pn = L & 3; u.kind = i & 1; u.epi = u.kind; u.nt = u.kind ? 4 * (u.pn + 1) : 4; u.rows = 256; u.rt = 0; return true;
    }
    __device__ __forceinline__ void setupA(const gk::Unit& u, int tid, const char*& base, unsigned (&vo)[2][2], unsigned& kstep) const {
        if (u.kind) { s5_setupA(proj, u.e, u.pm, tid, base, vo, kstep); }
        else { base = (const char*)xin + ((size_t)u.pm * 256 * 2048 + u.e * 256) * 2; kstep = 128;
#pragma unroll
            for (int h = 0; h < 2; ++h)
#pragma unroll
                for (int i = 0; i < 2; ++i) { int R_, C_, Rb_; gk::stage_coords(tid, i, R_, C_, Rb_); (void)R_; (void)Rb_; vo[h][i] = (unsigned)((h * 128 + R_) * 2048 + C_) * 2u; } }
    }
    __device__ __forceinline__ void setupB(const gk::Unit& u, int tid, const char*& base, unsigned (&vo)[2], unsigned& kstep, unsigned& hstep) const {
        const int pitch = u.kind ? 1024 : 256;
        base = (const char*)(u.kind ? Mbt : Fbt) + ((size_t)u.e * 1024 + u.pn * 256) * pitch * 2; kstep = 128; hstep = 128u * pitch * 2u;
#pragma unroll
        for (int i = 0; i < 2; ++i) { int R_, C_, Rb_; gk::stage_coords(tid, i, R_, C_, Rb_); (void)R_; (void)Rb_; vo[i] = (unsigned)(Rb_ * pitch + C_) * 2u; }
    }
    __device__ __forceinline__ void epi(const gk::Acc& acc, const gk::Unit& u, int wr, int wc, int fr, int fq) const {
        int row0 = u.pm * 256 + wr * 64 + fr; asm volatile("" : "+v"(row0));
#pragma unroll
        for (int bj = 0; bj < 2; ++bj) {
            const int ncol = u.pn * 256 + bj * 128 + wc * 32 + 8 * fq, t = ncol >> 5, c32 = ncol & 31;
#pragma unroll
            for (int ai = 0; ai < 2; ++ai)
#pragma unroll
                for (int m = 0; m < 4; ++m) {
                    const int row = row0 + ai * 128 + m * 16;
                    const f32x4 v0 = acc[ai][bj][m][0], v1 = acc[ai][bj][m][1];
                    u32x4 w; w.x = pk2(gelu_tanh(v0[0]), gelu_tanh(v0[1])); w.y = pk2(gelu_tanh(v0[2]), gelu_tanh(v0[3])); w.z = pk2(gelu_tanh(v1[0]), gelu_tanh(v1[1])); w.w = pk2(gelu_tanh(v1[2]), gelu_tanh(v1[3]));
                    *(u32x4*)(ygelu + ((size_t)row * S5L + t) * 256 + u.e * 32 + c32) = w;
                    __builtin_amdgcn_sched_barrier(0);
                }
        }
    }
};
__device__ __forceinline__ void moe_tables(Frame& F, const unsigned* cnt) {
    if (F.wave == 0) {
        const int c = (F.lane < 32) ? (int)__hip_atomic_load(cnt + F.lane, __ATOMIC_RELAXED, __HIP_MEMORY_SCOPE_AGENT) : 0;
        const int tl = (c + 255) >> 8;
        int ps = c, pt = tl;
#pragma unroll
        for (int o = 1; o < 32; o <<= 1) { const int a = __shfl_up(ps, o), b = __shfl_up(pt, o); if (F.lane >= o) { ps += a; pt += b; } }
        if (F.lane < 32) { F.CTL[16 + F.lane + 1] = (unsigned)pt; F.CTL[64 + F.lane + 1] = (unsigned)ps; F.CTL[128 + F.lane] = (unsigned)c; }
        if (F.lane == 0) { F.CTL[16] = 0u; F.CTL[64] = 0u; }
    }
    __syncthreads();
}
__device__ __forceinline__ bool moe_next(volatile LAS unsigned* CTL, int i, int G, int c, int nct, gk::Unit& u) {
    const int L = i * G + c, tl = L / nct; u.pn = L % nct;
    if (tl >= (int)CTL[16 + 32]) return false;
    int e = 0;
    while ((int)CTL[16 + e + 1] <= tl) ++e;
    u.e = e; u.rt = tl - (int)CTL[16 + e]; u.rows = (int)CTL[128 + e] - 256 * u.rt; if (u.rows > 256) u.rows = 256;
    u.pm = (int)CTL[64 + e] + 256 * u.rt;
    u.nt = 16; u.epi = 1; u.kind = 0; return true;
}
struct Moe1Prob {
    const unsigned char* h8; const unsigned char* w1t; const float* b1; const int* lists; unsigned char* act; volatile LAS unsigned* CTL; int G, c;
    __device__ __forceinline__ bool next(int i, gk::Unit& u) const { const bool ok = moe_next(CTL, i, G, c, 8, u); int n8 = 8; asm volatile("" : "+s"(n8)); u.nt = n8; return ok; }
    __device__ __forceinline__ void setupA(const gk::Unit& u, int tid, const char*& base, unsigned (&vo)[2][2], unsigned& kstep) const {
        base = (const char*)h8; kstep = 128;
        const int* li = lists + (size_t)u.e * NT + 256 * u.rt;
#pragma unroll
        for (int h = 0; h < 2; ++h)
#pragma unroll
            for (int i = 0; i < 2; ++i) { int R_, C_, Rb_; gk::stage_coords(tid, i, R_, C_, Rb_); (void)Rb_; const int r = h * 128 + R_; const int tk = li[r < u.rows ? r : 0]; vo[h][i] = (unsigned)((tk >> 2) * DM + C_ * 2); }
    }
    __device__ __forceinline__ void setupB(const gk::Unit& u, int tid, const char*& base, unsigned (&vo)[2], unsigned& kstep, unsigned& hstep) const {
        base = (const char*)w1t + ((size_t)u.e * 2048 + u.pn * 256) * 1024; kstep = 128; hstep = 128u * 1024u;
#pragma unroll
        for (int i = 0; i < 2; ++i) { int R_, C_, Rb_; gk::stage_coords(tid, i, R_, C_, Rb_); (void)R_; vo[i] = (unsigned)(Rb_ * 1024 + C_ * 2); }
    }
    __device__ __forceinline__ void epi(const gk::Acc& acc, const gk::Unit& u, int wr, int wc, int fr, int fq) const {
        int r0 = wr * 64 + fr, col0 = u.pn * 256 + wc * 32 + 8 * fq; asm volatile("" : "+v"(r0), "+v"(col0));
        constexpr float US = 1.0f / (F8_SW * F8_SH);
        f32x4 bv[2][2];
#pragma unroll
        for (int bj = 0; bj < 2; ++bj)
#pragma unroll
            for (int n = 0; n < 2; ++n) bv[bj][n] = *(const f32x4*)(b1 + (size_t)u.e * 2048 + col0 + bj * 128 + 4 * n);
#pragma unroll
        for (int ai = 0; ai < 2; ++ai)
#pragma unroll
            for (int m = 0; m < 4; ++m) {
                const int r = r0 + ai * 128 + m * 16;
                if (r < u.rows) {
                    unsigned char* rowp = act + (size_t)(u.pm + r) * DM + (col0 >> 1);
#pragma unroll
                    for (int bj = 0; bj < 2; ++bj) {
                        const f32x4 v0 = acc[ai][bj][m][0] * US + bv[bj][0], v1 = acc[ai][bj][m][1] * US + bv[bj][1];
                        float o[4];
#pragma unroll
                        for (int j = 0; j < 4; ++j) { const float gl = fminf(j < 2 ? v0[2 * j] : v1[2 * j - 4], 7.0f); float ln = j < 2 ? v0[2 * j + 1] : v1[2 * j - 3]; ln = fminf(fmaxf(ln, -7.0f), 7.0f);
                            o[j] = gl * __builtin_amdgcn_rcpf(1.0f + __expf(-1.702f * gl)) * (ln + 1.0f) * F8_SA; }
                        *(unsigned*)(rowp + bj * 64) = pk4_fp8_nc(o[0], o[1], o[2], o[3]);
                    }
                }
            }
    }
};
struct Moe2Prob {
    const unsigned char* act; const unsigned char* w2t; const float* b2; const float* wslot; unsigned char* yk; volatile LAS unsigned* CTL; int G, c;
    __device__ __forceinline__ bool next(int i, gk::Unit& u) const { const bool ok = moe_next(CTL, i, G, c, 4, u); int n8 = 8; asm volatile("" : "+s"(n8)); u.nt = n8; return ok; }
    __device__ __forceinline__ void setupA(const gk::Unit& u, int tid, const char*& base, unsigned (&vo)[2][2], unsigned& kstep) const {
        base = (const char*)act + (size_t)u.pm * DM; kstep = 128;
#pragma unroll
        for (int h = 0; h < 2; ++h)
#pragma unroll
            for (int i = 0; i < 2; ++i) { int R_, C_, Rb_; gk::stage_coords(tid, i, R_, C_, Rb_); (void)Rb_; vo[h][i] = (unsigned)((h * 128 + R_) * DM + C_ * 2); }
    }
    __device__ __forceinline__ void setupB(const gk::Unit& u, int tid, const char*& base, unsigned (&vo)[2], unsigned& kstep, unsigned& hstep) const {
        base = (const char*)w2t + ((size_t)u.e * 1024 + u.pn * 256) * 1024; kstep = 128; hstep = 128u * 1024u;
#pragma unroll
        for (int i = 0; i < 2; ++i) { int R_, C_, Rb_; gk::stage_coords(tid, i, R_, C_, Rb_); (void)R_; vo[i] = (unsigned)(Rb_ * 1024 + C_ * 2); }
    }
    __device__ __forceinline__ void epi(const gk::Acc& acc, const gk::Unit& u, int wr, int wc, int fr, int fq) const {
        int r0 = wr * 64 + fr, col0 = u.pn * 256 + wc * 32 + 8 * fq; asm volatile("" : "+v"(r0), "+v"(col0));
        constexpr float US = 1.0f / (F8_SW * F8_SA);
        f32x4 bv[2][2];
#pragma unroll
        for (int bj = 0; bj < 2; ++bj)
#pragma unroll
            for (int n = 0; n < 2; ++n) bv[bj][n] = *(const f32x4*)(b2 + (size_t)u.e * 1024 + col0 + bj * 128 + 4 * n);
        float gwv[2][4];
#pragma unroll
        for (int ai = 0; ai < 2; ++ai)
#pragma unroll
            for (int m = 0; m < 4; ++m) { const int r = r0 + ai * 128 + m * 16; gwv[ai][m] = wslot[(size_t)u.e * NT + 256 * u.rt + (r < u.rows ? r : 0)]; }
#pragma unroll
        for (int ai = 0; ai < 2; ++ai)
#pragma unroll
            for (int m = 0; m < 4; ++m) {
                const int r = r0 + ai * 128 + m * 16;
                if (r < u.rows) {
                    const float gw = gwv[ai][m];
                    unsigned char* rowp = yk + (size_t)(u.pm + r) * DM + col0;
#pragma unroll
                    for (int bj = 0; bj < 2; ++bj) {
                        const f32x4 v0 = (acc[ai][bj][m][0] * US + bv[bj][0]) * (gw * F8_SY), v1 = (acc[ai][bj][m][1] * US + bv[bj][1]) * (gw * F8_SY);
                        *(u32x2*)(rowp + bj * 128) = (u32x2){pk4_fp8(v0[0], v0[1], v0[2], v0[3]), pk4_fp8(v1[0], v1[1], v1[2], v1[3])};
                    }
                }
            }
    }
};

namespace att {
__device__ __forceinline__ void glds16(const void* gsrc, unsigned lds_dst) {
    asm volatile("s_mov_b32 m0, %1\n\ts_nop 0\n\tglobal_load_lds_dwordx4 %0, off" :: "v"(gsrc), "s"(lds_dst) : "memory", "m0"); }
__device__ __forceinline__ void glds4(const void* gsrc, unsigned lds_dst) {
    asm volatile("s_mov_b32 m0, %1\n\ts_nop 0\n\tglobal_load_lds_dword %0, off" :: "v"(gsrc), "s"(lds_dst) : "memory", "m0"); }
typedef short v4i16_t __attribute__((ext_vector_type(4)));
__device__ __forceinline__ s16x4 vtr(const LAS char* p) { return __builtin_bit_cast(s16x4, __builtin_amdgcn_ds_read_tr16_b64_v4i16((LAS v4i16_t*)p)); }
__device__ __forceinline__ int crow(int r, int hi) { return (r & 3) + 8 * (r >> 2) + 4 * hi; }
__device__ __forceinline__ float swapmax(float m) { auto rr = __builtin_amdgcn_permlane32_swap(__float_as_uint(m), __float_as_uint(m), false, false); return fmaxf(__uint_as_float(rr[0]), __uint_as_float(rr[1])); }
__device__ __forceinline__ float swapadd(float m) { auto rr = __builtin_amdgcn_permlane32_swap(__float_as_uint(m), __float_as_uint(m), false, false); return __uint_as_float(rr[0]) + __uint_as_float(rr[1]); }
constexpr int SLOTB = 8192, LDS_K = 0, LDS_V = 3 * SLOTB, LDS_B = 6 * SLOTB;
__device__ __forceinline__ bf16x8 packp(const f32x16& p, int s) {
    u32x4 w; w.x = gk::cvt_pk_bf16(p[8 * s + 0], p[8 * s + 1]); w.y = gk::cvt_pk_bf16(p[8 * s + 2], p[8 * s + 3]); w.z = gk::cvt_pk_bf16(p[8 * s + 4], p[8 * s + 5]); w.w = gk::cvt_pk_bf16(p[8 * s + 6], p[8 * s + 7]);
    return __builtin_bit_cast(bf16x8, w);
}
__device__ __forceinline__ float softmax_step(f32x16& p0, f32x16& p1, float& m, float& l) {
    float rm = p0[0];
#pragma unroll
    for (int r = 1; r < 16; ++r) rm = fmaxf(rm, p0[r]);
#pragma unroll
    for (int r = 0; r < 16; ++r) rm = fmaxf(rm, p1[r]);
    rm = swapmax(rm);
    const float mn = fmaxf(m, rm), alpha = __builtin_amdgcn_exp2f(m - mn); m = mn;
    float s = 0.f;
#pragma unroll
    for (int r = 0; r < 16; ++r) { p0[r] = __builtin_amdgcn_exp2f(p0[r] - mn); s += p0[r]; }
#pragma unroll
    for (int r = 0; r < 16; ++r) { p1[r] = __builtin_amdgcn_exp2f(p1[r] - mn); s += p1[r]; }
    l = l * alpha + s;
    return alpha;
}
template <int THR>
__device__ __forceinline__ bool softmax_ref(f32x16& a0, f32x16& a1, f32x16& negm, float& ref, float& l, float& alpha, bool first) {
    float rm = a0[0];
#pragma unroll
    for (int r = 1; r < 16; ++r) rm = fmaxf(rm, a0[r]);
#pragma unroll
    for (int r = 0; r < 16; ++r) rm = fmaxf(rm, a1[r]);
    rm = swapmax(rm);
    bool resc = false; alpha = 1.0f;
    if (first || __any(rm > (float)THR)) {
        const float dl = first ? rm : fmaxf(rm, 0.0f);
        ref += dl; alpha = first ? 1.0f : __builtin_amdgcn_exp2f(-dl); l *= alpha; resc = !first;
#pragma unroll
        for (int r = 0; r < 16; ++r) { a0[r] -= dl; a1[r] -= dl; negm[r] = -ref; }
    }
    float s = 0.f;
#pragma unroll
    for (int r = 0; r < 16; ++r) { a0[r] = __builtin_amdgcn_exp2f(a0[r]); s += a0[r]; }
#pragma unroll
    for (int r = 0; r < 16; ++r) { a1[r] = __builtin_amdgcn_exp2f(a1[r]); s += a1[r]; }
    l += s;
    return resc;
}
template <int MODE>
__device__ __forceinline__ void unit(int b, int h, int qb, const bf16* proj, const float* fbias, const unsigned* qkn, bf16* ycat, float lam, float lam_init, const float* subln, LAS char* shm) {
    int tid_ = threadIdx.x; asm volatile("" : "+v"(tid_));
    const int tid = tid_, lane = tid & 63, r32 = lane & 31, hi = lane >> 5; const int wid = __builtin_amdgcn_readfirstlane(tid >> 6);
    constexpr int QC = MODE ? C_DQ : C_FQ, KC = MODE ? C_DK : C_FK, VC = MODE ? C_DV : C_FV, NDMA = MODE ? 2 : 3;
    const long rowbase = (long)b * SEQ; const int q0 = qb * 256;
    const bf16* Qw = proj + (rowbase + q0 + wid * 32) * NPROJ + QC + h * 64;
    const bf16* ksrc = proj + (rowbase + lane) * NPROJ + KC + h * 64 + wid * 8;
    const bf16* vsrc = proj + (rowbase + 16 * (wid & 3) + (lane >> 2)) * NPROJ + VC + h * 64 + (wid >> 2) * 32 + (lane & 3) * 8;
    const float* bsrc = fbias + (size_t)(b * 4 + h) * SEQ + lane;
    const unsigned lds0 = (unsigned)(uintptr_t)shm;
    const unsigned kdst = lds0 + LDS_K + wid * 1024, vdst = lds0 + LDS_V + wid * 1024, bdst = lds0 + LDS_B + wid * 768;
    const int NTL = (q0 + 256) / 64;
    bf16x8 qr[4];
#pragma unroll
    for (int d0 = 0; d0 < 4; ++d0) qr[d0] = *reinterpret_cast<const bf16x8*>(&Qw[(long)r32 * NPROJ + d0 * 16 + hi * 8]);
#define ATT_ISSUE(t, slot) do { glds16(ksrc + (long)(t) * 64 * NPROJ, (unsigned)__builtin_amdgcn_readfirstlane(kdst + (slot) * SLOTB)); \
        glds16(vsrc + (long)(t) * 64 * NPROJ, (unsigned)__builtin_amdgcn_readfirstlane(vdst + (slot) * SLOTB)); \
        if (MODE == 0) glds4(bsrc + (t) * 64, (unsigned)__builtin_amdgcn_readfirstlane(bdst + (slot) * 256)); } while (0)
    int T0 = 0;
    if (MODE == 0) {
        const float qn = __uint_as_float(__hip_atomic_load(qkn + (b * 4 + h) * 2, __ATOMIC_RELAXED, __HIP_MEMORY_SCOPE_AGENT)), kn = __uint_as_float(__hip_atomic_load(qkn + (b * 4 + h) * 2 + 1, __ATOMIC_RELAXED, __HIP_MEMORY_SCOPE_AGENT));
        const float* bb = fbias + (size_t)(b * 4 + h) * SEQ;
        const float thresh = bb[q0] - 64.0f - 2.0f * qn * kn;
        const float be = (lane < NTL) ? bb[64 * lane + 63] : INFINITY;
        const unsigned long long msk = __ballot(be >= thresh);
        T0 = __builtin_amdgcn_readfirstlane(__ffsll((long long)msk) - 1);
        if (T0 > NTL - 4) T0 = NTL - 4;
        if (T0 < 0) T0 = 0;
    }
    ATT_ISSUE(T0, 0); ATT_ISSUE(T0 + 1, 1);
    const LAS char* kp0 = shm + LDS_K + hi * 1024 + r32 * 16;
    const LAS char* vp0 = shm + LDS_V + ((lane >> 4) & 1) * 32 + (lane & 3) * 8 + (4 * hi + ((lane & 15) >> 2)) * 64;
    const LAS char* bp0 = shm + LDS_B + wid * 768 + hi * 16;
    float m1 = MODE ? 0.f : -1e30f, l1 = 0.f, m2 = MODE ? 0.f : -1e30f, l2 = 0.f;
    f32x16 o1[2], o2[2], ngA = f32x16{}, ngB = f32x16{};
    f32x16 o1_dummy; (void)o1_dummy;
    o1[0] = f32x16{}; o1[1] = f32x16{}; o2[0] = f32x16{}; o2[1] = f32x16{};
    const int qrel = wid * 32 + r32;
    int slot = 0;
    for (int t = T0; t < NTL; ++t) {
        if (t + 1 < NTL) { if (MODE == 0) asm volatile("s_waitcnt vmcnt(3)" ::: "memory"); else asm volatile("s_waitcnt vmcnt(2)" ::: "memory"); }
        else asm volatile("s_waitcnt vmcnt(0)" ::: "memory");
        __builtin_amdgcn_s_barrier();
        asm volatile("" ::: "memory");
        if (t + 2 < NTL) { const int s2 = (slot == 0) ? 2 : slot - 1; ATT_ISSUE(t + 2, s2); }
        const LAS char* kp = kp0 + slot * SLOTB; const LAS char* vp = vp0 + slot * SLOTB;
        const int jb = t - (NTL - 4);
        if (MODE == 0) {
            f32x16 p0, p1;
            const LAS char* bp = bp0 + slot * 256;
#pragma unroll
            for (int g = 0; g < 4; ++g) { const f32x4 a = *(const LAS f32x4*)(bp + g * 32), c = *(const LAS f32x4*)(bp + 128 + g * 32);
#pragma unroll
                for (int j = 0; j < 4; ++j) { p0[4 * g + j] = a[j]; p1[4 * g + j] = c[j]; } }
            bf16x8 kfr[4][2];
#pragma unroll
            for (int d0 = 0; d0 < 4; ++d0) { kfr[d0][0] = *(const LAS bf16x8*)(kp + d0 * 2048); kfr[d0][1] = *(const LAS bf16x8*)(kp + d0 * 2048 + 512); }
            __builtin_amdgcn_sched_barrier(0);
#pragma unroll
            for (int d0 = 0; d0 < 4; ++d0) { p0 = __builtin_amdgcn_mfma_f32_32x32x16_bf16(kfr[d0][0], qr[d0], p0, 0, 0, 0); p1 = __builtin_amdgcn_mfma_f32_32x32x16_bf16(kfr[d0][1], qr[d0], p1, 0, 0, 0); }
            if (jb >= 0) {
#pragma unroll
                for (int r = 0; r < 16; ++r) { const int kv = 64 * jb + crow(r, hi); if (kv > qrel) p0[r] = -INFINITY; if (kv + 32 > qrel) p1[r] = -INFINITY; }
            }
            bf16x8 vfr[4][2];
#pragma unroll
            for (int ks = 0; ks < 4; ++ks)
#pragma unroll
                for (int d0 = 0; d0 < 2; ++d0) { const s16x4 lo = vtr(vp + d0 * 4096 + ks * 1024), hh = vtr(vp + d0 * 4096 + ks * 1024 + 512); vfr[ks][d0] = (bf16x8){lo[0], lo[1], lo[2], lo[3], hh[0], hh[1], hh[2], hh[3]}; }
            __builtin_amdgcn_sched_barrier(0);
            const float al = softmax_step(p0, p1, m1, l1);
#pragma unroll
            for (int d = 0; d < 2; ++d)
#pragma unroll
                for (int r = 0; r < 16; ++r) o1[d][r] *= al;
#pragma unroll
            for (int ks = 0; ks < 4; ++ks) { const bf16x8 pf = (ks < 2) ? packp(p0, ks) : packp(p1, ks - 2);
#pragma unroll
                for (int d0 = 0; d0 < 2; ++d0) o1[d0] = __builtin_amdgcn_mfma_f32_32x32x16_bf16(vfr[ks][d0], pf, o1[d0], 0, 0, 0); }
        } else {
            f32x16 a0 = ngA, a1 = ngA, b0 = ngB, b1 = ngB;
            bf16x8 kfr[4][2];
#pragma unroll
            for (int d0 = 0; d0 < 4; ++d0) { kfr[d0][0] = *(const LAS bf16x8*)(kp + d0 * 2048); kfr[d0][1] = *(const LAS bf16x8*)(kp + d0 * 2048 + 512); }
            __builtin_amdgcn_sched_barrier(0);
#pragma unroll
            for (int d0 = 0; d0 < 2; ++d0) { a0 = __builtin_amdgcn_mfma_f32_32x32x16_bf16(kfr[d0][0], qr[d0], a0, 0, 0, 0); a1 = __builtin_amdgcn_mfma_f32_32x32x16_bf16(kfr[d0][1], qr[d0], a1, 0, 0, 0);
                b0 = __builtin_amdgcn_mfma_f32_32x32x16_bf16(kfr[d0 + 2][0], qr[d0 + 2], b0, 0, 0, 0); b1 = __builtin_amdgcn_mfma_f32_32x32x16_bf16(kfr[d0 + 2][1], qr[d0 + 2], b1, 0, 0, 0); }
            if (jb >= 0) {
#pragma unroll
                for (int r = 0; r < 16; ++r) { const int kv = 64 * jb + crow(r, hi); if (kv > qrel) { a0[r] = -INFINITY; b0[r] = -INFINITY; } if (kv + 32 > qrel) { a1[r] = -INFINITY; b1[r] = -INFINITY; } }
            }
            bf16x8 vfr[4][2];
#pragma unroll
            for (int ks = 0; ks < 4; ++ks)
#pragma unroll
                for (int d0 = 0; d0 < 2; ++d0) { const s16x4 lo = vtr(vp + d0 * 4096 + ks * 1024), hh = vtr(vp + d0 * 4096 + ks * 1024 + 512); vfr[ks][d0] = (bf16x8){lo[0], lo[1], lo[2], lo[3], hh[0], hh[1], hh[2], hh[3]}; }
            __builtin_amdgcn_sched_barrier(0);
            float al1, al2;
            const bool r1 = softmax_ref<8>(a0, a1, ngA, m1, l1, al1, t == T0), r2 = softmax_ref<8>(b0, b1, ngB, m2, l2, al2, t == T0);
            if (r1) {
#pragma unroll
                for (int d = 0; d < 2; ++d)
#pragma unroll
                    for (int r = 0; r < 16; ++r) o1[d][r] *= al1;
            }
            if (r2) {
#pragma unroll
                for (int d = 0; d < 2; ++d)
#pragma unroll
                    for (int r = 0; r < 16; ++r) o2[d][r] *= al2;
            }
#pragma unroll
            for (int ks = 0; ks < 4; ++ks) { const bf16x8 pa = (ks < 2) ? packp(a0, ks) : packp(a1, ks - 2), pb = (ks < 2) ? packp(b0, ks) : packp(b1, ks - 2);
#pragma unroll
                for (int d0 = 0; d0 < 2; ++d0) { o1[d0] = __builtin_amdgcn_mfma_f32_32x32x16_bf16(vfr[ks][d0], pa, o1[d0], 0, 0, 0); o2[d0] = __builtin_amdgcn_mfma_f32_32x32x16_bf16(vfr[ks][d0], pb, o2[d0], 0, 0, 0); } }
        }
        slot = (slot == 2) ? 0 : slot + 1;
    }
#undef ATT_ISSUE
    const float lt1 = swapadd(l1), inv1 = 1.0f / lt1;
    bf16* orow = ycat + (size_t)(rowbase + q0 + wid * 32 + r32) * DM + (MODE ? 512 : 0) + h * 64;
    if (MODE == 0) {
#pragma unroll
        for (int d0 = 0; d0 < 2; ++d0)
#pragma unroll
            for (int g = 0; g < 4; ++g) { u32x2 w; w.x = pk2(o1[d0][4 * g] * inv1, o1[d0][4 * g + 1] * inv1); w.y = pk2(o1[d0][4 * g + 2] * inv1, o1[d0][4 * g + 3] * inv1);
                *(u32x2*)(orow + d0 * 32 + 8 * g + 4 * hi) = w; }
    } else {
        const float lt2 = swapadd(l2), inv2 = lam / lt2;
        float ss = 0.f;
#pragma unroll
        for (int d0 = 0; d0 < 2; ++d0)
#pragma unroll
            for (int r = 0; r < 16; ++r) { const float y = o1[d0][r] * inv1 - o2[d0][r] * inv2; o1[d0][r] = y; ss += y * y; }
        ss = swapadd(ss);
        const float rs = rsqrtf(ss * (1.0f / 64.0f) + EPS) * (1.0f - lam_init);
#pragma unroll
        for (int d0 = 0; d0 < 2; ++d0)
#pragma unroll
            for (int g = 0; g < 4; ++g) { const f32x4 gg = *(const f32x4*)(subln + d0 * 32 + 8 * g + 4 * hi);
                u32x2 w; w.x = pk2(o1[d0][4 * g] * rs * gg[0], o1[d0][4 * g + 1] * rs * gg[1]); w.y = pk2(o1[d0][4 * g + 2] * rs * gg[2], o1[d0][4 * g + 3] * rs * gg[3]);
                *(u32x2*)(orow + d0 * 32 + 8 * g + 4 * hi) = w; }
    }
    asm volatile("s_waitcnt lgkmcnt(0)\n\ts_barrier" ::: "memory");
}
}

namespace hg {
constexpr int LD = 132, LDV = 68, LDB = 136;
constexpr int OFF_GA = 0, OFF_KT = 64 * LD * 4, OFF_QT = 2 * 64 * LD * 4, OFF_VV = 3 * 64 * LD * 4 + 1024, OFF_TOT = OFF_VV + 64 * LDV * 4, OFF_E31 = OFF_TOT + 2048, OFF_LB = OFF_E31 + 512, OFF_Q = OFF_LB + 2048;
__device__ __forceinline__ float rcp_(float x) { return __builtin_amdgcn_rcpf(x); }
struct Pre1 { u32x2 xf[4]; u32x4 v; };
struct Pre3 { u32x2 xf[4], xq[4]; u32x4 v, g; u32x4 si[2]; };
__device__ __forceinline__ void issue1(Pre1& P, const bf16* proj, int u, int tid) {
    const int c = u & 63, h = (u >> 6) & 3, b = u >> 8, t = tid >> 3, q = tid & 7; const bf16* r = proj + ((size_t)b * SEQ + c * 64 + t) * NPROJ;
#pragma unroll
    for (int cc = 0; cc < 4; ++cc) P.xf[cc] = *(const u32x2*)(r + C_HF + h * 128 + 32 * cc + 4 * q);
    P.v = *(const u32x4*)(r + C_HI + h * 64 + 8 * q);
}
__device__ __forceinline__ void issue3(Pre3& P, const bf16* proj, const bf16* hst, int u, int tid) {
    const int c = u & 63, h = (u >> 6) & 3, b = u >> 8, t = tid >> 3, q = tid & 7; const bf16* r = proj + ((size_t)b * SEQ + c * 64 + t) * NPROJ;
#pragma unroll
    for (int cc = 0; cc < 4; ++cc) { P.xf[cc] = *(const u32x2*)(r + C_HF + h * 128 + 32 * cc + 4 * q); P.xq[cc] = *(const u32x2*)(r + C_HQ + h * 128 + 32 * cc + 4 * q); }
    P.v = *(const u32x4*)(r + C_HI + h * 64 + 8 * q); P.g = *(const u32x4*)(r + C_HG + h * 64 + 8 * q);
#pragma unroll
    for (int j = 0; j < 2; ++j) P.si[j] = *(const u32x4*)(hst + (size_t)u * 8192 + (tid & 127) * 64 + (tid >> 7) * 16 + 8 * j);
}
__device__ __forceinline__ void common(LAS float* GA, LAS float* KT, LAS float* TOT, const LAS float* LB, const u32x2 (&xf)[4], int h, int tid) {
    { const int t = tid >> 3, q = tid & 7;
#pragma unroll
      for (int cc = 0; cc < 4; ++cc) { const int k = 32 * cc + 4 * q; const f32x4 lb = *(const LAS f32x4*)(LB + h * 128 + k);
          const float x[4] = {bflo(xf[cc].x), bfhi(xf[cc].x), bflo(xf[cc].y), bfhi(xf[cc].y)}; f32x4 g, om;
#pragma unroll
          for (int e = 0; e < 4; ++e) { const float ex = __expf(-fminf(fmaxf(x[e], -30.0f), 30.0f)); const float s = rcp_(1.0f + ex), s1 = ex * s;
              g[e] = __logf(lb[e] + (1.0f - lb[e]) * s); om[e] = (1.0f - lb[e]) * s1; }
          *(LAS f32x4*)(GA + t * LD + k) = g; *(LAS f32x4*)(KT + t * LD + k) = om; } }
    __syncthreads();
    const int kk = tid & 127, part = tid >> 7;
    float a[16]; float run = 0.f;
#pragma unroll
    for (int i = 0; i < 16; ++i) { run += GA[(16 * part + i) * LD + kk]; a[i] = run; }
    TOT[part * 128 + kk] = run;
    __syncthreads();
    float off = 0.f;
#pragma unroll
    for (int p = 0; p < 3; ++p) if (p < part) off += TOT[p * 128 + kk];
#pragma unroll
    for (int i = 0; i < 16; ++i) GA[(16 * part + i) * LD + kk] = a[i] + off;
    __syncthreads();
}
__device__ __forceinline__ void store_v(LAS float* VV, const u32x4 w, int tid) {
    const int t = tid >> 3, v0 = (tid & 7) * 8; LAS float* d = VV + t * LDV + v0;
    *(LAS f32x4*)d = (f32x4){bflo(w.x), bfhi(w.x), bflo(w.y), bfhi(w.y)}; *(LAS f32x4*)(d + 4) = (f32x4){bflo(w.z), bfhi(w.z), bflo(w.w), bfhi(w.w)};
}
__device__ __forceinline__ void lb_table(Frame& F, int l, const float* hgl) {
    LAS float* LB = (LAS float*)(F.lds + OFF_LB);
    LB[F.tid] = (l == 0) ? 0.0f : 1.0f / (1.0f + __expf(hgl[F.tid] - hgl[512 + F.tid]));
    __syncthreads();
}
__device__ __forceinline__ unsigned q_issue(Frame& F, unsigned* qc) { unsigned v = 0u; if (F.tid == 0) v = __hip_atomic_fetch_add(qc, 1u, __ATOMIC_RELAXED, __HIP_MEMORY_SCOPE_AGENT); return v; }
__device__ __forceinline__ void q_publish(Frame& F, unsigned v) { if (F.tid == 0) *(volatile LAS unsigned*)(F.lds + OFF_Q) = v; }
__device__ __forceinline__ int q_read(Frame& F) { return (int)*(volatile LAS unsigned*)(F.lds + OFF_Q); }
__device__ __forceinline__ void h1_phase(Frame& F, int l, const bf16* proj, const float* hgl, bf16* hst, float* hdec, unsigned* qc) {
    LAS float* SL = (LAS float*)(F.lds + OFF_QT);
    LAS float* GA = (LAS float*)(F.lds + OFF_GA); LAS float* KT = (LAS float*)(F.lds + OFF_KT); LAS float* VV = (LAS float*)(F.lds + OFF_VV); LAS float* TOT = (LAS float*)(F.lds + OFF_TOT);
    const LAS float* LB = (const LAS float*)(F.lds + OFF_LB);
    const int tid = F.tid;
    { const unsigned q0 = q_issue(F, qc); q_publish(F, q0); } lb_table(F, l, hgl);
    int u = q_read(F);
    __syncthreads();
    Pre1 P; if (u < HGUNITS) issue1(P, proj, u, tid);
    while (u < HGUNITS) {
        const int h = (u >> 6) & 3;
        const unsigned qv = q_issue(F, qc);
        common(GA, KT, TOT, LB, P.xf, h, tid);
        { const int t = tid >> 3, q = tid & 7;
#pragma unroll
          for (int cc = 0; cc < 4; ++cc) { const int k = 32 * cc + 4 * q; const f32x4 g31 = *(const LAS f32x4*)(GA + 31 * LD + k), gt = *(const LAS f32x4*)(GA + t * LD + k); f32x4 kt = *(const LAS f32x4*)(KT + t * LD + k);
#pragma unroll
              for (int e = 0; e < 4; ++e) kt[e] *= __expf(g31[e] - gt[e]);
              *(LAS f32x4*)(KT + t * LD + k) = kt; } }
        store_v(VV, P.v, tid);
        if (tid < 128) hdec[(size_t)u * 128 + tid] = __expf(GA[63 * LD + tid]);
        q_publish(F, qv);
        __syncthreads();
        const int un = q_read(F);
        if (un < HGUNITS) issue1(P, proj, un, tid);
        const int lane = F.lane, i = lane & 15, kk = lane >> 4, kb = 16 * F.wave;
#pragma unroll
        for (int vt = 0; vt < 4; ++vt) {
            f32x4 acc = (f32x4){0.f, 0.f, 0.f, 0.f};
#pragma unroll
            for (int s0 = 0; s0 < 64; s0 += 16)
#pragma unroll
                for (int m = 0; m < 4; ++m) { const int s = s0 + 4 * kk + m; acc = __builtin_amdgcn_mfma_f32_16x16x4f32(KT[s * LD + kb + i], VV[s * LDV + 16 * vt + i], acc, 0, 0, 0); }
#pragma unroll
            for (int r = 0; r < 4; ++r) { const int k = kb + 4 * kk + r; SL[k * LDV + 16 * vt + i] = acc[r] * __expf(GA[63 * LD + k] - GA[31 * LD + k]); }
        }
        __syncthreads();
        { const int k = tid >> 2, vq = (tid & 3) * 16; const LAS float* sp = SL + k * LDV + vq;
          const f32x4 a = *(const LAS f32x4*)sp, b = *(const LAS f32x4*)(sp + 4), c = *(const LAS f32x4*)(sp + 8), d = *(const LAS f32x4*)(sp + 12);
          bf16* dst = hst + (size_t)u * 8192 + k * 64 + vq;
          *(u32x4*)dst = (u32x4){pk2(a[0], a[1]), pk2(a[2], a[3]), pk2(b[0], b[1]), pk2(b[2], b[3])}; *(u32x4*)(dst + 8) = (u32x4){pk2(c[0], c[1]), pk2(c[2], c[3]), pk2(d[0], d[1]), pk2(d[2], d[3])}; }
        u = un;
    }
}
__device__ __forceinline__ void h3_phase(Frame& F, int l, const bf16* proj, const float* hgl, const bf16* hst, const float* normg, bf16* ycat, unsigned* qc) {
    LAS float* GA = (LAS float*)(F.lds + OFF_GA); LAS float* KT = (LAS float*)(F.lds + OFF_KT); LAS bf16* QTb = (LAS bf16*)(F.lds + OFF_QT); LAS bf16* KTb = QTb + 64 * LDB; LAS float* VV = (LAS float*)(F.lds + OFF_VV);
    LAS float* TOT = (LAS float*)(F.lds + OFF_TOT); LAS float* E31 = (LAS float*)(F.lds + OFF_E31); const LAS float* LB = (const LAS float*)(F.lds + OFF_LB);
    const int tid = F.tid;
    { const unsigned q0 = q_issue(F, qc); q_publish(F, q0); } lb_table(F, l, hgl);
    int u = q_read(F);
    __syncthreads();
    Pre3 P; if (u < HGUNITS) issue3(P, proj, hst, u, tid);
    while (u < HGUNITS) {
        const int c = u & 63, h = (u >> 6) & 3, b = u >> 8; const size_t row0 = (size_t)b * SEQ + c * 64;
        const unsigned qv = q_issue(F, qc);
        common(GA, KT, TOT, LB, P.xf, h, tid);
        { const int t = tid >> 3, q = tid & 7;
#pragma unroll
          for (int cc = 0; cc < 4; ++cc) { const int k = 32 * cc + 4 * q; const f32x4 g31 = *(const LAS f32x4*)(GA + 31 * LD + k), gt = *(const LAS f32x4*)(GA + t * LD + k); f32x4 kt = *(const LAS f32x4*)(KT + t * LD + k), qt;
              const float x[4] = {bflo(P.xq[cc].x), bfhi(P.xq[cc].x), bflo(P.xq[cc].y), bfhi(P.xq[cc].y)};
#pragma unroll
              for (int e = 0; e < 4; ++e) { const float d = gt[e] - g31[e], ed = __expf(d); qt[e] = x[e] * rcp_(1.0f + __expf(-x[e])) * ed; kt[e] *= rcp_(ed); }
              *(LAS u32x2*)(QTb + t * LDB + k) = (u32x2){pk2(qt[0], qt[1]), pk2(qt[2], qt[3])}; *(LAS u32x2*)(KTb + t * LDB + k) = (u32x2){pk2(kt[0], kt[1]), pk2(kt[2], kt[3])}; } }
        if (tid < 128) E31[tid] = __expf(GA[31 * LD + tid]);
        store_v(VV, P.v, tid);
        const u32x4 gate = P.g;
        __syncthreads();
        LAS bf16* SIt = (LAS bf16*)GA;
        { const int k = tid & 127, vb = (tid >> 7) * 16; const float sc = E31[k];
#pragma unroll
          for (int j = 0; j < 2; ++j) { const unsigned w4[4] = {P.si[j].x, P.si[j].y, P.si[j].z, P.si[j].w};
#pragma unroll
              for (int e = 0; e < 8; ++e) SIt[(vb + 8 * j + e) * LDB + k] = (bf16)f2bf(((e & 1) ? bfhi(w4[e >> 1]) : bflo(w4[e >> 1])) * sc); } }
        q_publish(F, qv);
        __syncthreads();
        const int un = q_read(F);
        if (un < HGUNITS) issue3(P, proj, hst, un, tid);
        const int lane = F.lane, i = lane & 15, kk = lane >> 4, w = F.wave, tt = (w < 4) ? w : 7 - w, vh = w >> 2;
        f32x4 o[2]; o[0] = (f32x4){0.f, 0.f, 0.f, 0.f}; o[1] = o[0];
        for (int j = 0; j <= tt; ++j) {
            f32x4 at = (f32x4){0.f, 0.f, 0.f, 0.f};
#pragma unroll
            for (int st = 0; st < 4; ++st) { const bf16x8 a8 = *(const LAS bf16x8*)(KTb + (16 * j + i) * LDB + 32 * st + 8 * kk), b8 = *(const LAS bf16x8*)(QTb + (16 * tt + i) * LDB + 32 * st + 8 * kk);
                at = __builtin_amdgcn_mfma_f32_16x16x32_bf16(a8, b8, at, 0, 0, 0); }
            if (j == tt) {
#pragma unroll
                for (int r = 0; r < 4; ++r) if (4 * kk + r > i) at[r] = 0.f;
            }
#pragma unroll
            for (int vt = 0; vt < 2; ++vt)
#pragma unroll
                for (int m = 0; m < 4; ++m) o[vt] = __builtin_amdgcn_mfma_f32_16x16x4f32(VV[(16 * j + 4 * kk + m) * LDV + 32 * vh + 16 * vt + i], at[m], o[vt], 0, 0, 0);
        }
#pragma unroll
        for (int st = 0; st < 4; ++st) { const bf16x8 b8 = *(const LAS bf16x8*)(QTb + (16 * tt + i) * LDB + 32 * st + 8 * kk);
#pragma unroll
            for (int vt = 0; vt < 2; ++vt) o[vt] = __builtin_amdgcn_mfma_f32_16x16x32_bf16(*(const LAS bf16x8*)(SIt + (32 * vh + 16 * vt + i) * LDB + 32 * st + 8 * kk), b8, o[vt], 0, 0, 0); }
        __syncthreads();
        LAS float* OUT = KT;
#pragma unroll
        for (int vt = 0; vt < 2; ++vt) *(LAS f32x4*)(OUT + (16 * tt + i) * LDV + 32 * vh + 16 * vt + 4 * kk) = o[vt];
        __syncthreads();
        { const int t = tid >> 3, v0 = (tid & 7) * 8;
          const f32x4 va = *(const LAS f32x4*)(OUT + t * LDV + v0), vb = *(const LAS f32x4*)(OUT + t * LDV + v0 + 4);
          const float vals[8] = {va[0], va[1], va[2], va[3], vb[0], vb[1], vb[2], vb[3]}; float ss = 0.f;
#pragma unroll
          for (int j = 0; j < 8; ++j) ss += vals[j] * vals[j];
          ss += __shfl_xor(ss, 1); ss += __shfl_xor(ss, 2); ss += __shfl_xor(ss, 4);
          const float rs = rsqrtf(ss * (1.0f / 64.0f) + EPS);
          const unsigned gww[4] = {gate.x, gate.y, gate.z, gate.w};
          float y[8];
#pragma unroll
          for (int j = 0; j < 8; ++j) { const float gx = (j & 1) ? bfhi(gww[j >> 1]) : bflo(gww[j >> 1]); y[j] = vals[j] * rs * normg[v0 + j] * gx * rcp_(1.0f + __expf(-gx)); }
          u32x4 wv; wv.x = pk2(y[0], y[1]); wv.y = pk2(y[2], y[3]); wv.z = pk2(y[4], y[5]); wv.w = pk2(y[6], y[7]);
          *(u32x4*)(ycat + (row0 + t) * DM + 256 + h * 64 + v0) = wv; }
        __syncthreads();
        u = un;
    }
}
}

struct S5P { const float *a_re, *a_im, *log_step, *b_re, *b_im, *c_re, *c_im, *d; };
__device__ __forceinline__ void s5_pow(const S5P& P, int g, int n, float p, float& pr, float& pi) {
    const float dt = __expf(P.log_step[g]); const float lr = fminf(P.a_re[g * 64 + n], -1e-4f), li = P.a_im[g * 64 + n];
    const float mag = expf(lr * dt * p); float s, c; sincosf(li * dt * p, &s, &c); pr = mag * c; pi = mag * s;
}
__device__ __forceinline__ void s5_z(const S5P& P, int g, int n, float& zr, float& zi) {
    const float dt = __expf(P.log_step[g]); const float lr = fminf(P.a_re[g * 64 + n], -1e-4f), li = P.a_im[g * 64 + n];
    const float mag = expf(lr * dt); float s, c; sincosf(li * dt, &s, &c); const float ar = mag * c, ai = mag * s, den = lr * lr + li * li;
    zr = ((ar - 1.0f) * lr + ai * li) / den; zi = (ai * lr - (ar - 1.0f) * li) / den;
}

__device__ __forceinline__ void transpose_tile(const float* W, int N, int K, int k0, int n0src, bf16* WT, int mode, int n0dst, LAS float* scr, int lane) {
#pragma unroll
    for (int i = 0; i < 16; ++i) { const int kk = 4 * i + (lane >> 4), nn = (lane & 15) * 4;
        const f32x4 v = *(const f32x4*)(W + (size_t)(k0 + kk) * N + n0src + nn);
        scr[kk * 65 + nn] = v[0]; scr[kk * 65 + nn + 1] = v[1]; scr[kk * 65 + nn + 2] = v[2]; scr[kk * 65 + nn + 3] = v[3]; }
    LDS_WAIT(); asm volatile("" ::: "memory");
    const int c = lane & 7;
#pragma unroll
    for (int p = 0; p < 8; ++p) { const int n = (lane >> 3) + 8 * p; const LAS float* s = scr + (8 * c) * 65 + n;
        u32x4 o; o.x = pk2(s[0], s[65]); o.y = pk2(s[2 * 65], s[3 * 65]); o.z = pk2(s[4 * 65], s[5 * 65]); o.w = pk2(s[6 * 65], s[7 * 65]);
        int drow = n0dst + n; if (mode == 2) { const int ns = n0src + n; drow = 2 * (ns & 255) + (ns >> 8); }
        *(u32x4*)(WT + (size_t)drow * K + k0 + 8 * c) = o; }
    LDS_WAIT(); asm volatile("" ::: "memory");
}
struct F8Item { const float* src; unsigned char* dst; int N; };
__device__ __forceinline__ void f8_item(Frame& F, int it, F8Item& I) {
    constexpr int I_W1 = 64 * 8 * 64, I_W2 = 64 * 8 * 32;
    int r = it;
    if (r < I_W1) { const int m = r / 512, q = r % 512, kb = q / 64, nb = q % 64; I.N = 2048; I.src = (const float*)karg(28) + (size_t)m * 1024 * 2048 + (size_t)(kb * 128) * 2048 + nb * 32; I.dst = F.ws + WS_W1T + (size_t)m * 2048 * 1024 + (size_t)(nb * 32) * 1024 + kb * 128; return; }
    r -= I_W1;
    if (r < I_W2) { const int m = r / 256, q = r % 256, kb = q / 32, nb = q % 32; I.N = 1024; I.src = (const float*)karg(30) + (size_t)m * 1024 * 1024 + (size_t)(kb * 128) * 1024 + nb * 32; I.dst = F.ws + WS_W2T + (size_t)m * 1024 * 1024 + (size_t)(nb * 32) * 1024 + kb * 128; return; }
    r -= I_W2;
    { const int m = r / 832, q = r % 832, kb = q / 104, nb = q % 104; const int nd = nb * 32, ns = nd < 768 ? nd : nd + 4; I.N = INCOLS;
      I.src = (const float*)karg(7) + (size_t)m * 1024 * INCOLS + (size_t)(kb * 128) * INCOLS + ns; I.dst = F.ws + WS_WIN + (size_t)m * NPROJ * 1024 + (size_t)nd * 1024 + kb * 128; }
}
__device__ __forceinline__ void f8_load(const F8Item& I, f32x4 (&tv)[16], int lane) {
#pragma unroll
    for (int i = 0; i < 16; ++i) { const int kk = 8 * i + (lane >> 3), nn = (lane & 7) * 4; tv[i] = __builtin_nontemporal_load((const f32x4*)(I.src + (size_t)kk * I.N + nn)); }
}
__device__ __forceinline__ void f8_store(const F8Item& I, const f32x4 (&tv)[16], LAS float* scr, int lane) {
#pragma unroll
    for (int i = 0; i < 16; ++i) { const int kk = 8 * i + (lane >> 3), nn = (lane & 7) * 4; *(LAS f32x2*)(scr + kk * 34 + nn) = (f32x2){tv[i][0], tv[i][1]}; *(LAS f32x2*)(scr + kk * 34 + nn + 2) = (f32x2){tv[i][2], tv[i][3]}; }
    LDS_WAIT(); asm volatile("" ::: "memory");
    const int n = lane & 31, kh = lane >> 5; const LAS float* s = scr + (64 * kh) * 34 + n;
#pragma unroll
    for (int c = 0; c < 4; ++c) { u32x4 o;
        o.x = pk4_fp8(s[(16 * c + 0) * 34] * F8_SW, s[(16 * c + 1) * 34] * F8_SW, s[(16 * c + 2) * 34] * F8_SW, s[(16 * c + 3) * 34] * F8_SW);
        o.y = pk4_fp8(s[(16 * c + 4) * 34] * F8_SW, s[(16 * c + 5) * 34] * F8_SW, s[(16 * c + 6) * 34] * F8_SW, s[(16 * c + 7) * 34] * F8_SW);
        o.z = pk4_fp8(s[(16 * c + 8) * 34] * F8_SW, s[(16 * c + 9) * 34] * F8_SW, s[(16 * c + 10) * 34] * F8_SW, s[(16 * c + 11) * 34] * F8_SW);
        o.w = pk4_fp8(s[(16 * c + 12) * 34] * F8_SW, s[(16 * c + 13) * 34] * F8_SW, s[(16 * c + 14) * 34] * F8_SW, s[(16 * c + 15) * 34] * F8_SW);
        *(u32x4*)(I.dst + (size_t)n * 1024 + 64 * kh + 16 * c) = o; }
    LDS_WAIT(); asm volatile("" ::: "memory");
}
__device__ __forceinline__ void p0_prologue(Frame& F, const Args& a) {
    LAS float* scr = (LAS float*)(F.lds + F.wave * 17408);
    const int gw = F.vcu * NWAVES + F.wave, NGW = F.G * NWAVES;
    const float* w_out = (const float*)karg(8); const float* glu = (const float*)karg(25);
    bf16* wout_t = (bf16*)(F.ws + WS_WOUT); bf16* glu_t = (bf16*)(F.ws + WS_GLU);
    { constexpr int NIT = 64 * 8 * 64 + 64 * 8 * 32 + 2 * 8 * 104;
      F8Item cur, nxt; f32x4 tv[16];
      int it = gw;
      if (it < NIT) { f8_item(F, it, cur); f8_load(cur, tv, F.lane); }
      while (it < NIT) {
          f32x4 tw[16];
#pragma unroll
          for (int i = 0; i < 16; ++i) tw[i] = tv[i];
          const int itn = it + NGW;
          if (itn < NIT) { f8_item(F, itn, nxt); f8_load(nxt, tv, F.lane); }
          f8_store(cur, tw, scr, F.lane);
          cur = nxt; it = itn;
      } }
    constexpr int I_WOUT = 2 * 16 * 16, I_GLU = 2 * 4 * 8;
    constexpr int NITEMS = I_WOUT + I_GLU;
    for (int it = gw; it < NITEMS; it += NGW) {
        int r = it;
        if (r < I_WOUT) { const int m = r / (16 * 16), q = r % (16 * 16), kb = q / 16, nb = q % 16; transpose_tile(w_out + (size_t)m * 1024 * 1024, 1024, 1024, kb * 64, nb * 64, wout_t + (size_t)m * 1024 * 1024, 0, nb * 64, scr, F.lane); continue; } r -= I_WOUT;
        { const int m = r / 32, q = r % 32, kb = q / 8, nb = q % 8; transpose_tile(glu + (size_t)m * 256 * 512, 512, 256, kb * 64, nb * 64, glu_t + (size_t)m * 512 * 256, 2, 0, scr, F.lane); }
    }
    __syncthreads();
    {
        const float* cc = (const float*)karg(1); const float* ada_w = (const float*)karg(3); const float* ada_b = (const float*)karg(4); float* mod = (float*)(F.ws + WS_MOD);
        LAS float* cs = (LAS float*)F.lds;
        LAS float* red = (LAS float*)(F.lds + 32768);
        for (int i = F.tid; i < 8192; i += NTHR) cs[i] = siluf_(cc[i]);
        __syncthreads();
        for (int it = F.vcu; it < 2 * 96; it += F.G) {
            const int l = it / 96, n0 = (it % 96) * 64, n = n0 + F.lane;
            float acc[8] = {0.f, 0.f, 0.f, 0.f, 0.f, 0.f, 0.f, 0.f};
            const float* wp = ada_w + (size_t)l * 1024 * 6144 + (size_t)(128 * F.wave) * 6144 + n;
#pragma unroll 8
            for (int k = 0; k < 128; ++k) { const float w = wp[(size_t)k * 6144];
#pragma unroll
                for (int b = 0; b < 8; ++b) acc[b] += cs[b * 1024 + 128 * F.wave + k] * w; }
#pragma unroll
            for (int b = 0; b < 8; ++b) red[(F.wave * 8 + b) * 64 + F.lane] = acc[b];
            __syncthreads();
            { const int b = F.tid >> 6, ln = F.tid & 63; float s = ada_b[l * 6144 + n0 + ln];
#pragma unroll
              for (int w = 0; w < 8; ++w) s += red[(w * 8 + b) * 64 + ln];
              mod[((size_t)l * 8 + b) * 6144 + n0 + ln] = s; }
            __syncthreads();
        }
    }
    {
        const int gt = F.vcu * NTHR + F.tid, NGT = F.G * NTHR;
        float* ktau = (float*)(F.ws + WS_KTAU4); bf16* Ebt = (bf16*)(F.ws + WS_S5E); bf16* Fbt = (bf16*)(F.ws + WS_S5F);
        for (int it4 = gt; it4 < 4 * 2 * 16 * 32 * 16; it4 += NGT) {
            const int it = it4 & 16383, nq = it4 >> 14;
            const int h = it & 15, tau = (it >> 4) & 31, g = (it >> 9) & 15, l = it >> 13;
            S5P P{(const float*)karg(17) + l * 1024, (const float*)karg(18) + l * 1024, (const float*)karg(19) + l * 16, (const float*)karg(20) + l * 16384, (const float*)karg(21) + l * 16384,
                  (const float*)karg(22) + l * 16384, (const float*)karg(23) + l * 16384, (const float*)karg(24) + l * 256};
            float acc[16];
#pragma unroll
            for (int j = 0; j < 16; ++j) acc[j] = 0.f;
            for (int n = 16 * nq; n < 16 * nq + 16; ++n) {
                float pr, pi, zr, zi; s5_pow(P, g, n, (float)tau, pr, pi); s5_z(P, g, n, zr, zi);
                const float cr = P.c_re[(g * 16 + h) * 64 + n], ci = P.c_im[(g * 16 + h) * 64 + n];
                const float qr = pr * zr - pi * zi, qi = pr * zi + pi * zr;
                const float tr = cr * qr - ci * qi, ti = cr * qi + ci * qr;
                const float* br = P.b_re + (g * 64 + n) * 16; const float* bi = P.b_im + (g * 64 + n) * 16;
#pragma unroll
                for (int j = 0; j < 16; ++j) acc[j] += tr * br[j] - ti * bi[j];
            }
            if (tau == 0 && nq == 0) acc[h] += P.d[g * 16 + h];
            float* o = ktau + (size_t)it4 * 16;
#pragma unroll
            for (int j = 0; j < 16; ++j) o[j] = acc[j];
        }
        for (int it = gt; it < 2 * 16 * 64 * 32; it += NGT) {
            const int s = it & 31, n = (it >> 5) & 63, g = (it >> 11) & 15, l = it >> 15, pair = g >> 1, gs = g & 1;
            S5P P{(const float*)karg(17) + l * 1024, (const float*)karg(18) + l * 1024, (const float*)karg(19) + l * 16, (const float*)karg(20) + l * 16384, (const float*)karg(21) + l * 16384,
                  (const float*)karg(22) + l * 16384, (const float*)karg(23) + l * 16384, (const float*)karg(24) + l * 256};
            float pr, pi, zr, zi; s5_pow(P, g, n, (float)(31 - s), pr, pi); s5_z(P, g, n, zr, zi);
            const float qr = pr * zr - pi * zi, qi = pr * zi + pi * zr;
            const float* br = P.b_re + (g * 64 + n) * 16; const float* bi = P.b_im + (g * 64 + n) * 16;
            bf16* e0 = Ebt + (((size_t)(l * 8 + pair) * 256) + gs * 128 + 2 * n) * 1024 + s * 32;
            unsigned wr_[8], wi_[8];
#pragma unroll
            for (int j = 0; j < 8; ++j) { const float vr0 = qr * br[2 * j] - qi * bi[2 * j], vi0 = qr * bi[2 * j] + qi * br[2 * j], vr1 = qr * br[2 * j + 1] - qi * bi[2 * j + 1], vi1 = qr * bi[2 * j + 1] + qi * br[2 * j + 1];
                wr_[j] = pk2(vr0, vr1); wi_[j] = pk2(vi0, vi1); }
            const u32x4 z4 = (u32x4){0u, 0u, 0u, 0u};
            *(u32x4*)(e0 + gs * 16) = (u32x4){wr_[0], wr_[1], wr_[2], wr_[3]}; *(u32x4*)(e0 + gs * 16 + 8) = (u32x4){wr_[4], wr_[5], wr_[6], wr_[7]};
            *(u32x4*)(e0 + 1024 + gs * 16) = (u32x4){wi_[0], wi_[1], wi_[2], wi_[3]}; *(u32x4*)(e0 + 1024 + gs * 16 + 8) = (u32x4){wi_[4], wi_[5], wi_[6], wi_[7]};
            *(u32x4*)(e0 + (1 - gs) * 16) = z4; *(u32x4*)(e0 + (1 - gs) * 16 + 8) = z4; *(u32x4*)(e0 + 1024 + (1 - gs) * 16) = z4; *(u32x4*)(e0 + 1024 + (1 - gs) * 16 + 8) = z4;
        }
        for (int it = gt; it < 2 * 16 * 64 * 32; it += NGT) {
            const int n = it & 63, t = (it >> 6) & 31, g = (it >> 11) & 15, l = it >> 15, pair = g >> 1, gs = g & 1;
            S5P P{(const float*)karg(17) + l * 1024, (const float*)karg(18) + l * 1024, (const float*)karg(19) + l * 16, (const float*)karg(20) + l * 16384, (const float*)karg(21) + l * 16384,
                  (const float*)karg(22) + l * 16384, (const float*)karg(23) + l * 16384, (const float*)karg(24) + l * 256};
            float pr, pi; s5_pow(P, g, n, (float)(t + 1), pr, pi);
            bf16* f0 = Fbt + ((size_t)(l * 8 + pair) * 1024 + t * 32) * 256 + gs * 128 + 2 * n;
#pragma unroll
            for (int h = 0; h < 16; ++h) { const float cr = P.c_re[(g * 16 + h) * 64 + n], ci = P.c_im[(g * 16 + h) * 64 + n];
                const float wr = cr * pr - ci * pi, wi = cr * pi + ci * pr;
                *(unsigned*)(f0 + (size_t)(gs * 16 + h) * 256) = pk2(wr, -wi);
                *(unsigned*)(f0 + (size_t)((1 - gs) * 16 + h) * 256) = 0u; }
        }
    }
}
__device__ __forceinline__ void s5_fill_m(Frame& F) {
    const int gt = F.vcu * NTHR + F.tid, NGT = F.G * NTHR;
    const float* ktau = (const float*)(F.ws + WS_KTAU4); bf16* Mbt = (bf16*)(F.ws + WS_S5M);
    for (int it = gt; it < 2 * 8 * 1024 * 128; it += NGT) {
        const int kc = it & 127, np = (it >> 7) & 1023, pair = (it >> 17) & 7, l = it >> 20;
        const int k0 = kc * 8, s = k0 >> 5, gs = (k0 >> 4) & 1, hp = k0 & 15, t = np >> 5, gsp = (np >> 4) & 1, h = np & 15;
        u32x4 o = (u32x4){0u, 0u, 0u, 0u};
        if (gs == gsp && s <= t) { const float* kp = ktau + ((((size_t)(l * 16 + pair * 2 + gs) * 32) + (t - s)) * 16 + h) * 16 + hp;
            f32x4 a = *(const f32x4*)kp, b = *(const f32x4*)(kp + 4);
#pragma unroll
            for (int q = 1; q < 4; ++q) { a += *(const f32x4*)(kp + (size_t)q * 262144); b += *(const f32x4*)(kp + (size_t)q * 262144 + 4); }
            o.x = pk2(a[0], a[1]); o.y = pk2(a[2], a[3]); o.z = pk2(b[0], b[1]); o.w = pk2(b[2], b[3]); }
        *(u32x4*)(Mbt + (size_t)it * 8) = o;
    }
}

struct RowVec { f32x4 v[4]; };
__device__ __forceinline__ RowVec load_vec(const float* p, int lane) { RowVec r; const f32x4* q = (const f32x4*)p + lane;
#pragma unroll
    for (int j = 0; j < 4; ++j) r.v[j] = q[64 * j];
    return r; }
__device__ __forceinline__ float sumsq(const RowVec& r) { float s = 0.f;
#pragma unroll
    for (int j = 0; j < 4; ++j) s += (r.v[j][0] * r.v[j][0] + r.v[j][1] * r.v[j][1]) + (r.v[j][2] * r.v[j][2] + r.v[j][3] * r.v[j][3]);
    return wave_sum(s); }
__device__ __forceinline__ void store_bf16_row(bf16* p, const RowVec& r, int lane) { u32x2* q = (u32x2*)p + lane;
#pragma unroll
    for (int j = 0; j < 4; ++j) { u32x2 w; w.x = pk2(r.v[j][0], r.v[j][1]); w.y = pk2(r.v[j][2], r.v[j][3]); q[64 * j] = w; } }
__device__ __forceinline__ RowVec load_vec_bf16(const bf16* p, int lane) { RowVec r; const u32x2* q = (const u32x2*)p + lane;
#pragma unroll
    for (int j = 0; j < 4; ++j) { const u32x2 w = q[64 * j]; r.v[j] = (f32x4){bflo(w.x), bfhi(w.x), bflo(w.y), bfhi(w.y)}; }
    return r; }
struct Norm1Ctx { RowVec gm, sh; f32x4 wff[16]; f32x4 fb; };
__device__ __forceinline__ void norm1_setup(Norm1Ctx& cx, const Args& a, const float* mod, int l, int b, int lane) {
    const RowVec g = load_vec((const float*)karg(5) + (size_t)(l * 2 + 0) * DM, lane), sc = load_vec(mod + ((size_t)l * 8 + b) * 6144 + 1024, lane);
    cx.sh = load_vec(mod + ((size_t)l * 8 + b) * 6144, lane);
#pragma unroll
    for (int j = 0; j < 4; ++j) cx.gm.v[j] = g.v[j] * (sc.v[j] + 1.0f);
    const float* w_in = (const float*)karg(7) + (size_t)l * DM * INCOLS + 768;
#pragma unroll
    for (int j = 0; j < 4; ++j)
#pragma unroll
        for (int c = 0; c < 4; ++c) cx.wff[j * 4 + c] = *(const f32x4*)(w_in + (size_t)(4 * lane + 256 * j + c) * INCOLS);
    cx.fb = *(const f32x4*)((const float*)karg(9) + l * 4);
}
__device__ __forceinline__ void norm1_row(const Norm1Ctx& cx, const RowVec& x, unsigned char* hrow, float* logf_row, int lane) {
    const float rs = rsqrtf(sumsq(x) * (1.0f / DM) + EPS);
    RowVec h; f32x4 ff = (f32x4){0.f, 0.f, 0.f, 0.f};
#pragma unroll
    for (int j = 0; j < 4; ++j) { h.v[j] = x.v[j] * rs * cx.gm.v[j] + cx.sh.v[j];
#pragma unroll
        for (int c = 0; c < 4; ++c) ff += cx.wff[j * 4 + c] * h.v[j][c]; }
    { unsigned* q = (unsigned*)hrow + lane;
#pragma unroll
      for (int j = 0; j < 4; ++j) q[64 * j] = pk4_fp8(h.v[j][0] * F8_SH, h.v[j][1] * F8_SH, h.v[j][2] * F8_SH, h.v[j][3] * F8_SH); }
#pragma unroll
    for (int c = 0; c < 4; ++c) ff[c] = wave_sum(ff[c]);
    if (lane == 0) { f32x4 o;
#pragma unroll
        for (int c = 0; c < 4; ++c) { const float z = ff[c] + cx.fb[c]; o[c] = fminf(z, 0.f) - log1pf(__expf(-fabsf(z))); }
        *(f32x4*)logf_row = o; }
}
__device__ __forceinline__ void p1_norm1(Frame& F, const Args& a, int l, const float* xsrc) {
    const int gw = F.vcu * NWAVES + F.wave; const int row0 = gw * 16, b = row0 / SEQ;
    Norm1Ctx cx; norm1_setup(cx, a, (const float*)(F.ws + WS_MOD), l, b, F.lane);
    unsigned char* H = F.ws + WS_H8; float* logf = (float*)(F.ws + WS_LOGF);
    RowVec xn = load_vec(xsrc + (size_t)row0 * DM, F.lane);
#pragma unroll 1
    for (int r = 0; r < 16; ++r) { const int row = row0 + r; const RowVec x = xn; if (r < 15) xn = load_vec(xsrc + (size_t)(row + 1) * DM, F.lane); norm1_row(cx, x, H + (size_t)row * DM, logf + (size_t)row * 4, F.lane); }
}
__device__ __forceinline__ void fox_cumsum(Frame& F, int bh) {
    const float* logf = (const float*)(F.ws + WS_LOGF); float* fb = (float*)(F.ws + WS_FBIAS);
    const int b = bh >> 2, h = bh & 3, lane = F.lane;
    const float* src = logf + ((size_t)b * SEQ + 64 * lane) * 4 + h;
    float tot = 0.f;
#pragma unroll 16
    for (int i = 0; i < 64; ++i) tot += src[i * 4];
    float inc = tot;
#pragma unroll
    for (int o = 1; o < 64; o <<= 1) { const float t = __shfl_up(inc, o); if (lane >= o) inc += t; }
    float run = inc - tot;
    float* dst = fb + (size_t)bh * SEQ + 64 * lane;
#pragma unroll 16
    for (int i = 0; i < 64; ++i) { run += src[i * 4]; dst[i] = -run * LOG2E; }
}
__device__ __forceinline__ void fox_norms(Frame& F, int task, int l) {
    const int bh = task >> 4, ch = task & 15, b = bh >> 2, h = bh & 3, lane = F.lane;
    const bf16* base = (const bf16*)(F.ws + WS_PROJ) + ((size_t)b * SEQ + ch * 256 + lane * 4) * NPROJ + h * 64;
    float mq = 0.f, mk = 0.f;
#pragma unroll
    for (int i = 0; i < 4; ++i) {
        float sq = 0.f, sk = 0.f;
#pragma unroll
        for (int j = 0; j < 8; ++j) { const u32x4 wq = *(const u32x4*)(base + (size_t)i * NPROJ + C_FQ + 8 * j), wk = *(const u32x4*)(base + (size_t)i * NPROJ + C_FK + 8 * j);
            const unsigned a[4] = {wq.x, wq.y, wq.z, wq.w}, c[4] = {wk.x, wk.y, wk.z, wk.w};
#pragma unroll
            for (int e = 0; e < 4; ++e) { sq += bflo(a[e]) * bflo(a[e]) + bfhi(a[e]) * bfhi(a[e]); sk += bflo(c[e]) * bflo(c[e]) + bfhi(c[e]) * bfhi(c[e]); } }
        mq = fmaxf(mq, sq); mk = fmaxf(mk, sk);
    }
    mq = sqrtf(wave_max(mq)) * 1.001f; mk = sqrtf(wave_max(mk)) * 1.001f;
    if (lane == 0) { unsigned* w = F.ctl + CW_QKN + 64 * l + bh * 2; atomicMax(w, __float_as_uint(mq)); atomicMax(w + 1, __float_as_uint(mk)); }
}
__device__ __forceinline__ void hg_scan(Frame& F) {
    const bf16* hst = (const bf16*)(F.ws + WS_HST); bf16* hst2 = (bf16*)(F.ws + WS_HST2); const float* hdec = (const float*)(F.ws + WS_HDEC);
    const int gt = F.vcu * NTHR + F.tid, NGT = F.G * NTHR;
    for (int e = gt; e < 32 * 8192; e += NGT) {
        const int bh = e >> 13, kv = e & 8191, k = kv >> 6;
        float carry = 0.f;
        const bf16* p = hst + (size_t)bh * 64 * 8192 + kv; bf16* q = hst2 + (size_t)bh * 64 * 8192 + kv; const float* d = hdec + (size_t)bh * 64 * 128 + k;
#pragma unroll 16
        for (int c = 0; c < 64; ++c) { const float t = bf2f(p[(size_t)c * 8192]); q[(size_t)c * 8192] = (bf16)f2bf(carry); carry = d[c * 128] * carry + t; }
    }
}
__device__ __forceinline__ void s5_scan(Frame& F, const Args& a, int l) {
    const int gt = F.vcu * NTHR + F.tid;
    if (gt >= 8 * 16 * 64 * 8) return;
    const int lane = F.lane, seg = lane >> 3, gwv = gt >> 6, n = (gwv & 7) * 8 + (lane & 7), g = (gwv >> 3) & 15, b = gwv >> 7, pair = g >> 1, gs = g & 1;
    S5P P{(const float*)karg(17) + l * 1024, (const float*)karg(18) + l * 1024, (const float*)karg(19) + l * 16, nullptr, nullptr, nullptr, nullptr, nullptr};
    float ar, ai, br, bi; s5_pow(P, g, n, 32.0f, ar, ai); s5_pow(P, g, n, 512.0f, br, bi);
    const float* xl = (const float*)(F.ws + WS_XLOC) + ((size_t)b * 128 + seg * 16) * 2048 + pair * 256 + gs * 128 + 2 * n;
    bf16* xi = (bf16*)(F.ws + WS_XIN) + ((size_t)b * 128 + seg * 16) * 2048 + pair * 256 + gs * 128 + 2 * n;
    float lr[16], li[16]; float xr = 0.f, xim = 0.f;
#pragma unroll
    for (int j = 0; j < 16; ++j) { const f32x2 v = *(const f32x2*)(xl + (size_t)j * 2048); lr[j] = xr; li[j] = xim;
        const float nr = ar * xr - ai * xim + v[0], ni = ar * xim + ai * xr + v[1]; xr = nr; xim = ni; }
    float cr = 0.f, ci = 0.f;
#pragma unroll
    for (int sg = 1; sg < 8; ++sg) { const float tr = __shfl_up(xr, 8), ti = __shfl_up(xim, 8), pr_ = __shfl_up(cr, 8), pi_ = __shfl_up(ci, 8);
        if (seg == sg) { cr = br * pr_ - bi * pi_ + tr; ci = br * pi_ + bi * pr_ + ti; } }
    float pr = 1.f, pi = 0.f;
#pragma unroll
    for (int j = 0; j < 16; ++j) { *(unsigned*)(xi + (size_t)j * 2048) = pk2(lr[j] + pr * cr - pi * ci, li[j] + pr * ci + pi * cr);
        const float qr = pr * ar - pi * ai, qi = pr * ai + pi * ar; pr = qr; pi = qi; }
}
constexpr int RW_LD = 1028;
constexpr int LDS_LG = LDS_STASH;
__device__ __forceinline__ void p8_post_router(Frame& F, const Args& a, int l, const float* xsrc, bool dummy) {
    const bf16* x2src = (const bf16*)(F.ws + WS_X2);
#define P8_LOADX(row_) ((l == 0) ? load_vec(xsrc + (size_t)(row_) * DM, lane) : load_vec_bf16(x2src + (size_t)(row_) * DM, lane))
    const int lane = F.lane, tid = F.tid;
    const int gw = F.vcu * NWAVES + F.wave; const int row0 = gw * 16, b = row0 / SEQ;
    const float* mod = (const float*)(F.ws + WS_MOD) + ((size_t)l * 8 + b) * 6144;
    const float* pre_g = (const float*)karg(5) + (size_t)(l * 2 + 1) * DM;
    LAS float* WT = (LAS float*)F.lds;
    LAS float* CV = (LAS float*)(F.lds + 135680);
    { const float* rw = (const float*)karg(26) + (size_t)l * DM * NEXP;
      for (int idx = tid; idx < 8192; idx += NTHR) { const int k = idx >> 3, eq = idx & 7; const f32x4 w = *(const f32x4*)(rw + (size_t)k * NEXP + 4 * eq); const float g = pre_g[k] * (mod[4096 + k] + 1.0f);
          WT[(4 * eq + 0) * RW_LD + k] = w[0] * g; WT[(4 * eq + 1) * RW_LD + k] = w[1] * g; WT[(4 * eq + 2) * RW_LD + k] = w[2] * g; WT[(4 * eq + 3) * RW_LD + k] = w[3] * g; }
      { const int e = tid & 31, part = tid >> 5; float sacc = 0.f;
#pragma unroll 8
        for (int k = part * 64; k < part * 64 + 64; ++k) sacc += mod[3072 + k] * rw[(size_t)k * NEXP + e];
        CV[32 + part * 32 + e] = sacc; }
      __syncthreads();
      if (tid < 32) { float sacc = ((const float*)karg(27))[l * NEXP + tid];
#pragma unroll
          for (int p = 0; p < 16; ++p) sacc += CV[32 + p * 32 + tid];
          CV[tid] = sacc; } }
    __syncthreads();
    RowVec pg;
    { const RowVec pgv = load_vec((const float*)karg(6) + (size_t)(l * 2 + 0) * DM, lane), g1 = load_vec(mod + 2048, lane);
#pragma unroll
      for (int j = 0; j < 4; ++j) pg.v[j] = pgv.v[j] * g1.v[j]; }
    const bf16* Y2 = (const bf16*)(F.ws + WS_Y2); unsigned char* H8 = F.ws + WS_H8; bf16* xbuf = (bf16*)(F.ws + WS_X1);
    RowVec gm2, sh2s;
    { const RowVec pre = load_vec(pre_g, lane), sc2 = load_vec(mod + 4096, lane), sh2 = load_vec(mod + 3072, lane);
#pragma unroll
      for (int j = 0; j < 4; ++j) { gm2.v[j] = pre.v[j] * (sc2.v[j] + 1.0f) * F8_SH; sh2s.v[j] = sh2.v[j] * F8_SH; } }
    float rs2mine = 0.f;
    RowVec xn = P8_LOADX(row0); u32x2 yn[4];
    { const u32x2* yp = (const u32x2*)(Y2 + (size_t)row0 * DM) + lane;
#pragma unroll
      for (int j = 0; j < 4; ++j) yn[j] = yp[64 * j]; }
#pragma unroll 1
    for (int rr = 0; rr < 16; ++rr) {
        const int row = row0 + rr;
        RowVec x = xn, y;
#pragma unroll
        for (int j = 0; j < 4; ++j) y.v[j] = (f32x4){bflo(yn[j].x), bfhi(yn[j].x), bflo(yn[j].y), bfhi(yn[j].y)};
        if (rr < 15) { xn = P8_LOADX(row + 1); const u32x2* yp = (const u32x2*)(Y2 + (size_t)(row + 1) * DM) + lane;
#pragma unroll
            for (int j = 0; j < 4; ++j) yn[j] = yp[64 * j]; }
        const float rs = rsqrtf(sumsq(y) * (1.0f / DM) + EPS);
#pragma unroll
        for (int j = 0; j < 4; ++j) x.v[j] += y.v[j] * rs * pg.v[j];
        store_bf16_row(xbuf + (size_t)row * DM, x, lane);
        const float rs2 = rsqrtf(sumsq(x) * (1.0f / DM) + EPS);
        if (lane == rr) rs2mine = rs2;
        { unsigned* q = (unsigned*)(H8 + (size_t)row * DM) + lane;
#pragma unroll
          for (int j = 0; j < 4; ++j) { const f32x4 hv = x.v[j] * rs2 * gm2.v[j] + sh2s.v[j]; q[64 * j] = pk4_fp8(hv[0], hv[1], hv[2], hv[3]); } }
    }
    asm volatile("s_waitcnt vmcnt(0)" ::: "memory");
    f32x4 acc0 = (f32x4){0.f, 0.f, 0.f, 0.f}, acc1 = acc0;
    { const int i = lane & 15, kk = lane >> 4;
      const bf16* xa = xbuf + (size_t)(row0 + i) * DM + 4 * kk; const LAS float* wb = WT + i * RW_LD + 4 * kk;
#pragma unroll 8
      for (int k0 = 0; k0 < DM; k0 += 16) { const u32x2 aw = *(const u32x2*)(xa + k0); const f32x4 av = (f32x4){bflo(aw.x), bfhi(aw.x), bflo(aw.y), bfhi(aw.y)}; const f32x4 b0 = *(const LAS f32x4*)(wb + k0), b1 = *(const LAS f32x4*)(wb + 16 * RW_LD + k0);
#pragma unroll
          for (int m = 0; m < 4; ++m) { acc0 = __builtin_amdgcn_mfma_f32_16x16x4f32(av[m], b0[m], acc0, 0, 0, 0); acc1 = __builtin_amdgcn_mfma_f32_16x16x4f32(av[m], b1[m], acc1, 0, 0, 0); } }
      LAS float* LG = (LAS float*)(F.lds + LDS_LG) + F.wave * (16 * 33);
#pragma unroll
      for (int r = 0; r < 4; ++r) { const int rowi = 4 * kk + r; const float sc = __shfl(rs2mine, rowi); LG[rowi * 33 + i] = acc0[r] * sc + CV[i]; LG[rowi * 33 + 16 + i] = acc1[r] * sc + CV[16 + i]; } }
    LDS_WAIT(); asm volatile("" ::: "memory");
    LAS unsigned* TOP = (LAS unsigned*)(F.lds + 131584) + F.wave * 128;
    if (lane < 16) {
        const LAS float* LG = (const LAS float*)(F.lds + LDS_LG) + F.wave * (16 * 33) + lane * 33;
        float lg[32];
#pragma unroll
        for (int e = 0; e < 32; ++e) lg[e] = LG[e];
        unsigned used = 0u; float tv[4]; int te[4];
#pragma unroll
        for (int k = 0; k < 4; ++k) { float best = -INFINITY; int bi = 0;
#pragma unroll
            for (int e = 0; e < 32; ++e) { const bool ok = ((used >> e) & 1u) == 0u && lg[e] > best; best = ok ? lg[e] : best; bi = ok ? e : bi; }
            used |= 1u << bi; tv[k] = best; te[k] = bi; }
        float ws[4]; float sum = 0.f;
#pragma unroll
        for (int k = 0; k < 4; ++k) { ws[k] = __expf(tv[k] - tv[0]); sum += ws[k]; }
        const float inv = 1.0f / sum;
#pragma unroll
        for (int k = 0; k < 4; ++k) { TOP[4 * lane + k] = (unsigned)te[k]; TOP[64 + 4 * lane + k] = __float_as_uint(ws[k] * inv); }
    }
    LDS_WAIT(); asm volatile("" ::: "memory");
    const int myE = (int)TOP[lane]; const float myW = __uint_as_float(TOP[64 + lane]);
    unsigned long long mymask = 0ull, remaining = ~0ull;
#pragma unroll 1
    while (remaining) { const int src = __ffsll((long long)remaining) - 1; const int e0 = __builtin_amdgcn_readlane(myE, src); const unsigned long long m = __ballot(myE == e0); if (myE == e0) mymask = m; remaining &= ~m; }
    const int leader = __ffsll((long long)mymask) - 1, cntg = __popcll(mymask), rank = __popcll(mymask & ((1ull << lane) - 1ull));
    unsigned* cnt = F.ctl + (dummy ? CW_CNT_DUMMY : CW_CNT) + 64 * l;
    int base = 0;
    if (lane == leader) base = (int)__hip_atomic_fetch_add(cnt + myE, (unsigned)cntg, __ATOMIC_RELAXED, __HIP_MEMORY_SCOPE_AGENT);
    base = __shfl(base, leader);
    const int pos = base + rank, tokk = (row0 + (lane >> 2)) * 4 + (lane & 3);
    unsigned char* lw = F.ws + (dummy ? WS_ACT : 0);
    ((int*)(lw + WS_LISTS))[(size_t)myE * NT + pos] = tokk;
    ((float*)(lw + WS_WSLOT))[(size_t)myE * NT + pos] = myW;
    ((int*)(lw + WS_TOKPOS))[tokk] = myE * NT + pos;
    __syncthreads();
#undef P8_LOADX
}
__device__ __forceinline__ void p11_combine(Frame& F, const Args& a, int l) {
    const int lane = F.lane;
    const int gw = F.vcu * NWAVES + F.wave; const int row0 = gw * 16, b = row0 / SEQ;
    const float* mod = (const float*)(F.ws + WS_MOD) + ((size_t)l * 8 + b) * 6144;
    RowVec pg;
    { const RowVec pgv = load_vec((const float*)karg(6) + (size_t)(l * 2 + 1) * DM, lane), g2 = load_vec(mod + 5120, lane);
#pragma unroll
      for (int j = 0; j < 4; ++j) pg.v[j] = pgv.v[j] * g2.v[j]; }
    const unsigned* cnt = F.ctl + CW_CNT + 64 * l;
    int mybase; { const int c = (lane < 32) ? (int)__hip_atomic_load(cnt + lane, __ATOMIC_RELAXED, __HIP_MEMORY_SCOPE_AGENT) : 0; int ps = c;
#pragma unroll
        for (int o = 1; o < 32; o <<= 1) { const int t = __shfl_up(ps, o); if (lane >= o) ps += t; }
        mybase = ps - c; }
    const int* tokpos = (const int*)(F.ws + WS_TOKPOS); const unsigned char* YK = F.ws + WS_YK; const bf16* x1buf = (const bf16*)(F.ws + WS_X1); float* xbuf = (float*)karg(32); bf16* x2buf = (bf16*)(F.ws + WS_X2);
    Norm1Ctx cx; const bool nextl = (l + 1 < DEPTH);
    if (nextl) norm1_setup(cx, a, (const float*)(F.ws + WS_MOD), l + 1, b, lane);
    unsigned char* H = F.ws + WS_H8; float* logf = (float*)(F.ws + WS_LOGF);
    int myslot; { const int tp = tokpos[row0 * 4 + lane]; myslot = __shfl(mybase, tp >> 15) + (tp & 32767); }
    unsigned yn[4][4]; u32x2 xq[4];
#define P11_ISSUE(r_) do { _Pragma("unroll") for (int k = 0; k < 4; ++k) { const int slot = __shfl(myslot, 4 * (r_) + k); const unsigned* yp = (const unsigned*)(YK + (size_t)slot * DM) + lane; \
        _Pragma("unroll") for (int j = 0; j < 4; ++j) yn[k][j] = yp[64 * j]; } { const u32x2* xp = (const u32x2*)(x1buf + (size_t)(row0 + (r_)) * DM) + lane; _Pragma("unroll") for (int j = 0; j < 4; ++j) xq[j] = xp[64 * j]; } } while (0)
    P11_ISSUE(0);
#pragma unroll 1
    for (int r = 0; r < 16; ++r) {
        const int row = row0 + r;
        RowVec y, x;
#pragma unroll
        for (int j = 0; j < 4; ++j) { y.v[j] = (f32x4){0.f, 0.f, 0.f, 0.f}; x.v[j] = (f32x4){bflo(xq[j].x), bfhi(xq[j].x), bflo(xq[j].y), bfhi(xq[j].y)};
#pragma unroll
            for (int k = 0; k < 4; ++k) { const int w = (int)yn[k][j]; y.v[j] += (f32x4){__builtin_amdgcn_cvt_f32_fp8(w, 0), __builtin_amdgcn_cvt_f32_fp8(w, 1), __builtin_amdgcn_cvt_f32_fp8(w, 2), __builtin_amdgcn_cvt_f32_fp8(w, 3)}; } }
        if (r < 15) P11_ISSUE(r + 1);
        const float rs = rsqrtf(sumsq(y) * (1.0f / DM) + EPS);
#pragma unroll
        for (int j = 0; j < 4; ++j) x.v[j] += y.v[j] * rs * pg.v[j];
        if (nextl) store_bf16_row(x2buf + (size_t)row * DM, x, lane);
        else { f32x4* xo = (f32x4*)(xbuf + (size_t)row * DM) + lane;
#pragma unroll
          for (int j = 0; j < 4; ++j) xo[64 * j] = x.v[j]; }
        if (nextl) norm1_row(cx, x, H + (size_t)row * DM, logf + (size_t)row * 4, lane);
    }
#undef P11_ISSUE
}

constexpr int NPH = 22;
#ifndef PH_MASK
#define PH_MASK 0xFFF
#endif
#define PHON(id) ((((PH_MASK) >> (id)) & 1) && (BODY < 0 || BODY == (id)))
#ifndef SUB_MASK
#define SUB_MASK 0xFF
#endif
#define SUBON(id) (((SUB_MASK) >> (id)) & 1)
#ifndef DUP_MASK
#define DUP_MASK 0
#endif
#ifndef XMODE
#define XMODE 0
#endif
#define DUPN(id) ((((DUP_MASK) >> (id)) & 1) ? 2 : 1)
#define REP(id) for (int rep_ = 0; rep_ < DUPN(id); ++rep_)
#define REPBAR(id) do { if (DUPN(id) == 2 && rep_ == 0) GRID_BAR(); } while (0)
#define IN(k) (lo <= (k) && (k) < hi)
#if MK_ONE_LAUNCH
#define GRID_BAR() do { XcdBarrier b2_ = bar; asm volatile("" : "+s"(b2_.bar)); xcd_barrier(b2_); } while (0)
#else
#define GRID_BAR() do { } while (0)
#endif
#define SEAM(k) do { if (IN(k) && IN((k) + 1)) GRID_BAR(); } while (0)
#define x_in ((const float*)karg(0))
#define PROJ ((bf16*)(F.ws + WS_PROJ))
#define H ((bf16*)(F.ws + WS_H))
#define YCAT ((bf16*)(F.ws + WS_YCAT))
template <int BODY, int l>
__device__ __forceinline__ void layer_phases(Frame& F, const Args& args, const int lo, const int hi, const XcdBarrier& bar) {
        constexpr int pb = 2 + 10 * l;

        if (PHON(2) && IN(pb + 0)) REP(2) {
            REFRESH();
            ProjProb P; P.A = F.ws + WS_H8; P.Bt = F.ws + WS_WIN + (size_t)l * NPROJ * DM; P.O = PROJ; P.pos = (const int*)karg(2); P.G = F.G; P.c = F.vcu;
            gk::run<ProjProb, true>(F.lds, P, (DUPN(2) == 2 && rep_ == 0) ? XMODE : 0);
        REPBAR(2); } SEAM(pb + 0);
        if (PHON(3) && IN(pb + 1)) REP(3) {
            REFRESH();
            { const int gw = F.vcu * NWAVES + F.wave; if (gw >= 1024 && gw < 1024 + 32) fox_cumsum(F, gw - 1024); if (gw < 512) fox_norms(F, gw, l); }
            REFRESH();
            REFRESH();
            if (SUBON(1)) { S5EProb P; P.proj = PROJ; P.Ebt = (const bf16*)(F.ws + WS_S5E) + (size_t)l * 8 * 256 * 1024; P.xloc = (float*)(F.ws + WS_XLOC); P.G = F.G; P.c = F.G - 1 - F.vcu; gk::run(F.lds, P); }
            REFRESH();
            if (SUBON(0)) hg::h1_phase(F, l, PROJ, (const float*)karg(10), (bf16*)(F.ws + WS_HST), (float*)(F.ws + WS_HDEC), F.ctl + CW_HGQ + 8 * (2 * l + 0) + 4 * rep_);
        REPBAR(3); } SEAM(pb + 1);
        if (PHON(4) && IN(pb + 2)) REP(4) { REFRESH(); s5_scan(F, args, l); REFRESH(); hg_scan(F); REPBAR(4); } SEAM(pb + 2);
        if (PHON(5) && IN(pb + 3)) REP(5) {
            REFRESH();
            if (SUBON(1)) { S5FMProb P; P.proj = PROJ; P.xin = (const bf16*)(F.ws + WS_XIN); P.Fbt = (const bf16*)(F.ws + WS_S5F) + (size_t)l * 8 * 1024 * 256; P.Mbt = (const bf16*)(F.ws + WS_S5M) + (size_t)l * 8 * 1024 * 1024;
              P.ygelu = (bf16*)(F.ws + WS_YGELU); P.G = F.G; P.c = F.vcu; gk::run(F.lds, P); }
            REFRESH();
            if (SUBON(0)) hg::h3_phase(F, l, PROJ, (const float*)karg(10), (const bf16*)(F.ws + WS_HST2), (const float*)karg(11) + l * 64, YCAT, F.ctl + CW_HGQ + 8 * (2 * l + 1) + 4 * rep_);
        REPBAR(5); } SEAM(pb + 3);
        if (PHON(6) && IN(pb + 4)) REP(6) {
            REFRESH();
            if (SUBON(1)) { GluProb P; P.A = (const bf16*)(F.ws + WS_YGELU); P.Bt = (const bf16*)(F.ws + WS_GLU) + (size_t)l * 512 * 256; P.pitchA = 256; P.pitchB = 256; P.O = YCAT; P.G = F.G; P.c = F.vcu; gk::run(F.lds, P); }
            REFRESH();
            const float lam_init = 0.8f - 0.6f * expf(-0.3f * (float)l);
            float lam;
            { const float* q1 = (const float*)karg(12) + l * 32; const float* k1 = (const float*)karg(13) + l * 32; const float* q2 = (const float*)karg(14) + l * 32; const float* k2 = (const float*)karg(15) + l * 32;
              float s1 = 0.f, s2 = 0.f; for (int i = 0; i < 32; ++i) { s1 += q1[i] * k1[i]; s2 += q2[i] * k2[i]; } lam = expf(s1) - expf(s2) + lam_init; }
            const float* fbias = (const float*)(F.ws + WS_FBIAS); const float* subln = (const float*)karg(16) + l * 64; bf16* proj_ = PROJ; bf16* ycat_ = YCAT; const unsigned* qkn_ = F.ctl + CW_QKN + 64 * l;
            for (int v = F.vcu; v < 256; v += F.G) {
                const int bh = v >> 3, s = v & 7, b = bh >> 2, h = bh & 3;
                if (SUBON(2)) att::unit<1>(b, h, 15 - s, proj_, fbias, qkn_, ycat_, lam, lam_init, subln, (LAS char*)F.lds);
                if (SUBON(0)) att::unit<0>(b, h, 15 - s, proj_, fbias, qkn_, ycat_, lam, lam_init, subln, (LAS char*)F.lds);
                if (SUBON(2)) att::unit<1>(b, h, s, proj_, fbias, qkn_, ycat_, lam, lam_init, subln, (LAS char*)F.lds);
                if (SUBON(0)) att::unit<0>(b, h, s, proj_, fbias, qkn_, ycat_, lam, lam_init, subln, (LAS char*)F.lds);
            }
        REPBAR(6); } SEAM(pb + 4);
        if (PHON(7) && IN(pb + 5)) REP(7) {
            REFRESH();
            PlainProb P; P.A = YCAT; P.Bt = (const bf16*)(F.ws + WS_WOUT) + (size_t)l * DM * DM; P.pitchA = DM; P.pitchB = DM; P.O = (bf16*)(F.ws + WS_Y2); P.ldc = DM; P.nM = NT / 256; P.nN = 4; P.G = F.G; P.c = F.vcu;
            gk::run(F.lds, P);
        REPBAR(7); } SEAM(pb + 5);
        if (PHON(8) && IN(pb + 6)) REP(8) { REFRESH(); p8_post_router(F, args, l, l == 0 ? x_in : (const float*)karg(32), DUPN(8) == 2 && rep_ == 0); REPBAR(8); } SEAM(pb + 6);
        if (PHON(9) && IN(pb + 7)) REP(9) {
            REFRESH();
            moe_tables(F, F.ctl + CW_CNT + 64 * l);
            Moe1Prob P; P.h8 = (const unsigned char*)(F.ws + WS_H8); P.w1t = (const unsigned char*)(F.ws + WS_W1T) + (size_t)l * 32 * 2048 * 1024; P.b1 = (const float*)karg(29) + (size_t)l * 32 * 2048; P.lists = (const int*)(F.ws + WS_LISTS);
            P.act = (unsigned char*)(F.ws + WS_ACT); P.CTL = F.CTL; P.G = F.G; P.c = F.vcu; gk::run<Moe1Prob, true>(F.lds, P, (DUPN(9) == 2 && rep_ == 0) ? XMODE : 0);
        REPBAR(9); } SEAM(pb + 7);
        if (PHON(10) && IN(pb + 8)) REP(10) {
            REFRESH();
            moe_tables(F, F.ctl + CW_CNT + 64 * l);
            Moe2Prob P; P.act = (const unsigned char*)(F.ws + WS_ACT); P.w2t = (const unsigned char*)(F.ws + WS_W2T) + (size_t)l * 32 * 1024 * 1024; P.b2 = (const float*)karg(31) + (size_t)l * 32 * 1024; P.wslot = (const float*)(F.ws + WS_WSLOT);
            P.yk = F.ws + WS_YK; P.CTL = F.CTL; P.G = F.G; P.c = F.vcu; gk::run<Moe2Prob, true>(F.lds, P, (DUPN(10) == 2 && rep_ == 0) ? XMODE : 0);
        REPBAR(10); } SEAM(pb + 8);
        if (PHON(11) && IN(pb + 9)) REP(11) { REFRESH(); p11_combine(F, args, l); REPBAR(11); } SEAM(pb + 9);
    }
template <int BODY>
__global__ void __launch_bounds__(NTHR, 2) mk_fwd(Args args) {
    extern __shared__ __attribute__((aligned(16))) unsigned char lds_raw[];
    Frame F;
    F.lds = (LAS unsigned char*)lds_raw; F.CTL = (volatile LAS unsigned*)(F.lds + LDSCTL_OFF);
    F.G = gridDim.x; { const int bx = blockIdx.x; F.vcu = (F.G % 8 == 0) ? (bx % 8) * (F.G / 8) + bx / 8 : bx; }
    REFRESH();
    for (int u = F.tid; u < (LDS_BYTES - LDSCTL_OFF) / 4; u += NTHR) ((LAS unsigned*)(F.lds + LDSCTL_OFF))[u] = 0u;
    __syncthreads();
    XcdBarrier bar; bar.bar = F.ctl + CW_BAR; bar.x = 0; bar.st = F.CTL;
#if MK_ONE_LAUNCH
    bar = xcd_barrier_post(F.ctl + CW_BAR, F.CTL);
#endif
    const int lo = args.ph_lo, hi = args.ph_hi;
    if (PHON(0) && IN(0)) REP(0) { REFRESH(); p0_prologue(F, args); REPBAR(0); } SEAM(0);
    if (PHON(1) && IN(1)) REP(1) { REFRESH(); p1_norm1(F, args, 0, x_in); REFRESH(); s5_fill_m(F); REPBAR(1); } SEAM(1);
    layer_phases<BODY, 0>(F, args, lo, hi, bar);
    layer_phases<BODY, 1>(F, args, lo, hi, bar);
}
#undef IN
#undef SEAM
#undef x_in
#undef PROJ
#undef H
#undef YCAT

extern "C" void kernel_launch(void* const* d_in, const int* in_sizes, int n_in, void* d_out, int out_size, void* d_ws, size_t ws_size, hipStream_t stream) {
    static int grid = 0;
    if (grid == 0) {
        if (n_in != 32 || out_size != NT * DM || ws_size < WS_END) { fprintf(stderr, "kernel_launch: unexpected problem (n_in %d, out %d, ws %zu)\n", n_in, out_size, ws_size); grid = -1; return; }
        int dev = 0, cus = 0, per_cu = 0;
        if (hipGetDevice(&dev) != hipSuccess || hipDeviceGetAttribute(&cus, hipDeviceAttributeMultiprocessorCount, dev) != hipSuccess) { grid = -1; return; }
#if MK_ONE_LAUNCH
        const void* kfn[1] = {(const void*)mk_fwd<-1>};
#else
        const void* kfn[12] = {(const void*)mk_fwd<0>, (const void*)mk_fwd<1>, (const void*)mk_fwd<2>, (const void*)mk_fwd<3>, (const void*)mk_fwd<4>, (const void*)mk_fwd<5>, (const void*)mk_fwd<6>, (const void*)mk_fwd<7>,
                               (const void*)mk_fwd<8>, (const void*)mk_fwd<9>, (const void*)mk_fwd<10>, (const void*)mk_fwd<11>};
#endif
        for (const void* f : kfn) if (hipFuncSetAttribute(f, hipFuncAttributeMaxDynamicSharedMemorySize, LDS_BYTES) != hipSuccess) { fprintf(stderr, "kernel_launch: hipFuncSetAttribute failed\n"); grid = -1; return; }
        if (hipOccupancyMaxActiveBlocksPerMultiprocessor(&per_cu, kfn[0], NTHR, LDS_BYTES) != hipSuccess || per_cu < 1) fprintf(stderr, "kernel_launch: occupancy query says %d\n", per_cu);
        (void)hipGetLastError();
        grid = cus;
    }
    if (grid < 0) return;
    (void)hipMemsetAsync((char*)d_ws + WS_CTL, 0, CTL_BYTES, stream);
    Args a{};
    for (int i = 0; i < 32; ++i) a.in[i] = d_in[i];
    a.out = (float*)d_out; a.ws = (unsigned char*)d_ws;
#if MK_ONE_LAUNCH
    a.ph_lo = 0; a.ph_hi = NPH;
    hipLaunchKernelGGL(mk_fwd<-1>, dim3(grid), dim3(NTHR), LDS_BYTES, stream, a);
#else
    for (int p = 0; p < NPH; ++p) {
        a.ph_lo = p; a.ph_hi = p + 1;
        const int body = p < 2 ? p : 2 + (p - 2) % 10;
        switch (body) {
#define MK_CASE(n) case n: hipLaunchKernelGGL(mk_fwd<n>, dim3(grid), dim3(NTHR), LDS_BYTES, stream, a); break;
            MK_CASE(0) MK_CASE(1) MK_CASE(2) MK_CASE(3) MK_CASE(4) MK_CASE(5) MK_CASE(6) MK_CASE(7) MK_CASE(8) MK_CASE(9) MK_CASE(10) MK_CASE(11)
#undef MK_CASE
        }
    }
#endif
}
```

```cpp
#include <hip/hip_runtime.h>
#include <cstdio>
#include <cstdint>
#include <cmath>

#ifndef MK_ONE_LAUNCH
#define MK_ONE_LAUNCH 1
#endif

#define GAS __attribute__((address_space(1)))
#define LAS __attribute__((address_space(3)))
typedef unsigned short bf16;
typedef short bf16x8 __attribute__((ext_vector_type(8)));
typedef short s16x4 __attribute__((ext_vector_type(4)));
typedef float f32x2 __attribute__((ext_vector_type(2)));
typedef float f32x4 __attribute__((ext_vector_type(4)));
typedef float f32x16 __attribute__((ext_vector_type(16)));
typedef unsigned u32x2 __attribute__((ext_vector_type(2)));
typedef unsigned u32x4 __attribute__((ext_vector_type(4)));

constexpr int NB = 8, SEQ = 4096, DM = 1024, NT = NB * SEQ, DEPTH = 2;
constexpr int NPROJ = 3328, INCOLS = 3332;
constexpr int C_FQ = 0, C_FK = 256, C_FV = 512, C_HQ = 768, C_HF = 1280, C_HI = 1792, C_HG = 2048, C_DQ = 2304, C_DK = 2560, C_DV = 2816, C_SU = 3072;
constexpr int NEXP = 32, TOPK = 4;
constexpr float EPS = 1e-6f;
constexpr float LOG2E = 1.4426950408889634f;
constexpr int NWAVES = 8, NTHR = 512;
constexpr int S5L = 32, S5ROWS = NT / S5L;
constexpr int HGC = 64, HGUNITS = NB * 4 * (SEQ / HGC);

constexpr size_t MiB = 1u << 20;
constexpr size_t WS_CTL = 0, CTL_BYTES = 1 * MiB;
constexpr size_t WS_WIN = 2 * MiB;
constexpr size_t WS_WOUT = 16 * MiB;
constexpr size_t WS_GLU = 20 * MiB;
constexpr size_t WS_MOD = 21 * MiB;
constexpr size_t WS_KTAU = 22 * MiB;
constexpr size_t WS_LOGF = 23 * MiB;
constexpr size_t WS_FBIAS = 24 * MiB;
constexpr size_t WS_HDEC = 25 * MiB;
constexpr size_t WS_TOKPOS = 26 * MiB;
constexpr size_t WS_XIN = 27 * MiB;
constexpr size_t WS_XLOC = 32 * MiB;
constexpr size_t WS_LISTS = 40 * MiB;
constexpr size_t WS_WSLOT = 44 * MiB;
constexpr size_t WS_S5E = 48 * MiB;
constexpr size_t WS_S5F = 56 * MiB;
constexpr size_t WS_S5M = 64 * MiB;
constexpr size_t WS_YGELU = 96 * MiB;
constexpr size_t WS_H = 112 * MiB;
constexpr size_t WS_YCAT = 176 * MiB;
constexpr size_t WS_Y2 = 240 * MiB;
constexpr size_t WS_HST = 304 * MiB;
constexpr size_t WS_PROJ = 368 * MiB;
constexpr size_t WS_W1T = 576 * MiB;
constexpr size_t WS_W2T = 832 * MiB;
constexpr size_t WS_ACT = 960 * MiB;
constexpr size_t WS_YK = 1220 * MiB;
constexpr size_t WS_X1 = 1480 * MiB;
constexpr size_t WS_X2 = 1544 * MiB;
constexpr size_t WS_HST2 = 1608 * MiB;
constexpr size_t WS_H8 = 1672 * MiB;
constexpr size_t WS_KTAU4 = 1704 * MiB;
constexpr size_t WS_END = 1708 * MiB;
constexpr int CW_CNT_DUMMY = 1024;
constexpr int CW_BAR = 4096;
constexpr int CW_QKN = 768;
constexpr int CW_HGQ = 640;
constexpr int CW_CNT = 256;

constexpr int LDS_RING = 131072;
constexpr int LDSCTL_OFF = 139264;
constexpr int LDS_BYTES = 163840;
constexpr int LDS_STASH = LDSCTL_OFF + 4096;

__device__ __forceinline__ unsigned f2bf(float f) { unsigned u = __builtin_bit_cast(unsigned, f); return (u + 0x7fffu + ((u >> 16) & 1u)) >> 16; }
__device__ __forceinline__ unsigned pk2(float lo, float hi) { unsigned r; asm("v_cvt_pk_bf16_f32 %0, %1, %2" : "=v"(r) : "v"(lo), "v"(hi)); return r; }
__device__ __forceinline__ float bflo(unsigned w) { return __builtin_bit_cast(float, w << 16); }
__device__ __forceinline__ float bfhi(unsigned w) { return __builtin_bit_cast(float, w & 0xffff0000u); }
__device__ __forceinline__ float bf2f(bf16 v) { return __builtin_bit_cast(float, (unsigned)v << 16); }
#define DPP_F(old, v, ctrl, rm) __builtin_bit_cast(float, __builtin_amdgcn_update_dpp(__builtin_bit_cast(int, (float)(old)), __builtin_bit_cast(int, (float)(v)), (ctrl), (rm), 0xf, false))
__device__ __forceinline__ float wave_sum(float v) {
    v += DPP_F(0.f, v, 0xB1, 0xf);
    v += DPP_F(0.f, v, 0x4E, 0xf);
    v += DPP_F(0.f, v, 0x141, 0xf);
    v += DPP_F(0.f, v, 0x140, 0xf);
    v += DPP_F(0.f, v, 0x142, 0xa);
    v += DPP_F(0.f, v, 0x143, 0xc);
    return __builtin_bit_cast(float, __builtin_amdgcn_readlane(__builtin_bit_cast(int, v), 63));
}
__device__ __forceinline__ float wave_max(float v) {
    v = fmaxf(v, DPP_F(v, v, 0xB1, 0xf));
    v = fmaxf(v, DPP_F(v, v, 0x4E, 0xf));
    v = fmaxf(v, DPP_F(v, v, 0x141, 0xf));
    v = fmaxf(v, DPP_F(v, v, 0x140, 0xf));
    v = fmaxf(v, DPP_F(v, v, 0x142, 0xa));
    v = fmaxf(v, DPP_F(v, v, 0x143, 0xc));
    return __builtin_bit_cast(float, __builtin_amdgcn_readlane(__builtin_bit_cast(int, v), 63));
}
__device__ __forceinline__ float sigmoidf_(float x) { return __builtin_amdgcn_rcpf(1.0f + __expf(-x)); }
__device__ __forceinline__ float siluf_(float x) { return x * __builtin_amdgcn_rcpf(1.0f + __expf(-x)); }
__device__ __forceinline__ float gelu_tanh(float x) { const float u = 0.7978845608028654f * (x + 0.044715f * x * x * x); return x * __builtin_amdgcn_rcpf(1.0f + __expf(-2.0f * u)); }
__device__ __forceinline__ float clamp448(float x) { return __builtin_amdgcn_fmed3f(x, -448.0f, 448.0f); }
__device__ __forceinline__ unsigned pk4_fp8_nc(float a, float b, float c, float d) {
    int w = 0; w = __builtin_amdgcn_cvt_pk_fp8_f32(a, b, w, false); w = __builtin_amdgcn_cvt_pk_fp8_f32(c, d, w, true); return (unsigned)w; }
__device__ __forceinline__ unsigned pk4_fp8(float a, float b, float c, float d) {
    int w = 0; w = __builtin_amdgcn_cvt_pk_fp8_f32(clamp448(a), clamp448(b), w, false); w = __builtin_amdgcn_cvt_pk_fp8_f32(clamp448(c), clamp448(d), w, true); return (unsigned)w; }
constexpr float F8_SW = 256.0f, F8_SH = 16.0f, F8_SA = 4.0f, F8_SY = 64.0f;
#define LDS_WAIT() asm volatile("s_waitcnt lgkmcnt(0)" ::: "memory")
#define VM_WAIT() asm volatile("s_waitcnt vmcnt(0)" ::: "memory")

#define XB_TMO      128
#define XB_XCNT(j)  (256  + 64 * (j))
#define XB_XSUB(j)  (1280 + 64 * (j))
#define XB_XGEN(j)  (2304 + 64 * (j))
#define XB_TOP      3328
#define XB_TOPGEN   3392
#define XCD_BAR_WORDS 3456
#define XB_SPIN_CAP (1u << 18)
__device__ __forceinline__ unsigned xb_ld(unsigned* p)              { return __hip_atomic_load(p, __ATOMIC_RELAXED, __HIP_MEMORY_SCOPE_AGENT); }
__device__ __forceinline__ unsigned xb_add(unsigned* p, unsigned v) { return __hip_atomic_fetch_add(p, v, __ATOMIC_RELAXED, __HIP_MEMORY_SCOPE_AGENT); }
__device__ __forceinline__ unsigned xb_xcc_id() { return (unsigned)__builtin_amdgcn_s_getreg((3 << 11) | 20) & 0xFu; }
#define XB_SPIN(cond, bar) do { unsigned _sp = 0; while (cond) { __builtin_amdgcn_s_sleep(1); \
    if ((++_sp & 255u) == 0u) { if (xb_ld(&(bar)[XB_TMO])) break; if (_sp > XB_SPIN_CAP) { atomicAdd(&(bar)[XB_TMO], 1u); break; } } } } while (0)
struct XcdBarrier { unsigned* bar; unsigned x; volatile LAS unsigned* st; };
__device__ __forceinline__ XcdBarrier xcd_barrier_post(unsigned* bar, volatile LAS unsigned* st) {
    XcdBarrier b; b.bar = bar; b.x = xb_xcc_id(); b.st = st;
    if (threadIdx.x == 0) (void)xb_add(&bar[XB_XCNT(b.x)], 1u);
    return b;
}
__device__ __forceinline__ void xcd_barrier_complete(unsigned* bar, unsigned x, unsigned& nloc, unsigned& nx) {
    const unsigned G = gridDim.x * gridDim.y * gridDim.z;
    unsigned sum, cnt, mine, sp = 0u;
    for (;;) {
        sum = 0u; cnt = 0u; mine = 0u;
#pragma unroll
        for (unsigned j = 0; j < 16; ++j) { const unsigned c = xb_ld(&bar[XB_XCNT(j)]); sum += c; cnt += (c > 0u) ? 1u : 0u; mine = (j == x) ? c : mine; }
        if (sum == G) break;
        __builtin_amdgcn_s_sleep(1);
        if ((++sp & 255u) == 0u) { if (xb_ld(&bar[XB_TMO])) break; if (sp > XB_SPIN_CAP) { atomicAdd(&bar[XB_TMO], 1u); break; } }
    }
    nloc = mine > 0u ? mine : 1u; nx = cnt > 0u ? cnt : 1u;
}
__device__ __forceinline__ void xcd_barrier(const XcdBarrier& b) {
    asm volatile("s_waitcnt vmcnt(0)" ::: "memory");
    __syncthreads();
    if (threadIdx.x == 0) {
        unsigned* bar = b.bar;
        __builtin_amdgcn_s_waitcnt(0);
        unsigned nloc = b.st[0], nx = b.st[1];
        if (nloc == 0u) { xcd_barrier_complete(bar, b.x, nloc, nx); b.st[0] = nloc; b.st[1] = nx; }
        const unsigned old = xb_add(&bar[XB_XSUB(b.x)], 1u);
        const unsigned gen = old / nloc;
        if (old + 1u == (gen + 1u) * nloc) {
            __builtin_amdgcn_fence(__ATOMIC_RELEASE, "agent");
            asm volatile("s_waitcnt vmcnt(0)" ::: "memory");
            const unsigned og = xb_add(&bar[XB_TOP], 1u);
            const unsigned tg = og / nx;
            if (og + 1u == (tg + 1u) * nx) xb_add(&bar[XB_TOPGEN], 1u);
            else XB_SPIN(xb_ld(&bar[XB_TOPGEN]) == tg, bar);
            __builtin_amdgcn_fence(__ATOMIC_ACQUIRE, "agent");
            xb_add(&bar[XB_XGEN(b.x)], 1u);
            asm volatile("s_waitcnt vmcnt(0)" ::: "memory");
        } else {
            XB_SPIN(xb_ld(&bar[XB_XGEN(b.x)]) == gen, bar);
            __builtin_amdgcn_fence(__ATOMIC_ACQUIRE, "agent");
            asm volatile("s_waitcnt vmcnt(0)" ::: "memory");
        }
    }
    __syncthreads();
}

struct Args { const void* in[32]; float* out; unsigned char* ws; int ph_lo, ph_hi, pad0, pad1; };
struct Frame {
    LAS unsigned char* lds; volatile LAS unsigned* CTL; unsigned* ctl;
    int tid, lane, wave, vcu, G;
    unsigned char* ws;
};

__device__ __forceinline__ const void* karg(int k) { asm volatile("" : "+s"(k)); typedef const void* cvp_t; return ((const __attribute__((address_space(4))) cvp_t*)__builtin_amdgcn_kernarg_segment_ptr())[k]; }
#define REFRESH() do { F.ws = (unsigned char*)karg(33); int t_ = threadIdx.x; asm volatile("" : "+v"(t_)); F.tid = t_; F.lane = t_ & 63; F.wave = __builtin_amdgcn_readfirstlane(t_ >> 6); F.ctl = (unsigned*)(F.ws + WS_CTL); } while (0)

namespace gk {
constexpr int BM = 256, BK = 64, HALF = 128, HTB = HALF * BK * 2, STAGE_BYTES = 8 * HTB;
__host__ __device__ __forceinline__ int lds_byte(int r, int c) { const int st = (r >> 4) * 2 + (c >> 5), rr = r & 15, cc = c & 31, ob = rr * 64 + cc * 2; return st * 1024 + (ob ^ (((ob >> 9) & 1) << 5)); }
__host__ __device__ __forceinline__ void stage_rc(int b, int& R, int& C) { const int st = b / 1024, sb = b % 1024, swz = sb ^ (((sb >> 9) & 1) << 5); R = (st >> 1) * 16 + swz / 64; C = (st & 1) * 32 + (swz % 64) / 2; }
__host__ __device__ __forceinline__ int perm32(int rho) { const int n = rho >> 4, i = rho & 15; return 8 * (i >> 2) + 4 * n + (i & 3); }
struct Unit { int pm, pn, e, rows, nt, epi, rt, kind; };
typedef f32x4 Acc[2][2][4][2];
__device__ __forceinline__ unsigned cvt_pk_bf16(float lo, float hi) { unsigned r; asm volatile("v_cvt_pk_bf16_f32 %0, %1, %2" : "=v"(r) : "v"(lo), "v"(hi)); return r; }

template <int OFF> __device__ __forceinline__ void dma16(const char* sbase, unsigned voff, unsigned ldsbase) {
    asm volatile("s_add_u32 m0, %2, %3\n\ts_nop 0\n\tglobal_load_lds_dwordx4 %0, %1" :: "v"(voff), "s"(sbase), "s"(ldsbase), "i"(OFF) : "memory", "scc", "m0"); }
__device__ __forceinline__ void stage_coords(int tid, int i, int& R, int& C, int& Rb) { int t2 = tid; asm volatile("" : "+v"(t2)); stage_rc(t2 * 16 + i * 8192, R, C); Rb = (R & ~31) + perm32(R & 31); }
typedef int v4i_t __attribute__((ext_vector_type(4)));
typedef int v8i_t __attribute__((ext_vector_type(8)));
__device__ __forceinline__ v8i_t cat8(bf16x8 lo, bf16x8 hi) { const v4i_t a = __builtin_bit_cast(v4i_t, lo), b = __builtin_bit_cast(v4i_t, hi); return __builtin_shufflevector(a, b, 0, 1, 2, 3, 4, 5, 6, 7); }
template <class P, bool F8 = false>
__device__ __forceinline__ void run(LAS unsigned char* lds, const P& pr, const int xmode = 0) {
    int tid_ = threadIdx.x; asm volatile("" : "+v"(tid_));
    const int tid = tid_, wid = __builtin_amdgcn_readfirstlane(tid >> 6), lane = tid & 63, wr = wid >> 2, wc = wid & 3, fr = lane & 15, fq = lane >> 4;
    const unsigned ldsbw = (unsigned)(uintptr_t)lds + (unsigned)wid * 1024u;
    volatile LAS unsigned* stash = (volatile LAS unsigned*)(lds + LDS_STASH) + tid;
    const int aoff = lds_byte(wr * 64 + fr, fq * 8), boff = lds_byte(wc * 32 + fr, fq * 8);
#define GK_SA(b, h) (((b) * 2 + (h)) * HTB)
#define GK_SB(b, h) ((4 + (b) * 2 + (h)) * HTB)
#define GK_STAGE(bufoff, gbase, v0, v1) do { if (xmode != 3) { dma16<(bufoff)>((const char*)(gbase), (v0), ldsbw); dma16<(bufoff) + 8192>((const char*)(gbase), (v1), ldsbw); } } while (0)
#define GK_LDA(dst, b, h) do { if constexpr (F8) { _Pragma("unroll") for (int m = 0; m < 4; ++m) dst##8[m] = cat8(*(const LAS bf16x8*)(lds + GK_SA(b, h) + aoff + m * 2048), *(const LAS bf16x8*)(lds + GK_SA(b, h) + aoff + m * 2048 + 1024)); } \
        else { _Pragma("unroll") for (int m = 0; m < 4; ++m) _Pragma("unroll") for (int k = 0; k < 2; ++k) dst[m][k] = *(const LAS bf16x8*)(lds + GK_SA(b, h) + aoff + m * 2048 + k * 1024); } } while (0)
#define GK_LDB(dst, b, h) do { if constexpr (F8) { _Pragma("unroll") for (int n = 0; n < 2; ++n) dst##8[n] = cat8(*(const LAS bf16x8*)(lds + GK_SB(b, h) + boff + n * 2048), *(const LAS bf16x8*)(lds + GK_SB(b, h) + boff + n * 2048 + 1024)); } \
        else { _Pragma("unroll") for (int n = 0; n < 2; ++n) _Pragma("unroll") for (int k = 0; k < 2; ++k) dst[n][k] = *(const LAS bf16x8*)(lds + GK_SB(b, h) + boff + n * 2048 + k * 1024); } } while (0)
#define GK_MMA(ai, bj, At, Bt) do { if (xmode == 2) break; __builtin_amdgcn_s_setprio(1); \
        if constexpr (F8) { _Pragma("unroll") for (int m = 0; m < 4; ++m) _Pragma("unroll") for (int n = 0; n < 2; ++n) \
            asm volatile("v_mfma_f32_16x16x128_f8f6f4 %0, %1, %2, %0" : "+v"(acc[ai][bj][m][n]) : "v"(Bt##8[n]), "v"(At##8[m])); } \
        else { _Pragma("unroll") for (int m = 0; m < 4; ++m) _Pragma("unroll") for (int n = 0; n < 2; ++n) _Pragma("unroll") for (int k = 0; k < 2; ++k) \
            acc[ai][bj][m][n] = __builtin_amdgcn_mfma_f32_16x16x32_bf16(Bt[n][k], At[m][k], acc[ai][bj][m][n], 0, 0, 0); } \
        __builtin_amdgcn_s_setprio(0); } while (0)
#define GK_WAIT_V(n) asm volatile("s_waitcnt vmcnt(" #n ")" ::: "memory")
#define GK_WAIT_L(n) asm volatile("s_waitcnt lgkmcnt(" #n ")" ::: "memory")
#define GK_BAR __builtin_amdgcn_s_barrier()
#define GK_SCHED __builtin_amdgcn_sched_barrier(0)
#define GK_ZERO() do { _Pragma("unroll") for (int a = 0; a < 2; ++a) _Pragma("unroll") for (int b = 0; b < 2; ++b) _Pragma("unroll") for (int m = 0; m < 4; ++m) _Pragma("unroll") for (int n = 0; n < 2; ++n) acc[a][b][m][n] = (f32x4){0.f, 0.f, 0.f, 0.f}; } while (0)
    Unit cur, nxt; int ui = 0;
    if (!pr.next(0, cur)) return;
    Acc acc; GK_ZERO();
    bf16x8 At[4][2], B0[2][2], B1[2][2]; v8i_t At8[4], B08[2], B18[2];
    (void)At; (void)B0; (void)B1; (void)At8; (void)B08; (void)B18;
    const char *cA, *cB; unsigned cvA[2][2], cvB[2]; unsigned ckA, ckB, chB;
    pr.setupA(cur, tid, cA, cvA, ckA); pr.setupB(cur, tid, cB, cvB, ckB, chB);
    GK_STAGE(GK_SB(0, 0), cB, cvB[0], cvB[1]); GK_STAGE(GK_SB(0, 1), cB + chB, cvB[0], cvB[1]); GK_STAGE(GK_SA(0, 0), cA, cvA[0][0], cvA[0][1]); GK_STAGE(GK_SA(0, 1), cA, cvA[1][0], cvA[1][1]);
    if (wr == 1) GK_BAR;
    GK_WAIT_V(2); GK_BAR;
    GK_STAGE(GK_SB(1, 0), cB + ckB, cvB[0], cvB[1]); GK_STAGE(GK_SA(1, 0), cA + ckA, cvA[0][0], cvA[0][1]); GK_STAGE(GK_SB(1, 1), cB + chB + ckB, cvB[0], cvB[1]);
    GK_WAIT_V(6); GK_BAR;
    for (;;) {
        const bool has_next = pr.next(ui + 1, nxt);
        const char *nA = cA, *nB = cB; unsigned nkA = ckA, nkB = ckB, nhB = chB;
        {
            unsigned nvA[2][2] = {{cvA[0][0], cvA[0][1]}, {cvA[1][0], cvA[1][1]}}, nvB[2] = {cvB[0], cvB[1]};
            if (has_next) { pr.setupA(nxt, tid, nA, nvA, nkA); pr.setupB(nxt, tid, nB, nvB, nkB, nhB); }
            stash[0] = nvA[0][0]; stash[512] = nvA[0][1]; stash[1024] = nvA[1][0]; stash[1536] = nvA[1][1]; stash[2048] = nvB[0]; stash[2560] = nvB[1];
        }
        const int nt = cur.nt;
        for (int t = 0; t < nt; t += 2) {
            const bool last = (t == nt - 2);
            const char* a1 = cA + (size_t)((unsigned)(t + 1) * ckA);
            const char* a2 = last ? nA : cA + (size_t)((unsigned)(t + 2) * ckA); const char* b2 = last ? nB : cB + (size_t)((unsigned)(t + 2) * ckB);
            const unsigned k2A = last ? nkA : ckA, k2B = last ? nkB : ckB, h2B = last ? nhB : chB;
            const char* a3 = a2 + k2A; const char* b3 = b2 + k2B;
            unsigned wA00 = cvA[0][0], wA01 = cvA[0][1], wA10 = cvA[1][0], wA11 = cvA[1][1], wB0 = cvB[0], wB1 = cvB[1];
            if (last) { wA00 = stash[0]; wA01 = stash[512]; wA10 = stash[1024]; wA11 = stash[1536]; wB0 = stash[2048]; wB1 = stash[2560]; }
            GK_LDB(B0, 0, 0); GK_LDB(B1, 0, 1); GK_SCHED; GK_LDA(At, 0, 0); GK_STAGE(GK_SA(1, 1), a1, cvA[1][0], cvA[1][1]);
            GK_WAIT_V(8); GK_WAIT_L(0); GK_BAR; GK_MMA(0, 0, At, B0); GK_MMA(0, 1, At, B1); GK_BAR; GK_SCHED;
            GK_LDA(At, 0, 1); GK_STAGE(GK_SB(0, 0), b2, wB0, wB1); GK_STAGE(GK_SB(0, 1), b2 + h2B, wB0, wB1); GK_STAGE(GK_SA(0, 0), a2, wA00, wA01);
            GK_WAIT_V(8); GK_WAIT_L(0); GK_BAR; GK_MMA(1, 0, At, B0); GK_MMA(1, 1, At, B1); GK_BAR; GK_SCHED;
            GK_LDB(B0, 1, 0); GK_LDB(B1, 1, 1); GK_SCHED; GK_LDA(At, 1, 0); GK_STAGE(GK_SA(0, 1), a2, wA10, wA11);
            GK_WAIT_V(8); GK_WAIT_L(0); GK_BAR; GK_MMA(0, 0, At, B0); GK_MMA(0, 1, At, B1); GK_BAR; GK_SCHED;
            GK_LDA(At, 1, 1); GK_STAGE(GK_SB(1, 0), b3, wB0, wB1); GK_STAGE(GK_SB(1, 1), b3 + h2B, wB0, wB1); GK_STAGE(GK_SA(1, 0), a3, wA00, wA01);
            GK_WAIT_V(8); GK_WAIT_L(0); GK_BAR; GK_MMA(1, 0, At, B0); GK_MMA(1, 1, At, B1); GK_BAR; GK_SCHED;
        }
        if constexpr (F8) asm volatile("s_nop 15\n\ts_nop 15" ::: "memory");
        if (cur.epi) { if (wr == 0) GK_BAR; if (xmode != 1) pr.epi(acc, cur, wr, wc, fr, fq); }
        if (!has_next) break;
        if (cur.epi) GK_ZERO();
        const int had_epi = cur.epi;
        cur = nxt; cA = nA; cB = nB; ckA = nkA; ckB = nkB; chB = nhB;
        cvA[0][0] = stash[0]; cvA[0][1] = stash[512]; cvA[1][0] = stash[1024]; cvA[1][1] = stash[1536]; cvB[0] = stash[2048]; cvB[1] = stash[2560];
        ++ui;
        if (had_epi) { if (wr == 1) GK_BAR; }
    }
    GK_WAIT_V(0);
    if (!cur.epi) { if (wr == 0) GK_BAR; }
    GK_BAR;
}
}

__device__ __forceinline__ bool reg_order(int i, int G, int c, int nM, int nN, int& pm, int& pn) {
    const long L = (long)i * G + c; if (L >= (long)nM * nN) return false;
    const int nig = 8 * nN, gid = (int)(L / nig), r = (int)(L % nig); pm = gid * 8 + (r % 8); pn = r / 8; return true;
}
struct RegAB {
    const bf16* A; const bf16* Bt; int pitchA, pitchB;
    __device__ __forceinline__ void setupA(const gk::Unit& u, int tid, const char*& base, unsigned (&vo)[2][2], unsigned& kstep) const {
        base = (const char*)A + (size_t)u.pm * 256 * pitchA * 2; kstep = 128;
#pragma unroll
        for (int h = 0; h < 2; ++h)
#pragma unroll
            for (int i = 0; i < 2; ++i) { int R_, C_, Rb_; gk::stage_coords(tid, i, R_, C_, Rb_); (void)R_; (void)Rb_; vo[h][i] = (unsigned)((h * 128 + R_) * pitchA + C_) * 2u; }
    }
    __device__ __forceinline__ void setupB(const gk::Unit& u, int tid, const char*& base, unsigned (&vo)[2], unsigned& kstep, unsigned& hstep) const {
        base = (const char*)Bt + (size_t)u.pn * 256 * pitchB * 2; kstep = 128; hstep = 128u * pitchB * 2u;
#pragma unroll
        for (int i = 0; i < 2; ++i) { int R_, C_, Rb_; gk::stage_coords(tid, i, R_, C_, Rb_); (void)R_; (void)Rb_; vo[i] = (unsigned)(Rb_ * pitchB + C_) * 2u; }
    }
};

struct ProjProb {
    const unsigned char* A; const unsigned char* Bt; bf16* O; const int* pos; int G, c;
    __device__ __forceinline__ bool next(int i, gk::Unit& u) const { int n8 = 8; asm volatile("" : "+s"(n8)); u.nt = n8; u.epi = 1; u.e = 0; u.rows = 256; u.rt = 0; u.kind = 0; return reg_order(i, G, c, NT / 256, NPROJ / 256, u.pm, u.pn); }
    __device__ __forceinline__ void setupA(const gk::Unit& u, int tid, const char*& base, unsigned (&vo)[2][2], unsigned& kstep) const {
        base = (const char*)A + (size_t)u.pm * 256 * DM; kstep = 128;
#pragma unroll
        for (int h = 0; h < 2; ++h)
#pragma unroll
            for (int i = 0; i < 2; ++i) { int R_, C_, Rb_; gk::stage_coords(tid, i, R_, C_, Rb_); (void)Rb_; vo[h][i] = (unsigned)((h * 128 + R_) * DM + C_ * 2); }
    }
    __device__ __forceinline__ void setupB(const gk::Unit& u, int tid, const char*& base, unsigned (&vo)[2], unsigned& kstep, unsigned& hstep) const {
        base = (const char*)Bt + (size_t)u.pn * 256 * DM; kstep = 128; hstep = 128u * DM;
#pragma unroll
        for (int i = 0; i < 2; ++i) { int R_, C_, Rb_; gk::stage_coords(tid, i, R_, C_, Rb_); (void)R_; vo[i] = (unsigned)(Rb_ * DM + C_ * 2); }
    }
    __device__ __forceinline__ void epi(const gk::Acc& acc, const gk::Unit& u, int wr, int wc, int fr, int fq) const {
        int row0 = u.pm * 256 + wr * 64 + fr, col0 = u.pn * 256 + wc * 32 + 8 * fq; asm volatile("" : "+v"(row0), "+v"(col0));
        const bool rope = (u.pn == 9 || u.pn == 10) && (fq == 0);
        const float sc = ((u.pn == 0) ? 0.125f * LOG2E : ((u.pn == 9) ? 0.17677669529663687f * LOG2E : 1.0f)) * (1.0f / (F8_SW * F8_SH));
#pragma unroll
        for (int ai = 0; ai < 2; ++ai)
#pragma unroll
            for (int m = 0; m < 4; ++m) {
                const int row = row0 + ai * 128 + m * 16;
                float cs[4], sn[4];
                if (u.pn == 9 || u.pn == 10) {
                    const float p = (float)pos[row];
#pragma unroll
                    for (int j = 0; j < 4; ++j) { const float inv = (j == 0) ? 1.0f : (j == 1 ? 0.03760603093086394f : (j == 2 ? 0.0014142135623730951f : 5.318295896944989e-05f)); sincosf(p * inv, &sn[j], &cs[j]); }
                }
                bf16* rowp = O + (size_t)row * NPROJ + col0;
#pragma unroll
                for (int bj = 0; bj < 2; ++bj) {
                    f32x4 v0 = acc[ai][bj][m][0], v1 = acc[ai][bj][m][1];
                    if (rope) {
#pragma unroll
                        for (int j = 0; j < 4; ++j) { const float x1 = v0[j], x2 = v1[j]; v0[j] = x1 * cs[j] - x2 * sn[j]; v1[j] = x2 * cs[j] + x1 * sn[j]; }
                    }
                    v0 = v0 * sc; v1 = v1 * sc;
                    u32x4 w; w.x = gk::cvt_pk_bf16(v0[0], v0[1]); w.y = gk::cvt_pk_bf16(v0[2], v0[3]); w.z = gk::cvt_pk_bf16(v1[0], v1[1]); w.w = gk::cvt_pk_bf16(v1[2], v1[3]);
                    *(u32x4*)(rowp + bj * 128) = w;
                }
            }
    }
};
struct PlainProb : RegAB {
    bf16* O; int ldc, nM, nN, G, c;
    __device__ __forceinline__ bool next(int i, gk::Unit& u) const { u.nt = pitchA / 64; u.epi = 1; u.e = 0; u.rows = 256; u.rt = 0; u.kind = 0; return reg_order(i, G, c, nM, nN, u.pm, u.pn); }
    __device__ __forceinline__ void epi(const gk::Acc& acc, const gk::Unit& u, int wr, int wc, int fr, int fq) const {
        int row0 = u.pm * 256 + wr * 64 + fr, col0 = u.pn * 256 + wc * 32 + 8 * fq; asm volatile("" : "+v"(row0), "+v"(col0));
#pragma unroll
        for (int ai = 0; ai < 2; ++ai)
#pragma unroll
            for (int m = 0; m < 4; ++m) {
                bf16* rowp = O + (size_t)(row0 + ai * 128 + m * 16) * ldc + col0;
#pragma unroll
                for (int bj = 0; bj < 2; ++bj) {
                    const f32x4 v0 = acc[ai][bj][m][0], v1 = acc[ai][bj][m][1];
                    u32x4 w; w.x = gk::cvt_pk_bf16(v0[0], v0[1]); w.y = gk::cvt_pk_bf16(v0[2], v0[3]); w.z = gk::cvt_pk_bf16(v1[0], v1[1]); w.w = gk::cvt_pk_bf16(v1[2], v1[3]);
                    *(u32x4*)(rowp + bj * 128) = w;
                }
            }
    }
};
struct GluProb : RegAB {
    bf16* O; int G, c;
    __device__ __forceinline__ bool next(int i, gk::Unit& u) const { int n4 = 4; asm volatile("" : "+s"(n4)); u.nt = n4; u.epi = 1; u.e = 0; u.rows = 256; u.rt = 0; u.kind = 0; return reg_order(i, G, c, NT / 256, 2, u.pm, u.pn); }
    __device__ __forceinline__ void epi(const gk::Acc& acc, const gk::Unit& u, int wr, int wc, int fr, int fq) const {
        int row0 = u.pm * 256 + wr * 64 + fr, col0 = u.pn * 256 + wc * 32 + 8 * fq; asm volatile("" : "+v"(row0), "+v"(col0));
#pragma unroll
        for (int ai = 0; ai < 2; ++ai)
#pragma unroll
            for (int m = 0; m < 4; ++m) {
                bf16* rowp = O + (size_t)(row0 + ai * 128 + m * 16) * DM + 768 + (col0 >> 1);
#pragma unroll
                for (int bj = 0; bj < 2; ++bj) {
                    const f32x4 v0 = acc[ai][bj][m][0], v1 = acc[ai][bj][m][1];
                    u32x2 w; w.x = pk2(v0[0] * sigmoidf_(v0[1]), v0[2] * sigmoidf_(v0[3])); w.y = pk2(v1[0] * sigmoidf_(v1[1]), v1[2] * sigmoidf_(v1[3]));
                    *(u32x2*)(rowp + bj * 64) = w;
                }
                __builtin_amdgcn_sched_barrier(0);
            }
    }
};
__device__ __forceinline__ void s5_setupA(const bf16* proj, int pair, int pm, int tid, const char*& base, unsigned (&vo)[2][2], unsigned& kstep) {
    base = (const char*)proj + ((size_t)pm * 256 * S5L * NPROJ + C_SU + pair * 32) * 2; kstep = 2u * NPROJ * 2u;
#pragma unroll
    for (int h = 0; h < 2; ++h)
#pragma unroll
        for (int i = 0; i < 2; ++i) { int R_, C_, Rb_; gk::stage_coords(tid, i, R_, C_, Rb_); (void)R_; (void)Rb_; vo[h][i] = (unsigned)(((h * 128 + R_) * S5L + (C_ >> 5)) * NPROJ + (C_ & 31)) * 2u; }
}
struct S5EProb {
    const bf16* proj; const bf16* Ebt; float* xloc; int G, c;
    __device__ __forceinline__ bool next(int i, gk::Unit& u) const { const int L = i * G + c; if (L >= 32) return false; u.e = L >> 2; u.pm = L & 3; u.pn = 0; u.nt = 16; u.epi = 1; u.rows = 256; u.rt = 0; u.kind = 0; return true; }
    __device__ __forceinline__ void setupA(const gk::Unit& u, int tid, const char*& base, unsigned (&vo)[2][2], unsigned& kstep) const { s5_setupA(proj, u.e, u.pm, tid, base, vo, kstep); }
    __device__ __forceinline__ void setupB(const gk::Unit& u, int tid, const char*& base, unsigned (&vo)[2], unsigned& kstep, unsigned& hstep) const {
        base = (const char*)Ebt + (size_t)u.e * 256 * 1024 * 2; kstep = 128; hstep = 128u * 1024u * 2u;
#pragma unroll
        for (int i = 0; i < 2; ++i) { int R_, C_, Rb_; gk::stage_coords(tid, i, R_, C_, Rb_); (void)R_; (void)Rb_; vo[i] = (unsigned)(Rb_ * 1024 + C_) * 2u; }
    }
    __device__ __forceinline__ void epi(const gk::Acc& acc, const gk::Unit& u, int wr, int wc, int fr, int fq) const {
        int row0 = u.pm * 256 + wr * 64 + fr, col0 = wc * 32 + 8 * fq; asm volatile("" : "+v"(row0), "+v"(col0));
#pragma unroll
        for (int ai = 0; ai < 2; ++ai)
#pragma unroll
            for (int m = 0; m < 4; ++m) {
                float* rowp = xloc + (size_t)(row0 + ai * 128 + m * 16) * 2048 + u.e * 256 + col0;
#pragma unroll
                for (int bj = 0; bj < 2; ++bj) { *(f32x4*)(rowp + bj * 128) = acc[ai][bj][m][0]; *(f32x4*)(rowp + bj * 128 + 4) = acc[ai][bj][m][1]; }
            }
    }
};
struct S5FMProb {
    const bf16* proj; const bf16* xin; const bf16* Fbt; const bf16* Mbt; bf16* ygelu; int G, c;
    __device__ __forceinline__ bool next(int i, gk::Unit& u) const {
        const int L = (i >> 1) * G + c; if (L >= 128) return false;
        u.e = L >> 4; u.pm = (L >> 2) & 3; u.pn = L & 3; u.kind = i & 1; u.epi = u.kind; u.nt = u.kind ? 4 * (u.pn + 1) : 4; u.rows = 256; u.rt = 0; return true;
    }
    __device__ __forceinline__ void setupA(const gk::Unit& u, int tid, const char*& base, unsigned (&vo)[2][2], unsigned& kstep) const {
        if (u.kind) { s5_setupA(proj, u.e, u.pm, tid, base, vo, kstep); }
        else { base = (const char*)xin + ((size_t)u.pm * 256 * 2048 + u.e * 256) * 2; kstep = 128;
#pragma unroll
            for (int h = 0; h < 2; ++h)
#pragma unroll
                for (int i = 0; i < 2; ++i) { int R_, C_, Rb_; gk::stage_coords(tid, i, R_, C_, Rb_); (void)R_; (void)Rb_; vo[h][i] = (unsigned)((h * 128 + R_) * 2048 + C_) * 2u; } }
    }
    __device__ __forceinline__ void setupB(const gk::Unit& u, int tid, const char*& base, unsigned (&vo)[2], unsigned& kstep, unsigned& hstep) const {
        const int pitch = u.kind ? 1024 : 256;
        base = (const char*)(u.kind ? Mbt : Fbt) + ((size_t)u.e * 1024 + u.pn * 256) * pitch * 2; kstep = 128; hstep = 128u * pitch * 2u;
#pragma unroll
        for (int i = 0; i < 2; ++i) { int R_, C_, Rb_; gk::stage_coords(tid, i, R_, C_, Rb_); (void)R_; (void)Rb_; vo[i] = (unsigned)(Rb_ * pitch + C_) * 2u; }
    }
    __device__ __forceinline__ void epi(const gk::Acc& acc, const gk::Unit& u, int wr, int wc, int fr, int fq) const {
        int row0 = u.pm * 256 + wr * 64 + fr; asm volatile("" : "+v"(row0));
#pragma unroll
        for (int bj = 0; bj < 2; ++bj) {
            const int ncol = u.pn * 256 + bj * 128 + wc * 32 + 8 * fq, t = ncol >> 5, c32 = ncol & 31;
#pragma unroll
            for (int ai = 0; ai < 2; ++ai)
#pragma unroll
                for (int m = 0; m < 4; ++m) {
                    const int row = row0 + ai * 128 + m * 16;
                    const f32x4 v0 = acc[ai][bj][m][0], v1 = acc[ai][bj][m][1];
                    u32x4 w; w.x = pk2(gelu_tanh(v0[0]), gelu_tanh(v0[1])); w.y = pk2(gelu_tanh(v0[2]), gelu_tanh(v0[3])); w.z = pk2(gelu_tanh(v1[0]), gelu_tanh(v1[1])); w.w = pk2(gelu_tanh(v1[2]), gelu_tanh(v1[3]));
                    *(u32x4*)(ygelu + ((size_t)row * S5L + t) * 256 + u.e * 32 + c32) = w;
                    __builtin_amdgcn_sched_barrier(0);
                }
        }
    }
};
__device__ __forceinline__ void moe_tables(Frame& F, const unsigned* cnt) {
    if (F.wave == 0) {
        const int c = (F.lane < 32) ? (int)__hip_atomic_load(cnt + F.lane, __ATOMIC_RELAXED, __HIP_MEMORY_SCOPE_AGENT) : 0;
        const int tl = (c + 255) >> 8;
        int ps = c, pt = tl;
#pragma unroll
        for (int o = 1; o < 32; o <<= 1) { const int a = __shfl_up(ps, o), b = __shfl_up(pt, o); if (F.lane >= o) { ps += a; pt += b; } }
        if (F.lane < 32) { F.CTL[16 + F.lane + 1] = (unsigned)pt; F.CTL[64 + F.lane + 1] = (unsigned)ps; F.CTL[128 + F.lane] = (unsigned)c; }
        if (F.lane == 0) { F.CTL[16] = 0u; F.CTL[64] = 0u; }
    }
    __syncthreads();
}
__device__ __forceinline__ bool moe_next(volatile LAS unsigned* CTL, int i, int G, int c, int nct, gk::Unit& u) {
    const int L = i * G + c, tl = L / nct; u.pn = L % nct;
    if (tl >= (int)CTL[16 + 32]) return false;
    int e = 0;
#pragma unroll
    for (int st = 16; st >= 1; st >>= 1) if ((int)CTL[16 + e + st] <= tl) e += st;
    e = __builtin_amdgcn_readfirstlane(e);
    u.e = e; u.rt = tl - (int)CTL[16 + e]; u.rows = (int)CTL[128 + e] - 256 * u.rt; if (u.rows > 256) u.rows = 256;
    u.pm = (int)CTL[64 + e] + 256 * u.rt;
    u.nt = 16; u.epi = 1; u.kind = 0; return true;
}
struct Moe1Prob {
    const unsigned char* h8; const unsigned char* w1t; const float* b1; const int* lists; unsigned char* act; volatile LAS unsigned* CTL; int G, c;
    __device__ __forceinline__ bool next(int i, gk::Unit& u) const { const bool ok = moe_next(CTL, i, G, c, 8, u); int n8 = 8; asm volatile("" : "+s"(n8)); u.nt = n8; return ok; }
    __device__ __forceinline__ void setupA(const gk::Unit& u, int tid, const char*& base, unsigned (&vo)[2][2], unsigned& kstep) const {
        base = (const char*)h8; kstep = 128;
        const int* li = lists + (size_t)u.e * NT + 256 * u.rt;
#pragma unroll
        for (int h = 0; h < 2; ++h)
#pragma unroll
            for (int i = 0; i < 2; ++i) { int R_, C_, Rb_; gk::stage_coords(tid, i, R_, C_, Rb_); (void)Rb_; const int r = h * 128 + R_; const int tk = li[r < u.rows ? r : 0]; vo[h][i] = (unsigned)((tk >> 2) * DM + C_ * 2); }
    }
    __device__ __forceinline__ void setupB(const gk::Unit& u, int tid, const char*& base, unsigned (&vo)[2], unsigned& kstep, unsigned& hstep) const {
        base = (const char*)w1t + ((size_t)u.e * 2048 + u.pn * 256) * 1024; kstep = 128; hstep = 128u * 1024u;
#pragma unroll
        for (int i = 0; i < 2; ++i) { int R_, C_, Rb_; gk::stage_coords(tid, i, R_, C_, Rb_); (void)R_; vo[i] = (unsigned)(Rb_ * 1024 + C_ * 2); }
    }
    __device__ __forceinline__ void epi(const gk::Acc& acc, const gk::Unit& u, int wr, int wc, int fr, int fq) const {
        int r0 = wr * 64 + fr, col0 = u.pn * 256 + wc * 32 + 8 * fq; asm volatile("" : "+v"(r0), "+v"(col0));
        constexpr float US = 1.0f / (F8_SW * F8_SH);
        f32x4 bv[2][2];
#pragma unroll
        for (int bj = 0; bj < 2; ++bj)
#pragma unroll
            for (int n = 0; n < 2; ++n) bv[bj][n] = *(const f32x4*)(b1 + (size_t)u.e * 2048 + col0 + bj * 128 + 4 * n);
#pragma unroll
        for (int ai = 0; ai < 2; ++ai)
#pragma unroll
            for (int m = 0; m < 4; ++m) {
                const int r = r0 + ai * 128 + m * 16;
                if (r < u.rows) {
                    unsigned char* rowp = act + (size_t)(u.pm + r) * DM + (col0 >> 1);
#pragma unroll
                    for (int bj = 0; bj < 2; ++bj) {
                        const f32x4 v0 = acc[ai][bj][m][0] * US + bv[bj][0], v1 = acc[ai][bj][m][1] * US + bv[bj][1];
                        float o[4];
#pragma unroll
                        for (int j = 0; j < 4; ++j) { const float gl = fminf(j < 2 ? v0[2 * j] : v1[2 * j - 4], 7.0f); float ln = j < 2 ? v0[2 * j + 1] : v1[2 * j - 3]; ln = fminf(fmaxf(ln, -7.0f), 7.0f);
                            o[j] = gl * __builtin_amdgcn_rcpf(1.0f + __expf(-1.702f * gl)) * (ln + 1.0f) * F8_SA; }
                        *(unsigned*)(rowp + bj * 64) = pk4_fp8_nc(o[0], o[1], o[2], o[3]);
                    }
                }
                __builtin_amdgcn_sched_barrier(0);
            }
    }
};
struct Moe2Prob {
    const unsigned char* act; const unsigned char* w2t; const float* b2; const float* wslot; unsigned char* yk; volatile LAS unsigned* CTL; int G, c;
    __device__ __forceinline__ bool next(int i, gk::Unit& u) const { const bool ok = moe_next(CTL, i, G, c, 4, u); int n8 = 8; asm volatile("" : "+s"(n8)); u.nt = n8; return ok; }
    __device__ __forceinline__ void setupA(const gk::Unit& u, int tid, const char*& base, unsigned (&vo)[2][2], unsigned& kstep) const {
        base = (const char*)act + (size_t)u.pm * DM; kstep = 128;
#pragma unroll
        for (int h = 0; h < 2; ++h)
#pragma unroll
            for (int i = 0; i < 2; ++i) { int R_, C_, Rb_; gk::stage_coords(tid, i, R_, C_, Rb_); (void)Rb_; vo[h][i] = (unsigned)((h * 128 + R_) * DM + C_ * 2); }
    }
    __device__ __forceinline__ void setupB(const gk::Unit& u, int tid, const char*& base, unsigned (&vo)[2], unsigned& kstep, unsigned& hstep) const {
        base = (const char*)w2t + ((size_t)u.e * 1024 + u.pn * 256) * 1024; kstep = 128; hstep = 128u * 1024u;
#pragma unroll
        for (int i = 0; i < 2; ++i) { int R_, C_, Rb_; gk::stage_coords(tid, i, R_, C_, Rb_); (void)R_; vo[i] = (unsigned)(Rb_ * 1024 + C_ * 2); }
    }
    __device__ __forceinline__ void epi(const gk::Acc& acc, const gk::Unit& u, int wr, int wc, int fr, int fq) const {
        int r0 = wr * 64 + fr, col0 = u.pn * 256 + wc * 32 + 8 * fq; asm volatile("" : "+v"(r0), "+v"(col0));
        constexpr float US = 1.0f / (F8_SW * F8_SA);
        f32x4 bv[2][2];
#pragma unroll
        for (int bj = 0; bj < 2; ++bj)
#pragma unroll
            for (int n = 0; n < 2; ++n) bv[bj][n] = *(const f32x4*)(b2 + (size_t)u.e * 1024 + col0 + bj * 128 + 4 * n);
        float gwv[2][4];
#pragma unroll
        for (int ai = 0; ai < 2; ++ai)
#pragma unroll
            for (int m = 0; m < 4; ++m) { const int r = r0 + ai * 128 + m * 16; gwv[ai][m] = wslot[(size_t)u.e * NT + 256 * u.rt + (r < u.rows ? r : 0)]; }
#pragma unroll
        for (int ai = 0; ai < 2; ++ai)
#pragma unroll
            for (int m = 0; m < 4; ++m) {
                const int r = r0 + ai * 128 + m * 16;
                if (r < u.rows) {
                    const float gw = gwv[ai][m];
                    unsigned char* rowp = yk + (size_t)(u.pm + r) * DM + col0;
#pragma unroll
                    for (int bj = 0; bj < 2; ++bj) {
                        const f32x4 v0 = (acc[ai][bj][m][0] * US + bv[bj][0]) * (gw * F8_SY), v1 = (acc[ai][bj][m][1] * US + bv[bj][1]) * (gw * F8_SY);
                        *(u32x2*)(rowp + bj * 128) = (u32x2){pk4_fp8(v0[0], v0[1], v0[2], v0[3]), pk4_fp8(v1[0], v1[1], v1[2], v1[3])};
                    }
                }
            }
    }
};

namespace att {
__device__ __forceinline__ void glds16(const void* gsrc, unsigned lds_dst) {
    asm volatile("s_mov_b32 m0, %1\n\ts_nop 0\n\tglobal_load_lds_dwordx4 %0, off" :: "v"(gsrc), "s"(lds_dst) : "memory", "m0"); }
__device__ __forceinline__ void glds4(const void* gsrc, unsigned lds_dst) {
    asm volatile("s_mov_b32 m0, %1\n\ts_nop 0\n\tglobal_load_lds_dword %0, off" :: "v"(gsrc), "s"(lds_dst) : "memory", "m0"); }
typedef short v4i16_t __attribute__((ext_vector_type(4)));
__device__ __forceinline__ s16x4 vtr(const LAS char* p) { return __builtin_bit_cast(s16x4, __builtin_amdgcn_ds_read_tr16_b64_v4i16((LAS v4i16_t*)p)); }
__device__ __forceinline__ int crow(int r, int hi) { return (r & 3) + 8 * (r >> 2) + 4 * hi; }
__device__ __forceinline__ float swapmax(float m) { auto rr = __builtin_amdgcn_permlane32_swap(__float_as_uint(m), __float_as_uint(m), false, false); return fmaxf(__uint_as_float(rr[0]), __uint_as_float(rr[1])); }
__device__ __forceinline__ float swapadd(float m) { auto rr = __builtin_amdgcn_permlane32_swap(__float_as_uint(m), __float_as_uint(m), false, false); return __uint_as_float(rr[0]) + __uint_as_float(rr[1]); }
constexpr int SLOTB = 8192, LDS_K = 0, LDS_V = 3 * SLOTB, LDS_B = 6 * SLOTB;
__device__ __forceinline__ bf16x8 packp(const f32x16& p, int s) {
    u32x4 w; w.x = gk::cvt_pk_bf16(p[8 * s + 0], p[8 * s + 1]); w.y = gk::cvt_pk_bf16(p[8 * s + 2], p[8 * s + 3]); w.z = gk::cvt_pk_bf16(p[8 * s + 4], p[8 * s + 5]); w.w = gk::cvt_pk_bf16(p[8 * s + 6], p[8 * s + 7]);
    return __builtin_bit_cast(bf16x8, w);
}
__device__ __forceinline__ float softmax_step(f32x16& p0, f32x16& p1, float& m, float& l) {
    float rm = p0[0];
#pragma unroll
    for (int r = 1; r < 16; ++r) rm = fmaxf(rm, p0[r]);
#pragma unroll
    for (int r = 0; r < 16; ++r) rm = fmaxf(rm, p1[r]);
    rm = swapmax(rm);
    const float mn = fmaxf(m, rm), alpha = __builtin_amdgcn_exp2f(m - mn); m = mn;
    float s = 0.f;
#pragma unroll
    for (int r = 0; r < 16; ++r) { p0[r] = __builtin_amdgcn_exp2f(p0[r] - mn); s += p0[r]; }
#pragma unroll
    for (int r = 0; r < 16; ++r) { p1[r] = __builtin_amdgcn_exp2f(p1[r] - mn); s += p1[r]; }
    l = l * alpha + s;
    return alpha;
}
template <int THR>
__device__ __forceinline__ bool softmax_ref(f32x16& a0, f32x16& a1, f32x16& negm, float& ref, float& l, float& alpha, bool first) {
    float rm = a0[0];
#pragma unroll
    for (int r = 1; r < 16; ++r) rm = fmaxf(rm, a0[r]);
#pragma unroll
    for (int r = 0; r < 16; ++r) rm = fmaxf(rm, a1[r]);
    rm = swapmax(rm);
    bool resc = false; alpha = 1.0f;
    if (first || __any(rm > (float)THR)) {
        const float dl = first ? rm : fmaxf(rm, 0.0f);
        ref += dl; alpha = first ? 1.0f : __builtin_amdgcn_exp2f(-dl); l *= alpha; resc = !first;
#pragma unroll
        for (int r = 0; r < 16; ++r) { a0[r] -= dl; a1[r] -= dl; negm[r] = -ref; }
    }
    float s = 0.f;
#pragma unroll
    for (int r = 0; r < 16; ++r) { a0[r] = __builtin_amdgcn_exp2f(a0[r]); s += a0[r]; }
#pragma unroll
    for (int r = 0; r < 16; ++r) { a1[r] = __builtin_amdgcn_exp2f(a1[r]); s += a1[r]; }
    l += s;
    return resc;
}
template <int MODE>
__device__ __forceinline__ void unit(int b, int h, int qb, const bf16* proj, const float* fbias, const unsigned* qkn, bf16* ycat, float lam, float lam_init, const float* subln, LAS char* shm) {
    int tid_ = threadIdx.x; asm volatile("" : "+v"(tid_));
    const int tid = tid_, lane = tid & 63, r32 = lane & 31, hi = lane >> 5; const int wid = __builtin_amdgcn_readfirstlane(tid >> 6);
    constexpr int QC = MODE ? C_DQ : C_FQ, KC = MODE ? C_DK : C_FK, VC = MODE ? C_DV : C_FV, NDMA = MODE ? 2 : 3;
    const long rowbase = (long)b * SEQ; const int q0 = qb * 256;
    const bf16* Qw = proj + (rowbase + q0 + wid * 32) * NPROJ + QC + h * 64;
    const bf16* ksrc = proj + (rowbase + lane) * NPROJ + KC + h * 64 + wid * 8;
    const bf16* vsrc = proj + (rowbase + 16 * (wid & 3) + (lane >> 2)) * NPROJ + VC + h * 64 + (wid >> 2) * 32 + (lane & 3) * 8;
    const float* bsrc = fbias + (size_t)(b * 4 + h) * SEQ + lane;
    const unsigned lds0 = (unsigned)(uintptr_t)shm;
    const unsigned kdst = lds0 + LDS_K + wid * 1024, vdst = lds0 + LDS_V + wid * 1024, bdst = lds0 + LDS_B + wid * 768;
    const int NTL = (q0 + 256) / 64;
    bf16x8 qr[4];
#pragma unroll
    for (int d0 = 0; d0 < 4; ++d0) qr[d0] = *reinterpret_cast<const bf16x8*>(&Qw[(long)r32 * NPROJ + d0 * 16 + hi * 8]);
#define ATT_ISSUE(t, slot) do { glds16(ksrc + (long)(t) * 64 * NPROJ, (unsigned)__builtin_amdgcn_readfirstlane(kdst + (slot) * SLOTB)); \
        glds16(vsrc + (long)(t) * 64 * NPROJ, (unsigned)__builtin_amdgcn_readfirstlane(vdst + (slot) * SLOTB)); \
        if (MODE == 0) glds4(bsrc + (t) * 64, (unsigned)__builtin_amdgcn_readfirstlane(bdst + (slot) * 256)); } while (0)
    int T0 = 0;
    if (MODE == 0) {
        const float qn = __uint_as_float(__hip_atomic_load(qkn + (b * 4 + h) * 2, __ATOMIC_RELAXED, __HIP_MEMORY_SCOPE_AGENT)), kn = __uint_as_float(__hip_atomic_load(qkn + (b * 4 + h) * 2 + 1, __ATOMIC_RELAXED, __HIP_MEMORY_SCOPE_AGENT));
        const float* bb = fbias + (size_t)(b * 4 + h) * SEQ;
        const float thresh = bb[q0] - 64.0f - 2.0f * qn * kn;
        const float be = (lane < NTL) ? bb[64 * lane + 63] : INFINITY;
        const unsigned long long msk = __ballot(be >= thresh);
        T0 = __builtin_amdgcn_readfirstlane(__ffsll((long long)msk) - 1);
        if (T0 > NTL - 4) T0 = NTL - 4;
        if (T0 < 0) T0 = 0;
    }
    ATT_ISSUE(T0, 0); ATT_ISSUE(T0 + 1, 1);
    const LAS char* kp0 = shm + LDS_K + hi * 1024 + r32 * 16;
    const LAS char* vp0 = shm + LDS_V + ((lane >> 4) & 1) * 32 + (lane & 3) * 8 + (4 * hi + ((lane & 15) >> 2)) * 64;
    const LAS char* bp0 = shm + LDS_B + wid * 768 + hi * 16;
    float m1 = MODE ? 0.f : -1e30f, l1 = 0.f, m2 = MODE ? 0.f : -1e30f, l2 = 0.f;
    f32x16 o1[2], o2[2], ngA = f32x16{}, ngB = f32x16{};
    f32x16 o1_dummy; (void)o1_dummy;
    o1[0] = f32x16{}; o1[1] = f32x16{}; o2[0] = f32x16{}; o2[1] = f32x16{};
    const int qrel = wid * 32 + r32;
    int slot = 0;
    for (int t = T0; t < NTL; ++t) {
        if (t + 1 < NTL) { if (MODE == 0) asm volatile("s_waitcnt vmcnt(3)" ::: "memory"); else asm volatile("s_waitcnt vmcnt(2)" ::: "memory"); }
        else asm volatile("s_waitcnt vmcnt(0)" ::: "memory");
        __builtin_amdgcn_s_barrier();
        asm volatile("" ::: "memory");
        if (t + 2 < NTL) { const int s2 = (slot == 0) ? 2 : slot - 1; ATT_ISSUE(t + 2, s2); }
        const LAS char* kp = kp0 + slot * SLOTB; const LAS char* vp = vp0 + slot * SLOTB;
        const int jb = t - (NTL - 4);
        if (MODE == 0) {
            f32x16 p0, p1;
            const LAS char* bp = bp0 + slot * 256;
#pragma unroll
            for (int g = 0; g < 4; ++g) { const f32x4 a = *(const LAS f32x4*)(bp + g * 32), c = *(const LAS f32x4*)(bp + 128 + g * 32);
#pragma unroll
                for (int j = 0; j < 4; ++j) { p0[4 * g + j] = a[j]; p1[4 * g + j] = c[j]; } }
            bf16x8 kfr[4][2];
#pragma unroll
            for (int d0 = 0; d0 < 4; ++d0) { kfr[d0][0] = *(const LAS bf16x8*)(kp + d0 * 2048); kfr[d0][1] = *(const LAS bf16x8*)(kp + d0 * 2048 + 512); }
            __builtin_amdgcn_sched_barrier(0);
#pragma unroll
            for (int d0 = 0; d0 < 4; ++d0) { p0 = __builtin_amdgcn_mfma_f32_32x32x16_bf16(kfr[d0][0], qr[d0], p0, 0, 0, 0); p1 = __builtin_amdgcn_mfma_f32_32x32x16_bf16(kfr[d0][1], qr[d0], p1, 0, 0, 0); }
            if (jb >= 0) {
#pragma unroll
                for (int r = 0; r < 16; ++r) { const int kv = 64 * jb + crow(r, hi); if (kv > qrel) p0[r] = -INFINITY; if (kv + 32 > qrel) p1[r] = -INFINITY; }
            }
            bf16x8 vfr[4][2];
#pragma unroll
            for (int ks = 0; ks < 4; ++ks)
#pragma unroll
                for (int d0 = 0; d0 < 2; ++d0) { const s16x4 lo = vtr(vp + d0 * 4096 + ks * 1024), hh = vtr(vp + d0 * 4096 + ks * 1024 + 512); vfr[ks][d0] = (bf16x8){lo[0], lo[1], lo[2], lo[3], hh[0], hh[1], hh[2], hh[3]}; }
            __builtin_amdgcn_sched_barrier(0);
            const float al = softmax_step(p0, p1, m1, l1);
#pragma unroll
            for (int d = 0; d < 2; ++d)
#pragma unroll
                for (int r = 0; r < 16; ++r) o1[d][r] *= al;
#pragma unroll
            for (int ks = 0; ks < 4; ++ks) { const bf16x8 pf = (ks < 2) ? packp(p0, ks) : packp(p1, ks - 2);
#pragma unroll
                for (int d0 = 0; d0 < 2; ++d0) o1[d0] = __builtin_amdgcn_mfma_f32_32x32x16_bf16(vfr[ks][d0], pf, o1[d0], 0, 0, 0); }
        } else {
            f32x16 a0 = ngA, a1 = ngA, b0 = ngB, b1 = ngB;
            bf16x8 kfr[4][2];
#pragma unroll
            for (int d0 = 0; d0 < 4; ++d0) { kfr[d0][0] = *(const LAS bf16x8*)(kp + d0 * 2048); kfr[d0][1] = *(const LAS bf16x8*)(kp + d0 * 2048 + 512); }
            __builtin_amdgcn_sched_barrier(0);
#pragma unroll
            for (int d0 = 0; d0 < 2; ++d0) { a0 = __builtin_amdgcn_mfma_f32_32x32x16_bf16(kfr[d0][0], qr[d0], a0, 0, 0, 0); a1 = __builtin_amdgcn_mfma_f32_32x32x16_bf16(kfr[d0][1], qr[d0], a1, 0, 0, 0);
                b0 = __builtin_amdgcn_mfma_f32_32x32x16_bf16(kfr[d0 + 2][0], qr[d0 + 2], b0, 0, 0, 0); b1 = __builtin_amdgcn_mfma_f32_32x32x16_bf16(kfr[d0 + 2][1], qr[d0 + 2], b1, 0, 0, 0); }
            if (jb >= 0) {
#pragma unroll
                for (int r = 0; r < 16; ++r) { const int kv = 64 * jb + crow(r, hi); if (kv > qrel) { a0[r] = -INFINITY; b0[r] = -INFINITY; } if (kv + 32 > qrel) { a1[r] = -INFINITY; b1[r] = -INFINITY; } }
            }
            bf16x8 vfr[4][2];
#pragma unroll
            for (int ks = 0; ks < 4; ++ks)
#pragma unroll
                for (int d0 = 0; d0 < 2; ++d0) { const s16x4 lo = vtr(vp + d0 * 4096 + ks * 1024), hh = vtr(vp + d0 * 4096 + ks * 1024 + 512); vfr[ks][d0] = (bf16x8){lo[0], lo[1], lo[2], lo[3], hh[0], hh[1], hh[2], hh[3]}; }
            __builtin_amdgcn_sched_barrier(0);
            float al1, al2;
            const bool r1 = softmax_ref<8>(a0, a1, ngA, m1, l1, al1, t == T0), r2 = softmax_ref<8>(b0, b1, ngB, m2, l2, al2, t == T0);
            if (r1) {
#pragma unroll
                for (int d = 0; d < 2; ++d)
#pragma unroll
                    for (int r = 0; r < 16; ++r) o1[d][r] *= al1;
            }
            if (r2) {
#pragma unroll
                for (int d = 0; d < 2; ++d)
#pragma unroll
                    for (int r = 0; r < 16; ++r) o2[d][r] *= al2;
            }
#pragma unroll
            for (int ks = 0; ks < 4; ++ks) { const bf16x8 pa = (ks < 2) ? packp(a0, ks) : packp(a1, ks - 2), pb = (ks < 2) ? packp(b0, ks) : packp(b1, ks - 2);
#pragma unroll
                for (int d0 = 0; d0 < 2; ++d0) { o1[d0] = __builtin_amdgcn_mfma_f32_32x32x16_bf16(vfr[ks][d0], pa, o1[d0], 0, 0, 0); o2[d0] = __builtin_amdgcn_mfma_f32_32x32x16_bf16(vfr[ks][d0], pb, o2[d0], 0, 0, 0); } }
        }
        slot = (slot == 2) ? 0 : slot + 1;
    }
#undef ATT_ISSUE
    const float lt1 = swapadd(l1), inv1 = 1.0f / lt1;
    bf16* orow = ycat + (size_t)(rowbase + q0 + wid * 32 + r32) * DM + (MODE ? 512 : 0) + h * 64;
    if (MODE == 0) {
#pragma unroll
        for (int d0 = 0; d0 < 2; ++d0)
#pragma unroll
            for (int g = 0; g < 4; ++g) { u32x2 w; w.x = pk2(o1[d0][4 * g] * inv1, o1[d0][4 * g + 1] * inv1); w.y = pk2(o1[d0][4 * g + 2] * inv1, o1[d0][4 * g + 3] * inv1);
                *(u32x2*)(orow + d0 * 32 + 8 * g + 4 * hi) = w; }
    } else {
        const float lt2 = swapadd(l2), inv2 = lam / lt2;
        float ss = 0.f;
#pragma unroll
        for (int d0 = 0; d0 < 2; ++d0)
#pragma unroll
            for (int r = 0; r < 16; ++r) { const float y = o1[d0][r] * inv1 - o2[d0][r] * inv2; o1[d0][r] = y; ss += y * y; }
        ss = swapadd(ss);
        const float rs = rsqrtf(ss * (1.0f / 64.0f) + EPS) * (1.0f - lam_init);
#pragma unroll
        for (int d0 = 0; d0 < 2; ++d0)
#pragma unroll
            for (int g = 0; g < 4; ++g) { const f32x4 gg = *(const f32x4*)(subln + d0 * 32 + 8 * g + 4 * hi);
                u32x2 w; w.x = pk2(o1[d0][4 * g] * rs * gg[0], o1[d0][4 * g + 1] * rs * gg[1]); w.y = pk2(o1[d0][4 * g + 2] * rs * gg[2], o1[d0][4 * g + 3] * rs * gg[3]);
                *(u32x2*)(orow + d0 * 32 + 8 * g + 4 * hi) = w; }
    }
    asm volatile("s_waitcnt lgkmcnt(0)\n\ts_barrier" ::: "memory");
}
}

namespace hg {
constexpr int LD = 132, LDV = 68, LDB = 136;
constexpr int OFF_GA = 0, OFF_KT = 64 * LD * 4, OFF_QT = 2 * 64 * LD * 4, OFF_VV = 3 * 64 * LD * 4 + 1024, OFF_TOT = OFF_VV + 64 * LDV * 4, OFF_E31 = OFF_TOT + 2048, OFF_LB = OFF_E31 + 512, OFF_Q = OFF_LB + 2048;
__device__ __forceinline__ float rcp_(float x) { return __builtin_amdgcn_rcpf(x); }
struct Pre1 { u32x2 xf[4]; u32x4 v; };
struct Pre3 { u32x2 xf[4], xq[4]; u32x4 v, g; u32x4 si[2]; };
__device__ __forceinline__ void issue1(Pre1& P, const bf16* proj, int u, int tid) {
    const int c = u & 63, h = (u >> 6) & 3, b = u >> 8, t = tid >> 3, q = tid & 7; const bf16* r = proj + ((size_t)b * SEQ + c * 64 + t) * NPROJ;
#pragma unroll
    for (int cc = 0; cc < 4; ++cc) P.xf[cc] = *(const u32x2*)(r + C_HF + h * 128 + 32 * cc + 4 * q);
    P.v = *(const u32x4*)(r + C_HI + h * 64 + 8 * q);
}
__device__ __forceinline__ void issue3(Pre3& P, const bf16* proj, const bf16* hst, int u, int tid) {
    const int c = u & 63, h = (u >> 6) & 3, b = u >> 8, t = tid >> 3, q = tid & 7; const bf16* r = proj + ((size_t)b * SEQ + c * 64 + t) * NPROJ;
#pragma unroll
    for (int cc = 0; cc < 4; ++cc) { P.xf[cc] = *(const u32x2*)(r + C_HF + h * 128 + 32 * cc + 4 * q); P.xq[cc] = *(const u32x2*)(r + C_HQ + h * 128 + 32 * cc + 4 * q); }
    P.v = *(const u32x4*)(r + C_HI + h * 64 + 8 * q); P.g = *(const u32x4*)(r + C_HG + h * 64 + 8 * q);
#pragma unroll
    for (int j = 0; j < 2; ++j) P.si[j] = *(const u32x4*)(hst + (size_t)u * 8192 + (tid & 127) * 64 + (tid >> 7) * 16 + 8 * j);
}
__device__ __forceinline__ void common(LAS float* GA, LAS float* KT, LAS float* TOT, const LAS float* LB, const u32x2 (&xf)[4], int h, int tid) {
    { const int t = tid >> 3, q = tid & 7;
#pragma unroll
      for (int cc = 0; cc < 4; ++cc) { const int k = 32 * cc + 4 * q; const f32x4 lb = *(const LAS f32x4*)(LB + h * 128 + k);
          const float x[4] = {bflo(xf[cc].x), bfhi(xf[cc].x), bflo(xf[cc].y), bfhi(xf[cc].y)}; f32x4 g, om;
#pragma unroll
          for (int e = 0; e < 4; ++e) { const float ex = __expf(-fminf(fmaxf(x[e], -30.0f), 30.0f)); const float s = rcp_(1.0f + ex), s1 = ex * s;
              g[e] = __logf(lb[e] + (1.0f - lb[e]) * s); om[e] = (1.0f - lb[e]) * s1; }
          *(LAS f32x4*)(GA + t * LD + k) = g; *(LAS f32x4*)(KT + t * LD + k) = om; } }
    __syncthreads();
    const int kk = tid & 127, part = tid >> 7;
    float a[16]; float run = 0.f;
#pragma unroll
    for (int i = 0; i < 16; ++i) { run += GA[(16 * part + i) * LD + kk]; a[i] = run; }
    TOT[part * 128 + kk] = run;
    __syncthreads();
    float off = 0.f;
#pragma unroll
    for (int p = 0; p < 3; ++p) if (p < part) off += TOT[p * 128 + kk];
#pragma unroll
    for (int i = 0; i < 16; ++i) GA[(16 * part + i) * LD + kk] = a[i] + off;
    __syncthreads();
}
__device__ __forceinline__ void store_v(LAS float* VV, const u32x4 w, int tid) {
    const int t = tid >> 3, v0 = (tid & 7) * 8; LAS float* d = VV + t * LDV + v0;
    *(LAS f32x4*)d = (f32x4){bflo(w.x), bfhi(w.x), bflo(w.y), bfhi(w.y)}; *(LAS f32x4*)(d + 4) = (f32x4){bflo(w.z), bfhi(w.z), bflo(w.w), bfhi(w.w)};
}
__device__ __forceinline__ void lb_table(Frame& F, int l, const float* hgl) {
    LAS float* LB = (LAS float*)(F.lds + OFF_LB);
    LB[F.tid] = (l == 0) ? 0.0f : 1.0f / (1.0f + __expf(hgl[F.tid] - hgl[512 + F.tid]));
    __syncthreads();
}
__device__ __forceinline__ unsigned q_issue(Frame& F, unsigned* qc) { unsigned v = 0u; if (F.tid == 0) v = __hip_atomic_fetch_add(qc, 1u, __ATOMIC_RELAXED, __HIP_MEMORY_SCOPE_AGENT); return v; }
__device__ __forceinline__ void q_publish(Frame& F, unsigned v) { if (F.tid == 0) *(volatile LAS unsigned*)(F.lds + OFF_Q) = v; }
__device__ __forceinline__ int q_read(Frame& F) { return (int)*(volatile LAS unsigned*)(F.lds + OFF_Q); }
__device__ __forceinline__ void h1_phase(Frame& F, int l, const bf16* proj, const float* hgl, bf16* hst, float* hdec, unsigned* qc) {
    LAS float* SL = (LAS float*)(F.lds + OFF_QT);
    LAS float* GA = (LAS float*)(F.lds + OFF_GA); LAS float* KT = (LAS float*)(F.lds + OFF_KT); LAS float* VV = (LAS float*)(F.lds + OFF_VV); LAS float* TOT = (LAS float*)(F.lds + OFF_TOT);
    const LAS float* LB = (const LAS float*)(F.lds + OFF_LB);
    const int tid = F.tid;
    { const unsigned q0 = q_issue(F, qc); q_publish(F, q0); } lb_table(F, l, hgl);
    int u = q_read(F);
    __syncthreads();
    Pre1 P; if (u < HGUNITS) issue1(P, proj, u, tid);
    while (u < HGUNITS) {
        const int h = (u >> 6) & 3;
        const unsigned qv = q_issue(F, qc);
        common(GA, KT, TOT, LB, P.xf, h, tid);
        { const int t = tid >> 3, q = tid & 7;
#pragma unroll
          for (int cc = 0; cc < 4; ++cc) { const int k = 32 * cc + 4 * q; const f32x4 g31 = *(const LAS f32x4*)(GA + 31 * LD + k), gt = *(const LAS f32x4*)(GA + t * LD + k); f32x4 kt = *(const LAS f32x4*)(KT + t * LD + k);
#pragma unroll
              for (int e = 0; e < 4; ++e) kt[e] *= __expf(g31[e] - gt[e]);
              *(LAS f32x4*)(KT + t * LD + k) = kt; } }
        store_v(VV, P.v, tid);
        if (tid < 128) hdec[(size_t)u * 128 + tid] = __expf(GA[63 * LD + tid]);
        q_publish(F, qv);
        __syncthreads();
        const int un = q_read(F);
        if (un < HGUNITS) issue1(P, proj, un, tid);
        const int lane = F.lane, i = lane & 15, kk = lane >> 4, kb = 16 * F.wave;
#pragma unroll
        for (int vt = 0; vt < 4; ++vt) {
            f32x4 acc = (f32x4){0.f, 0.f, 0.f, 0.f};
#pragma unroll
            for (int s0 = 0; s0 < 64; s0 += 16)
#pragma unroll
                for (int m = 0; m < 4; ++m) { const int s = s0 + 4 * kk + m; acc = __builtin_amdgcn_mfma_f32_16x16x4f32(KT[s * LD + kb + i], VV[s * LDV + 16 * vt + i], acc, 0, 0, 0); }
#pragma unroll
            for (int r = 0; r < 4; ++r) { const int k = kb + 4 * kk + r; SL[k * LDV + 16 * vt + i] = acc[r] * __expf(GA[63 * LD + k] - GA[31 * LD + k]); }
        }
        __syncthreads();
        { const int k = tid >> 2, vq = (tid & 3) * 16; const LAS float* sp = SL + k * LDV + vq;
          const f32x4 a = *(const LAS f32x4*)sp, b = *(const LAS f32x4*)(sp + 4), c = *(const LAS f32x4*)(sp + 8), d = *(const LAS f32x4*)(sp + 12);
          bf16* dst = hst + (size_t)u * 8192 + k * 64 + vq;
          *(u32x4*)dst = (u32x4){pk2(a[0], a[1]), pk2(a[2], a[3]), pk2(b[0], b[1]), pk2(b[2], b[3])}; *(u32x4*)(dst + 8) = (u32x4){pk2(c[0], c[1]), pk2(c[2], c[3]), pk2(d[0], d[1]), pk2(d[2], d[3])}; }
        u = un;
    }
}
__device__ __forceinline__ void h3_phase(Frame& F, int l, const bf16* proj, const float* hgl, const bf16* hst, const float* normg, bf16* ycat, unsigned* qc) {
    LAS float* GA = (LAS float*)(F.lds + OFF_GA); LAS float* KT = (LAS float*)(F.lds + OFF_KT); LAS bf16* QTb = (LAS bf16*)(F.lds + OFF_QT); LAS bf16* KTb = QTb + 64 * LDB; LAS float* VV = (LAS float*)(F.lds + OFF_VV);
    LAS float* TOT = (LAS float*)(F.lds + OFF_TOT); LAS float* E31 = (LAS float*)(F.lds + OFF_E31); const LAS float* LB = (const LAS float*)(F.lds + OFF_LB);
    const int tid = F.tid;
    { const unsigned q0 = q_issue(F, qc); q_publish(F, q0); } lb_table(F, l, hgl);
    int u = q_read(F);
    __syncthreads();
    Pre3 P; if (u < HGUNITS) issue3(P, proj, hst, u, tid);
    while (u < HGUNITS) {
        const int c = u & 63, h = (u >> 6) & 3, b = u >> 8; const size_t row0 = (size_t)b * SEQ + c * 64;
        const unsigned qv = q_issue(F, qc);
        common(GA, KT, TOT, LB, P.xf, h, tid);
        { const int t = tid >> 3, q = tid & 7;
#pragma unroll
          for (int cc = 0; cc < 4; ++cc) { const int k = 32 * cc + 4 * q; const f32x4 g31 = *(const LAS f32x4*)(GA + 31 * LD + k), gt = *(const LAS f32x4*)(GA + t * LD + k); f32x4 kt = *(const LAS f32x4*)(KT + t * LD + k), qt;
              const float x[4] = {bflo(P.xq[cc].x), bfhi(P.xq[cc].x), bflo(P.xq[cc].y), bfhi(P.xq[cc].y)};
#pragma unroll
              for (int e = 0; e < 4; ++e) { const float d = gt[e] - g31[e], ed = __expf(d); qt[e] = x[e] * rcp_(1.0f + __expf(-x[e])) * ed; kt[e] *= rcp_(ed); }
              *(LAS u32x2*)(QTb + t * LDB + k) = (u32x2){pk2(qt[0], qt[1]), pk2(qt[2], qt[3])}; *(LAS u32x2*)(KTb + t * LDB + k) = (u32x2){pk2(kt[0], kt[1]), pk2(kt[2], kt[3])}; } }
        if (tid < 128) E31[tid] = __expf(GA[31 * LD + tid]);
        store_v(VV, P.v, tid);
        const u32x4 gate = P.g;
        __syncthreads();
        LAS bf16* SIt = (LAS bf16*)GA;
        { const int k = tid & 127, vb = (tid >> 7) * 16; const float sc = E31[k];
#pragma unroll
          for (int j = 0; j < 2; ++j) { const unsigned w4[4] = {P.si[j].x, P.si[j].y, P.si[j].z, P.si[j].w};
#pragma unroll
              for (int e = 0; e < 8; ++e) SIt[(vb + 8 * j + e) * LDB + k] = (bf16)f2bf(((e & 1) ? bfhi(w4[e >> 1]) : bflo(w4[e >> 1])) * sc); } }
        q_publish(F, qv);
        __syncthreads();
        const int un = q_read(F);
        if (un < HGUNITS) issue3(P, proj, hst, un, tid);
        const int lane = F.lane, i = lane & 15, kk = lane >> 4, w = F.wave, tt = (w < 4) ? w : 7 - w, vh = w >> 2;
        f32x4 o[2]; o[0] = (f32x4){0.f, 0.f, 0.f, 0.f}; o[1] = o[0];
        for (int j = 0; j <= tt; ++j) {
            f32x4 at = (f32x4){0.f, 0.f, 0.f, 0.f};
#pragma unroll
            for (int st = 0; st < 4; ++st) { const bf16x8 a8 = *(const LAS bf16x8*)(KTb + (16 * j + i) * LDB + 32 * st + 8 * kk), b8 = *(const LAS bf16x8*)(QTb + (16 * tt + i) * LDB + 32 * st + 8 * kk);
                at = __builtin_amdgcn_mfma_f32_16x16x32_bf16(a8, b8, at, 0, 0, 0); }
            if (j == tt) {
#pragma unroll
                for (int r = 0; r < 4; ++r) if (4 * kk + r > i) at[r] = 0.f;
            }
#pragma unroll
            for (int vt = 0; vt < 2; ++vt)
#pragma unroll
                for (int m = 0; m < 4; ++m) o[vt] = __builtin_amdgcn_mfma_f32_16x16x4f32(VV[(16 * j + 4 * kk + m) * LDV + 32 * vh + 16 * vt + i], at[m], o[vt], 0, 0, 0);
        }
#pragma unroll
        for (int st = 0; st < 4; ++st) { const bf16x8 b8 = *(const LAS bf16x8*)(QTb + (16 * tt + i) * LDB + 32 * st + 8 * kk);
#pragma unroll
            for (int vt = 0; vt < 2; ++vt) o[vt] = __builtin_amdgcn_mfma_f32_16x16x32_bf16(*(const LAS bf16x8*)(SIt + (32 * vh + 16 * vt + i) * LDB + 32 * st + 8 * kk), b8, o[vt], 0, 0, 0); }
        __syncthreads();
        LAS float* OUT = KT;
#pragma unroll
        for (int vt = 0; vt < 2; ++vt) *(LAS f32x4*)(OUT + (16 * tt + i) * LDV + 32 * vh + 16 * vt + 4 * kk) = o[vt];
        __syncthreads();
        { const int t = tid >> 3, v0 = (tid & 7) * 8;
          const f32x4 va = *(const LAS f32x4*)(OUT + t * LDV + v0), vb = *(const LAS f32x4*)(OUT + t * LDV + v0 + 4);
          const float vals[8] = {va[0], va[1], va[2], va[3], vb[0], vb[1], vb[2], vb[3]}; float ss = 0.f;
#pragma unroll
          for (int j = 0; j < 8; ++j) ss += vals[j] * vals[j];
          ss += __shfl_xor(ss, 1); ss += __shfl_xor(ss, 2); ss += __shfl_xor(ss, 4);
          const float rs = rsqrtf(ss * (1.0f / 64.0f) + EPS);
          const unsigned gww[4] = {gate.x, gate.y, gate.z, gate.w};
          float y[8];
#pragma unroll
          for (int j = 0; j < 8; ++j) { const float gx = (j & 1) ? bfhi(gww[j >> 1]) : bflo(gww[j >> 1]); y[j] = vals[j] * rs * normg[v0 + j] * gx * rcp_(1.0f + __expf(-gx)); }
          u32x4 wv; wv.x = pk2(y[0], y[1]); wv.y = pk2(y[2], y[3]); wv.z = pk2(y[4], y[5]); wv.w = pk2(y[6], y[7]);
          *(u32x4*)(ycat + (row0 + t) * DM + 256 + h * 64 + v0) = wv; }
        __syncthreads();
        u = un;
    }
}
}

struct S5P { const float *a_re, *a_im, *log_step, *b_re, *b_im, *c_re, *c_im, *d; };
__device__ __forceinline__ void s5_pow(const S5P& P, int g, int n, float p, float& pr, float& pi) {
    const float dt = __expf(P.log_step[g]); const float lr = fminf(P.a_re[g * 64 + n], -1e-4f), li = P.a_im[g * 64 + n];
    const float mag = expf(lr * dt * p); float s, c; sincosf(li * dt * p, &s, &c); pr = mag * c; pi = mag * s;
}
__device__ __forceinline__ void s5_z(const S5P& P, int g, int n, float& zr, float& zi) {
    const float dt = __expf(P.log_step[g]); const float lr = fminf(P.a_re[g * 64 + n], -1e-4f), li = P.a_im[g * 64 + n];
    const float mag = expf(lr * dt); float s, c; sincosf(li * dt, &s, &c); const float ar = mag * c, ai = mag * s, den = lr * lr + li * li;
    zr = ((ar - 1.0f) * lr + ai * li) / den; zi = (ai * lr - (ar - 1.0f) * li) / den;
}

__device__ __forceinline__ void transpose_tile(const float* W, int N, int K, int k0, int n0src, bf16* WT, int mode, int n0dst, LAS float* scr, int lane) {
#pragma unroll
    for (int i = 0; i < 16; ++i) { const int kk = 4 * i + (lane >> 4), nn = (lane & 15) * 4;
        const f32x4 v = *(const f32x4*)(W + (size_t)(k0 + kk) * N + n0src + nn);
        scr[kk * 65 + nn] = v[0]; scr[kk * 65 + nn + 1] = v[1]; scr[kk * 65 + nn + 2] = v[2]; scr[kk * 65 + nn + 3] = v[3]; }
    LDS_WAIT(); asm volatile("" ::: "memory");
    const int c = lane & 7;
#pragma unroll
    for (int p = 0; p < 8; ++p) { const int n = (lane >> 3) + 8 * p; const LAS float* s = scr + (8 * c) * 65 + n;
        u32x4 o; o.x = pk2(s[0], s[65]); o.y = pk2(s[2 * 65], s[3 * 65]); o.z = pk2(s[4 * 65], s[5 * 65]); o.w = pk2(s[6 * 65], s[7 * 65]);
        int drow = n0dst + n; if (mode == 2) { const int ns = n0src + n; drow = 2 * (ns & 255) + (ns >> 8); }
        *(u32x4*)(WT + (size_t)drow * K + k0 + 8 * c) = o; }
    LDS_WAIT(); asm volatile("" ::: "memory");
}
struct F8Item { const float* src; unsigned char* dst; int N; };
__device__ __forceinline__ void f8_item(Frame& F, int it, F8Item& I) {
    constexpr int I_W1 = 64 * 8 * 64, I_W2 = 64 * 8 * 32;
    int r = it;
    if (r < I_W1) { const int m = r / 512, q = r % 512, kb = q / 64, nb = q % 64; I.N = 2048; I.src = (const float*)karg(28) + (size_t)m * 1024 * 2048 + (size_t)(kb * 128) * 2048 + nb * 32; I.dst = F.ws + WS_W1T + (size_t)m * 2048 * 1024 + (size_t)(nb * 32) * 1024 + kb * 128; return; }
    r -= I_W1;
    if (r < I_W2) { const int m = r / 256, q = r % 256, kb = q / 32, nb = q % 32; I.N = 1024; I.src = (const float*)karg(30) + (size_t)m * 1024 * 1024 + (size_t)(kb * 128) * 1024 + nb * 32; I.dst = F.ws + WS_W2T + (size_t)m * 1024 * 1024 + (size_t)(nb * 32) * 1024 + kb * 128; return; }
    r -= I_W2;
    { const int m = r / 832, q = r % 832, kb = q / 104, nb = q % 104; const int nd = nb * 32, ns = nd < 768 ? nd : nd + 4; I.N = INCOLS;
      I.src = (const float*)karg(7) + (size_t)m * 1024 * INCOLS + (size_t)(kb * 128) * INCOLS + ns; I.dst = F.ws + WS_WIN + (size_t)m * NPROJ * 1024 + (size_t)nd * 1024 + kb * 128; }
}
__device__ __forceinline__ void f8_load(const F8Item& I, f32x4 (&tv)[16], int lane) {
#pragma unroll
    for (int i = 0; i < 16; ++i) { const int kk = 8 * i + (lane >> 3), nn = (lane & 7) * 4; tv[i] = __builtin_nontemporal_load((const f32x4*)(I.src + (size_t)kk * I.N + nn)); }
}
__device__ __forceinline__ void f8_store(const F8Item& I, const f32x4 (&tv)[16], LAS float* scr, int lane) {
#pragma unroll
    for (int i = 0; i < 16; ++i) { const int kk = 8 * i + (lane >> 3), nn = (lane & 7) * 4; *(LAS f32x2*)(scr + kk * 34 + nn) = (f32x2){tv[i][0], tv[i][1]}; *(LAS f32x2*)(scr + kk * 34 + nn + 2) = (f32x2){tv[i][2], tv[i][3]}; }
    LDS_WAIT(); asm volatile("" ::: "memory");
    const int n = lane & 31, kh = lane >> 5; const LAS float* s = scr + (64 * kh) * 34 + n;
#pragma unroll
    for (int c = 0; c < 4; ++c) { u32x4 o;
        o.x = pk4_fp8(s[(16 * c + 0) * 34] * F8_SW, s[(16 * c + 1) * 34] * F8_SW, s[(16 * c + 2) * 34] * F8_SW, s[(16 * c + 3) * 34] * F8_SW);
        o.y = pk4_fp8(s[(16 * c + 4) * 34] * F8_SW, s[(16 * c + 5) * 34] * F8_SW, s[(16 * c + 6) * 34] * F8_SW, s[(16 * c + 7) * 34] * F8_SW);
        o.z = pk4_fp8(s[(16 * c + 8) * 34] * F8_SW, s[(16 * c + 9) * 34] * F8_SW, s[(16 * c + 10) * 34] * F8_SW, s[(16 * c + 11) * 34] * F8_SW);
        o.w = pk4_fp8(s[(16 * c + 12) * 34] * F8_SW, s[(16 * c + 13) * 34] * F8_SW, s[(16 * c + 14) * 34] * F8_SW, s[(16 * c + 15) * 34] * F8_SW);
        *(u32x4*)(I.dst + (size_t)n * 1024 + 64 * kh + 16 * c) = o; }
    LDS_WAIT(); asm volatile("" ::: "memory");
}
__device__ __forceinline__ void p0_prologue(Frame& F, const Args& a) {
    LAS float* scr = (LAS float*)(F.lds + F.wave * 17408);
    const int gw = F.vcu * NWAVES + F.wave, NGW = F.G * NWAVES;
    const float* w_out = (const float*)karg(8); const float* glu = (const float*)karg(25);
    bf16* wout_t = (bf16*)(F.ws + WS_WOUT); bf16* glu_t = (bf16*)(F.ws + WS_GLU);
    { constexpr int NIT = 64 * 8 * 64 + 64 * 8 * 32 + 2 * 8 * 104;
      F8Item cur, nxt; f32x4 tv[16];
      int it = gw;
      if (it < NIT) { f8_item(F, it, cur); f8_load(cur, tv, F.lane); }
      while (it < NIT) {
          f32x4 tw[16];
#pragma unroll
          for (int i = 0; i < 16; ++i) tw[i] = tv[i];
          const int itn = it + NGW;
          if (itn < NIT) { f8_item(F, itn, nxt); f8_load(nxt, tv, F.lane); }
          f8_store(cur, tw, scr, F.lane);
          cur = nxt; it = itn;
      } }
    constexpr int I_WOUT = 2 * 16 * 16, I_GLU = 2 * 4 * 8;
    constexpr int NITEMS = I_WOUT + I_GLU;
    for (int it = gw; it < NITEMS; it += NGW) {
        int r = it;
        if (r < I_WOUT) { const int m = r / (16 * 16), q = r % (16 * 16), kb = q / 16, nb = q % 16; transpose_tile(w_out + (size_t)m * 1024 * 1024, 1024, 1024, kb * 64, nb * 64, wout_t + (size_t)m * 1024 * 1024, 0, nb * 64, scr, F.lane); continue; } r -= I_WOUT;
        { const int m = r / 32, q = r % 32, kb = q / 8, nb = q % 8; transpose_tile(glu + (size_t)m * 256 * 512, 512, 256, kb * 64, nb * 64, glu_t + (size_t)m * 512 * 256, 2, 0, scr, F.lane); }
    }
    __syncthreads();
    {
        const float* cc = (const float*)karg(1); const float* ada_w = (const float*)karg(3); const float* ada_b = (const float*)karg(4); float* mod = (float*)(F.ws + WS_MOD);
        LAS float* cs = (LAS float*)F.lds;
        LAS float* red = (LAS float*)(F.lds + 32768);
        for (int i = F.tid; i < 8192; i += NTHR) cs[i] = siluf_(cc[i]);
        __syncthreads();
        for (int it = F.vcu; it < 2 * 96; it += F.G) {
            const int l = it / 96, n0 = (it % 96) * 64, n = n0 + F.lane;
            float acc[8] = {0.f, 0.f, 0.f, 0.f, 0.f, 0.f, 0.f, 0.f};
            const float* wp = ada_w + (size_t)l * 1024 * 6144 + (size_t)(128 * F.wave) * 6144 + n;
#pragma unroll 8
            for (int k = 0; k < 128; ++k) { const float w = wp[(size_t)k * 6144];
#pragma unroll
                for (int b = 0; b < 8; ++b) acc[b] += cs[b * 1024 + 128 * F.wave + k] * w; }
#pragma unroll
            for (int b = 0; b < 8; ++b) red[(F.wave * 8 + b) * 64 + F.lane] = acc[b];
            __syncthreads();
            { const int b = F.tid >> 6, ln = F.tid & 63; float s = ada_b[l * 6144 + n0 + ln];
#pragma unroll
              for (int w = 0; w < 8; ++w) s += red[(w * 8 + b) * 64 + ln];
              mod[((size_t)l * 8 + b) * 6144 + n0 + ln] = s; }
            __syncthreads();
        }
    }
    {
        const int gt = F.vcu * NTHR + F.tid, NGT = F.G * NTHR;
        float* ktau = (float*)(F.ws + WS_KTAU4); bf16* Ebt = (bf16*)(F.ws + WS_S5E); bf16* Fbt = (bf16*)(F.ws + WS_S5F);
        for (int it4 = gt; it4 < 4 * 2 * 16 * 32 * 16; it4 += NGT) {
            const int it = it4 & 16383, nq = it4 >> 14;
            const int h = it & 15, tau = (it >> 4) & 31, g = (it >> 9) & 15, l = it >> 13;
            S5P P{(const float*)karg(17) + l * 1024, (const float*)karg(18) + l * 1024, (const float*)karg(19) + l * 16, (const float*)karg(20) + l * 16384, (const float*)karg(21) + l * 16384,
                  (const float*)karg(22) + l * 16384, (const float*)karg(23) + l * 16384, (const float*)karg(24) + l * 256};
            float acc[16];
#pragma unroll
            for (int j = 0; j < 16; ++j) acc[j] = 0.f;
            for (int n = 16 * nq; n < 16 * nq + 16; ++n) {
                float pr, pi, zr, zi; s5_pow(P, g, n, (float)tau, pr, pi); s5_z(P, g, n, zr, zi);
                const float cr = P.c_re[(g * 16 + h) * 64 + n], ci = P.c_im[(g * 16 + h) * 64 + n];
                const float qr = pr * zr - pi * zi, qi = pr * zi + pi * zr;
                const float tr = cr * qr - ci * qi, ti = cr * qi + ci * qr;
                const float* br = P.b_re + (g * 64 + n) * 16; const float* bi = P.b_im + (g * 64 + n) * 16;
#pragma unroll
                for (int j = 0; j < 16; ++j) acc[j] += tr * br[j] - ti * bi[j];
            }
            if (tau == 0 && nq == 0) acc[h] += P.d[g * 16 + h];
            float* o = ktau + (size_t)it4 * 16;
#pragma unroll
            for (int j = 0; j < 16; ++j) o[j] = acc[j];
        }
        for (int it = gt; it < 2 * 16 * 64 * 32; it += NGT) {
            const int s = it & 31, n = (it >> 5) & 63, g = (it >> 11) & 15, l = it >> 15, pair = g >> 1, gs = g & 1;
            S5P P{(const float*)karg(17) + l * 1024, (const float*)karg(18) + l * 1024, (const float*)karg(19) + l * 16, (const float*)karg(20) + l * 16384, (const float*)karg(21) + l * 16384,
                  (const float*)karg(22) + l * 16384, (const float*)karg(23) + l * 16384, (const float*)karg(24) + l * 256};
            float pr, pi, zr, zi; s5_pow(P, g, n, (float)(31 - s), pr, pi); s5_z(P, g, n, zr, zi);
            const float qr = pr * zr - pi * zi, qi = pr * zi + pi * zr;
            const float* br = P.b_re + (g * 64 + n) * 16; const float* bi = P.b_im + (g * 64 + n) * 16;
            bf16* e0 = Ebt + (((size_t)(l * 8 + pair) * 256) + gs * 128 + 2 * n) * 1024 + s * 32;
            unsigned wr_[8], wi_[8];
#pragma unroll
            for (int j = 0; j < 8; ++j) { const float vr0 = qr * br[2 * j] - qi * bi[2 * j], vi0 = qr * bi[2 * j] + qi * br[2 * j], vr1 = qr * br[2 * j + 1] - qi * bi[2 * j + 1], vi1 = qr * bi[2 * j + 1] + qi * br[2 * j + 1];
                wr_[j] = pk2(vr0, vr1); wi_[j] = pk2(vi0, vi1); }
            const u32x4 z4 = (u32x4){0u, 0u, 0u, 0u};
            *(u32x4*)(e0 + gs * 16) = (u32x4){wr_[0], wr_[1], wr_[2], wr_[3]}; *(u32x4*)(e0 + gs * 16 + 8) = (u32x4){wr_[4], wr_[5], wr_[6], wr_[7]};
            *(u32x4*)(e0 + 1024 + gs * 16) = (u32x4){wi_[0], wi_[1], wi_[2], wi_[3]}; *(u32x4*)(e0 + 1024 + gs * 16 + 8) = (u32x4){wi_[4], wi_[5], wi_[6], wi_[7]};
            *(u32x4*)(e0 + (1 - gs) * 16) = z4; *(u32x4*)(e0 + (1 - gs) * 16 + 8) = z4; *(u32x4*)(e0 + 1024 + (1 - gs) * 16) = z4; *(u32x4*)(e0 + 1024 + (1 - gs) * 16 + 8) = z4;
        }
        for (int it = gt; it < 2 * 16 * 64 * 32; it += NGT) {
            const int n = it & 63, t = (it >> 6) & 31, g = (it >> 11) & 15, l = it >> 15, pair = g >> 1, gs = g & 1;
            S5P P{(const float*)karg(17) + l * 1024, (const float*)karg(18) + l * 1024, (const float*)karg(19) + l * 16, (const float*)karg(20) + l * 16384, (const float*)karg(21) + l * 16384,
                  (const float*)karg(22) + l * 16384, (const float*)karg(23) + l * 16384, (const float*)karg(24) + l * 256};
            float pr, pi; s5_pow(P, g, n, (float)(t + 1), pr, pi);
            bf16* f0 = Fbt + ((size_t)(l * 8 + pair) * 1024 + t * 32) * 256 + gs * 128 + 2 * n;
#pragma unroll
            for (int h = 0; h < 16; ++h) { const float cr = P.c_re[(g * 16 + h) * 64 + n], ci = P.c_im[(g * 16 + h) * 64 + n];
                const float wr = cr * pr - ci * pi, wi = cr * pi + ci * pr;
                *(unsigned*)(f0 + (size_t)(gs * 16 + h) * 256) = pk2(wr, -wi);
                *(unsigned*)(f0 + (size_t)((1 - gs) * 16 + h) * 256) = 0u; }
        }
    }
}
__device__ __forceinline__ void s5_fill_m(Frame& F) {
    const int gt = F.vcu * NTHR + F.tid, NGT = F.G * NTHR;
    const float* ktau = (const float*)(F.ws + WS_KTAU4); bf16* Mbt = (bf16*)(F.ws + WS_S5M);
    for (int it = gt; it < 2 * 8 * 1024 * 128; it += NGT) {
        const int kc = it & 127, np = (it >> 7) & 1023, pair = (it >> 17) & 7, l = it >> 20;
        const int k0 = kc * 8, s = k0 >> 5, gs = (k0 >> 4) & 1, hp = k0 & 15, t = np >> 5, gsp = (np >> 4) & 1, h = np & 15;
        u32x4 o = (u32x4){0u, 0u, 0u, 0u};
        if (gs == gsp && s <= t) { const float* kp = ktau + ((((size_t)(l * 16 + pair * 2 + gs) * 32) + (t - s)) * 16 + h) * 16 + hp;
            f32x4 a = *(const f32x4*)kp, b = *(const f32x4*)(kp + 4);
#pragma unroll
            for (int q = 1; q < 4; ++q) { a += *(const f32x4*)(kp + (size_t)q * 262144); b += *(const f32x4*)(kp + (size_t)q * 262144 + 4); }
            o.x = pk2(a[0], a[1]); o.y = pk2(a[2], a[3]); o.z = pk2(b[0], b[1]); o.w = pk2(b[2], b[3]); }
        *(u32x4*)(Mbt + (size_t)it * 8) = o;
    }
}

struct RowVec { f32x4 v[4]; };
__device__ __forceinline__ RowVec load_vec(const float* p, int lane) { RowVec r; const f32x4* q = (const f32x4*)p + lane;
#pragma unroll
    for (int j = 0; j < 4; ++j) r.v[j] = q[64 * j];
    return r; }
__device__ __forceinline__ float sumsq(const RowVec& r) { float s = 0.f;
#pragma unroll
    for (int j = 0; j < 4; ++j) s += (r.v[j][0] * r.v[j][0] + r.v[j][1] * r.v[j][1]) + (r.v[j][2] * r.v[j][2] + r.v[j][3] * r.v[j][3]);
    return wave_sum(s); }
__device__ __forceinline__ void store_bf16_row(bf16* p, const RowVec& r, int lane) { u32x2* q = (u32x2*)p + lane;
#pragma unroll
    for (int j = 0; j < 4; ++j) { u32x2 w; w.x = pk2(r.v[j][0], r.v[j][1]); w.y = pk2(r.v[j][2], r.v[j][3]); q[64 * j] = w; } }
__device__ __forceinline__ RowVec load_vec_bf16(const bf16* p, int lane) { RowVec r; const u32x2* q = (const u32x2*)p + lane;
#pragma unroll
    for (int j = 0; j < 4; ++j) { const u32x2 w = q[64 * j]; r.v[j] = (f32x4){bflo(w.x), bfhi(w.x), bflo(w.y), bfhi(w.y)}; }
    return r; }
struct Norm1Ctx { RowVec gm, sh; f32x4 wff[16]; f32x4 fb; };
__device__ __forceinline__ void norm1_setup(Norm1Ctx& cx, const Args& a, const float* mod, int l, int b, int lane) {
    const RowVec g = load_vec((const float*)karg(5) + (size_t)(l * 2 + 0) * DM, lane), sc = load_vec(mod + ((size_t)l * 8 + b) * 6144 + 1024, lane);
    cx.sh = load_vec(mod + ((size_t)l * 8 + b) * 6144, lane);
#pragma unroll
    for (int j = 0; j < 4; ++j) cx.gm.v[j] = g.v[j] * (sc.v[j] + 1.0f);
    const float* w_in = (const float*)karg(7) + (size_t)l * DM * INCOLS + 768;
#pragma unroll
    for (int j = 0; j < 4; ++j)
#pragma unroll
        for (int c = 0; c < 4; ++c) cx.wff[j * 4 + c] = *(const f32x4*)(w_in + (size_t)(4 * lane + 256 * j + c) * INCOLS);
    cx.fb = *(const f32x4*)((const float*)karg(9) + l * 4);
}
__device__ __forceinline__ void norm1_row(const Norm1Ctx& cx, const RowVec& x, unsigned char* hrow, float* logf_row, int lane) {
    const float rs = rsqrtf(sumsq(x) * (1.0f / DM) + EPS);
    RowVec h; f32x4 ff = (f32x4){0.f, 0.f, 0.f, 0.f};
#pragma unroll
    for (int j = 0; j < 4; ++j) { h.v[j] = x.v[j] * rs * cx.gm.v[j] + cx.sh.v[j];
#pragma unroll
        for (int c = 0; c < 4; ++c) ff += cx.wff[j * 4 + c] * h.v[j][c]; }
    { unsigned* q = (unsigned*)hrow + lane;
#pragma unroll
      for (int j = 0; j < 4; ++j) q[64 * j] = pk4_fp8(h.v[j][0] * F8_SH, h.v[j][1] * F8_SH, h.v[j][2] * F8_SH, h.v[j][3] * F8_SH); }
#pragma unroll
    for (int c = 0; c < 4; ++c) ff[c] = wave_sum(ff[c]);
    if (lane == 0) { f32x4 o;
#pragma unroll
        for (int c = 0; c < 4; ++c) { const float z = ff[c] + cx.fb[c]; o[c] = fminf(z, 0.f) - log1pf(__expf(-fabsf(z))); }
        *(f32x4*)logf_row = o; }
}
__device__ __forceinline__ void p1_norm1(Frame& F, const Args& a, int l, const float* xsrc) {
    const int gw = F.vcu * NWAVES + F.wave; const int row0 = gw * 16, b = row0 / SEQ;
    Norm1Ctx cx; norm1_setup(cx, a, (const float*)(F.ws + WS_MOD), l, b, F.lane);
    unsigned char* H = F.ws + WS_H8; float* logf = (float*)(F.ws + WS_LOGF);
    RowVec xn = load_vec(xsrc + (size_t)row0 * DM, F.lane);
#pragma unroll 1
    for (int r = 0; r < 16; ++r) { const int row = row0 + r; const RowVec x = xn; if (r < 15) xn = load_vec(xsrc + (size_t)(row + 1) * DM, F.lane); norm1_row(cx, x, H + (size_t)row * DM, logf + (size_t)row * 4, F.lane); }
}
__device__ __forceinline__ void fox_cumsum(Frame& F, int bh) {
    const float* logf = (const float*)(F.ws + WS_LOGF); float* fb = (float*)(F.ws + WS_FBIAS);
    const int b = bh >> 2, h = bh & 3, lane = F.lane;
    const float* src = logf + ((size_t)b * SEQ + 64 * lane) * 4 + h;
    float tot = 0.f;
#pragma unroll 16
    for (int i = 0; i < 64; ++i) tot += src[i * 4];
    float inc = tot;
#pragma unroll
    for (int o = 1; o < 64; o <<= 1) { const float t = __shfl_up(inc, o); if (lane >= o) inc += t; }
    float run = inc - tot;
    float* dst = fb + (size_t)bh * SEQ + 64 * lane;
#pragma unroll 16
    for (int i = 0; i < 64; ++i) { run += src[i * 4]; dst[i] = -run * LOG2E; }
}
__device__ __forceinline__ void fox_norms(Frame& F, int task, int l) {
    const int bh = task >> 4, ch = task & 15, b = bh >> 2, h = bh & 3, lane = F.lane;
    const bf16* base = (const bf16*)(F.ws + WS_PROJ) + ((size_t)b * SEQ + ch * 256 + lane * 4) * NPROJ + h * 64;
    float mq = 0.f, mk = 0.f;
#pragma unroll
    for (int i = 0; i < 4; ++i) {
        float sq = 0.f, sk = 0.f;
#pragma unroll
        for (int j = 0; j < 8; ++j) { const u32x4 wq = *(const u32x4*)(base + (size_t)i * NPROJ + C_FQ + 8 * j), wk = *(const u32x4*)(base + (size_t)i * NPROJ + C_FK + 8 * j);
            const unsigned a[4] = {wq.x, wq.y, wq.z, wq.w}, c[4] = {wk.x, wk.y, wk.z, wk.w};
#pragma unroll
            for (int e = 0; e < 4; ++e) { sq += bflo(a[e]) * bflo(a[e]) + bfhi(a[e]) * bfhi(a[e]); sk += bflo(c[e]) * bflo(c[e]) + bfhi(c[e]) * bfhi(c[e]); } }
        mq = fmaxf(mq, sq); mk = fmaxf(mk, sk);
    }
    mq = sqrtf(wave_max(mq)) * 1.001f; mk = sqrtf(wave_max(mk)) * 1.001f;
    if (lane == 0) { unsigned* w = F.ctl + CW_QKN + 64 * l + bh * 2; atomicMax(w, __float_as_uint(mq)); atomicMax(w + 1, __float_as_uint(mk)); }
}
__device__ __forceinline__ void hg_scan(Frame& F) {
    const bf16* hst = (const bf16*)(F.ws + WS_HST); bf16* hst2 = (bf16*)(F.ws + WS_HST2); const float* hdec = (const float*)(F.ws + WS_HDEC);
    const int gt = F.vcu * NTHR + F.tid, NGT = F.G * NTHR;
    for (int e = gt; e < 32 * 8192; e += NGT) {
        const int bh = e >> 13, kv = e & 8191, k = kv >> 6;
        float carry = 0.f;
        const bf16* p = hst + (size_t)bh * 64 * 8192 + kv; bf16* q = hst2 + (size_t)bh * 64 * 8192 + kv; const float* d = hdec + (size_t)bh * 64 * 128 + k;
#pragma unroll 16
        for (int c = 0; c < 64; ++c) { const float t = bf2f(p[(size_t)c * 8192]); q[(size_t)c * 8192] = (bf16)f2bf(carry); carry = d[c * 128] * carry + t; }
    }
}
__device__ __forceinline__ void s5_scan(Frame& F, const Args& a, int l) {
    const int gt = F.vcu * NTHR + F.tid;
    if (gt >= 8 * 16 * 64 * 8) return;
    const int lane = F.lane, seg = lane >> 3, gwv = gt >> 6, n = (gwv & 7) * 8 + (lane & 7), g = (gwv >> 3) & 15, b = gwv >> 7, pair = g >> 1, gs = g & 1;
    S5P P{(const float*)karg(17) + l * 1024, (const float*)karg(18) + l * 1024, (const float*)karg(19) + l * 16, nullptr, nullptr, nullptr, nullptr, nullptr};
    float ar, ai, br, bi; s5_pow(P, g, n, 32.0f, ar, ai); s5_pow(P, g, n, 512.0f, br, bi);
    const float* xl = (const float*)(F.ws + WS_XLOC) + ((size_t)b * 128 + seg * 16) * 2048 + pair * 256 + gs * 128 + 2 * n;
    bf16* xi = (bf16*)(F.ws + WS_XIN) + ((size_t)b * 128 + seg * 16) * 2048 + pair * 256 + gs * 128 + 2 * n;
    float lr[16], li[16]; float xr = 0.f, xim = 0.f;
#pragma unroll
    for (int j = 0; j < 16; ++j) { const f32x2 v = *(const f32x2*)(xl + (size_t)j * 2048); lr[j] = xr; li[j] = xim;
        const float nr = ar * xr - ai * xim + v[0], ni = ar * xim + ai * xr + v[1]; xr = nr; xim = ni; }
    float cr = 0.f, ci = 0.f;
#pragma unroll
    for (int sg = 1; sg < 8; ++sg) { const float tr = __shfl_up(xr, 8), ti = __shfl_up(xim, 8), pr_ = __shfl_up(cr, 8), pi_ = __shfl_up(ci, 8);
        if (seg == sg) { cr = br * pr_ - bi * pi_ + tr; ci = br * pi_ + bi * pr_ + ti; } }
    float pr = 1.f, pi = 0.f;
#pragma unroll
    for (int j = 0; j < 16; ++j) { *(unsigned*)(xi + (size_t)j * 2048) = pk2(lr[j] + pr * cr - pi * ci, li[j] + pr * ci + pi * cr);
        const float qr = pr * ar - pi * ai, qi = pr * ai + pi * ar; pr = qr; pi = qi; }
}
constexpr int RW_LD = 1028;
constexpr int LDS_LG = LDS_STASH;
__device__ __forceinline__ void p8_post_router(Frame& F, const Args& a, int l, const float* xsrc, bool dummy) {
    const bf16* x2src = (const bf16*)(F.ws + WS_X2);
#define P8_LOADX(row_) ((l == 0) ? load_vec(xsrc + (size_t)(row_) * DM, lane) : load_vec_bf16(x2src + (size_t)(row_) * DM, lane))
    const int lane = F.lane, tid = F.tid;
    const int gw = F.vcu * NWAVES + F.wave; const int row0 = gw * 16, b = row0 / SEQ;
    const float* mod = (const float*)(F.ws + WS_MOD) + ((size_t)l * 8 + b) * 6144;
    const float* pre_g = (const float*)karg(5) + (size_t)(l * 2 + 1) * DM;
    LAS float* WT = (LAS float*)F.lds;
    LAS float* CV = (LAS float*)(F.lds + 135680);
    { const float* rw = (const float*)karg(26) + (size_t)l * DM * NEXP;
      for (int idx = tid; idx < 8192; idx += NTHR) { const int k = idx >> 3, eq = idx & 7; const f32x4 w = *(const f32x4*)(rw + (size_t)k * NEXP + 4 * eq); const float g = pre_g[k] * (mod[4096 + k] + 1.0f);
          WT[(4 * eq + 0) * RW_LD + k] = w[0] * g; WT[(4 * eq + 1) * RW_LD + k] = w[1] * g; WT[(4 * eq + 2) * RW_LD + k] = w[2] * g; WT[(4 * eq + 3) * RW_LD + k] = w[3] * g; }
      { const int e = tid & 31, part = tid >> 5; float sacc = 0.f;
#pragma unroll 8
        for (int k = part * 64; k < part * 64 + 64; ++k) sacc += mod[3072 + k] * rw[(size_t)k * NEXP + e];
        CV[32 + part * 32 + e] = sacc; }
      __syncthreads();
      if (tid < 32) { float sacc = ((const float*)karg(27))[l * NEXP + tid];
#pragma unroll
          for (int p = 0; p < 16; ++p) sacc += CV[32 + p * 32 + tid];
          CV[tid] = sacc; } }
    __syncthreads();
    RowVec pg;
    { const RowVec pgv = load_vec((const float*)karg(6) + (size_t)(l * 2 + 0) * DM, lane), g1 = load_vec(mod + 2048, lane);
#pragma unroll
      for (int j = 0; j < 4; ++j) pg.v[j] = pgv.v[j] * g1.v[j]; }
    const bf16* Y2 = (const bf16*)(F.ws + WS_Y2); unsigned char* H8 = F.ws + WS_H8; bf16* xbuf = (bf16*)(F.ws + WS_X1);
    RowVec gm2, sh2s;
    { const RowVec pre = load_vec(pre_g, lane), sc2 = load_vec(mod + 4096, lane), sh2 = load_vec(mod + 3072, lane);
#pragma unroll
      for (int j = 0; j < 4; ++j) { gm2.v[j] = pre.v[j] * (sc2.v[j] + 1.0f) * F8_SH; sh2s.v[j] = sh2.v[j] * F8_SH; } }
    float rs2mine = 0.f;
    RowVec xn = P8_LOADX(row0); u32x2 yn[4];
    { const u32x2* yp = (const u32x2*)(Y2 + (size_t)row0 * DM) + lane;
#pragma unroll
      for (int j = 0; j < 4; ++j) yn[j] = yp[64 * j]; }
#pragma unroll 1
    for (int rr = 0; rr < 16; ++rr) {
        const int row = row0 + rr;
        RowVec x = xn, y;
#pragma unroll
        for (int j = 0; j < 4; ++j) y.v[j] = (f32x4){bflo(yn[j].x), bfhi(yn[j].x), bflo(yn[j].y), bfhi(yn[j].y)};
        if (rr < 15) { xn = P8_LOADX(row + 1); const u32x2* yp = (const u32x2*)(Y2 + (size_t)(row + 1) * DM) + lane;
#pragma unroll
            for (int j = 0; j < 4; ++j) yn[j] = yp[64 * j]; }
        const float rs = rsqrtf(sumsq(y) * (1.0f / DM) + EPS);
#pragma unroll
        for (int j = 0; j < 4; ++j) x.v[j] += y.v[j] * rs * pg.v[j];
        store_bf16_row(xbuf + (size_t)row * DM, x, lane);
        const float rs2 = rsqrtf(sumsq(x) * (1.0f / DM) + EPS);
        if (lane == rr) rs2mine = rs2;
        { unsigned* q = (unsigned*)(H8 + (size_t)row * DM) + lane;
#pragma unroll
          for (int j = 0; j < 4; ++j) { const f32x4 hv = x.v[j] * rs2 * gm2.v[j] + sh2s.v[j]; q[64 * j] = pk4_fp8(hv[0], hv[1], hv[2], hv[3]); } }
    }
    asm volatile("s_waitcnt vmcnt(0)" ::: "memory");
    f32x4 acc0 = (f32x4){0.f, 0.f, 0.f, 0.f}, acc1 = acc0;
    { const int i = lane & 15, kk = lane >> 4;
      const bf16* xa = xbuf + (size_t)(row0 + i) * DM + 4 * kk; const LAS float* wb = WT + i * RW_LD + 4 * kk;
#pragma unroll 8
      for (int k0 = 0; k0 < DM; k0 += 16) { const u32x2 aw = *(const u32x2*)(xa + k0); const f32x4 av = (f32x4){bflo(aw.x), bfhi(aw.x), bflo(aw.y), bfhi(aw.y)}; const f32x4 b0 = *(const LAS f32x4*)(wb + k0), b1 = *(const LAS f32x4*)(wb + 16 * RW_LD + k0);
#pragma unroll
          for (int m = 0; m < 4; ++m) { acc0 = __builtin_amdgcn_mfma_f32_16x16x4f32(av[m], b0[m], acc0, 0, 0, 0); acc1 = __builtin_amdgcn_mfma_f32_16x16x4f32(av[m], b1[m], acc1, 0, 0, 0); } }
      LAS float* LG = (LAS float*)(F.lds + LDS_LG) + F.wave * (16 * 33);
#pragma unroll
      for (int r = 0; r < 4; ++r) { const int rowi = 4 * kk + r; const float sc = __shfl(rs2mine, rowi); LG[rowi * 33 + i] = acc0[r] * sc + CV[i]; LG[rowi * 33 + 16 + i] = acc1[r] * sc + CV[16 + i]; } }
    LDS_WAIT(); asm volatile("" ::: "memory");
    LAS unsigned* TOP = (LAS unsigned*)(F.lds + 131584) + F.wave * 128;
    if (lane < 16) {
        const LAS float* LG = (const LAS float*)(F.lds + LDS_LG) + F.wave * (16 * 33) + lane * 33;
        float lg[32];
#pragma unroll
        for (int e = 0; e < 32; ++e) lg[e] = LG[e];
        unsigned used = 0u; float tv[4]; int te[4];
#pragma unroll
        for (int k = 0; k < 4; ++k) { float best = -INFINITY; int bi = 0;
#pragma unroll
            for (int e = 0; e < 32; ++e) { const bool ok = ((used >> e) & 1u) == 0u && lg[e] > best; best = ok ? lg[e] : best; bi = ok ? e : bi; }
            used |= 1u << bi; tv[k] = best; te[k] = bi; }
        float ws[4]; float sum = 0.f;
#pragma unroll
        for (int k = 0; k < 4; ++k) { ws[k] = __expf(tv[k] - tv[0]); sum += ws[k]; }
        const float inv = 1.0f / sum;
#pragma unroll
        for (int k = 0; k < 4; ++k) { TOP[4 * lane + k] = (unsigned)te[k]; TOP[64 + 4 * lane + k] = __float_as_uint(ws[k] * inv); }
    }
    LDS_WAIT(); asm volatile("" ::: "memory");
    const int myE = (int)TOP[lane]; const float myW = __uint_as_float(TOP[64 + lane]);
    unsigned long long mymask = 0ull, remaining = ~0ull;
#pragma unroll 1
    while (remaining) { const int src = __ffsll((long long)remaining) - 1; const int e0 = __builtin_amdgcn_readlane(myE, src); const unsigned long long m = __ballot(myE == e0); if (myE == e0) mymask = m; remaining &= ~m; }
    const int leader = __ffsll((long long)mymask) - 1, cntg = __popcll(mymask), rank = __popcll(mymask & ((1ull << lane) - 1ull));
    unsigned* cnt = F.ctl + (dummy ? CW_CNT_DUMMY : CW_CNT) + 64 * l;
    int base = 0;
    if (lane == leader) base = (int)__hip_atomic_fetch_add(cnt + myE, (unsigned)cntg, __ATOMIC_RELAXED, __HIP_MEMORY_SCOPE_AGENT);
    base = __shfl(base, leader);
    const int pos = base + rank, tokk = (row0 + (lane >> 2)) * 4 + (lane & 3);
    unsigned char* lw = F.ws + (dummy ? WS_ACT : 0);
    ((int*)(lw + WS_LISTS))[(size_t)myE * NT + pos] = tokk;
    ((float*)(lw + WS_WSLOT))[(size_t)myE * NT + pos] = myW;
    ((int*)(lw + WS_TOKPOS))[tokk] = myE * NT + pos;
    __syncthreads();
#undef P8_LOADX
}
__device__ __forceinline__ void p11_combine(Frame& F, const Args& a, int l) {
    const int lane = F.lane;
    const int gw = F.vcu * NWAVES + F.wave; const int row0 = gw * 16, b = row0 / SEQ;
    const float* mod = (const float*)(F.ws + WS_MOD) + ((size_t)l * 8 + b) * 6144;
    RowVec pg;
    { const RowVec pgv = load_vec((const float*)karg(6) + (size_t)(l * 2 + 1) * DM, lane), g2 = load_vec(mod + 5120, lane);
#pragma unroll
      for (int j = 0; j < 4; ++j) pg.v[j] = pgv.v[j] * g2.v[j]; }
    const unsigned* cnt = F.ctl + CW_CNT + 64 * l;
    int mybase; { const int c = (lane < 32) ? (int)__hip_atomic_load(cnt + lane, __ATOMIC_RELAXED, __HIP_MEMORY_SCOPE_AGENT) : 0; int ps = c;
#pragma unroll
        for (int o = 1; o < 32; o <<= 1) { const int t = __shfl_up(ps, o); if (lane >= o) ps += t; }
        mybase = ps - c; }
    const int* tokpos = (const int*)(F.ws + WS_TOKPOS); const unsigned char* YK = F.ws + WS_YK; const bf16* x1buf = (const bf16*)(F.ws + WS_X1); float* xbuf = (float*)karg(32); bf16* x2buf = (bf16*)(F.ws + WS_X2);
    Norm1Ctx cx; const bool nextl = (l + 1 < DEPTH);
    if (nextl) norm1_setup(cx, a, (const float*)(F.ws + WS_MOD), l + 1, b, lane);
    unsigned char* H = F.ws + WS_H8; float* logf = (float*)(F.ws + WS_LOGF);
    int myslot; { const int tp = tokpos[row0 * 4 + lane]; myslot = __shfl(mybase, tp >> 15) + (tp & 32767); }
    unsigned yn[4][4]; u32x2 xq[4];
#define P11_ISSUE(r_) do { _Pragma("unroll") for (int k = 0; k < 4; ++k) { const int slot = __shfl(myslot, 4 * (r_) + k); const unsigned* yp = (const unsigned*)(YK + (size_t)slot * DM) + lane; \
        _Pragma("unroll") for (int j = 0; j < 4; ++j) yn[k][j] = yp[64 * j]; } { const u32x2* xp = (const u32x2*)(x1buf + (size_t)(row0 + (r_)) * DM) + lane; _Pragma("unroll") for (int j = 0; j < 4; ++j) xq[j] = xp[64 * j]; } } while (0)
    P11_ISSUE(0);
#pragma unroll 1
    for (int r = 0; r < 16; ++r) {
        const int row = row0 + r;
        RowVec y, x;
#pragma unroll
        for (int j = 0; j < 4; ++j) { y.v[j] = (f32x4){0.f, 0.f, 0.f, 0.f}; x.v[j] = (f32x4){bflo(xq[j].x), bfhi(xq[j].x), bflo(xq[j].y), bfhi(xq[j].y)};
#pragma unroll
            for (int k = 0; k < 4; ++k) { const int w = (int)yn[k][j]; y.v[j] += (f32x4){__builtin_amdgcn_cvt_f32_fp8(w, 0), __builtin_amdgcn_cvt_f32_fp8(w, 1), __builtin_amdgcn_cvt_f32_fp8(w, 2), __builtin_amdgcn_cvt_f32_fp8(w, 3)}; } }
        if (r < 15) P11_ISSUE(r + 1);
        const float rs = rsqrtf(sumsq(y) * (1.0f / DM) + EPS);
#pragma unroll
        for (int j = 0; j < 4; ++j) x.v[j] += y.v[j] * rs * pg.v[j];
        if (nextl) store_bf16_row(x2buf + (size_t)row * DM, x, lane);
        else { f32x4* xo = (f32x4*)(xbuf + (size_t)row * DM) + lane;
#pragma unroll
          for (int j = 0; j < 4; ++j) xo[64 * j] = x.v[j]; }
        if (nextl) norm1_row(cx, x, H + (size_t)row * DM, logf + (size_t)row * 4, lane);
    }
#undef P11_ISSUE
}

constexpr int NPH = 22;
#ifndef PH_MASK
#define PH_MASK 0xFFF
#endif
#define PHON(id) ((((PH_MASK) >> (id)) & 1) && (BODY < 0 || BODY == (id)))
#ifndef SUB_MASK
#define SUB_MASK 0xFF
#endif
#define SUBON(id) (((SUB_MASK) >> (id)) & 1)
#ifndef DUP_MASK
#define DUP_MASK 0
#endif
#ifndef XMODE
#define XMODE 0
#endif
#define DUPN(id) ((((DUP_MASK) >> (id)) & 1) ? 2 : 1)
#define REP(id) for (int rep_ = 0; rep_ < DUPN(id); ++rep_)
#define REPBAR(id) do { if (DUPN(id) == 2 && rep_ == 0) GRID_BAR(); } while (0)
#define IN(k) (lo <= (k) && (k) < hi)
#if MK_ONE_LAUNCH
#define GRID_BAR() do { XcdBarrier b2_ = bar; asm volatile("" : "+s"(b2_.bar)); xcd_barrier(b2_); } while (0)
#else
#define GRID_BAR() do { } while (0)
#endif
#define SEAM(k) do { if (IN(k) && IN((k) + 1)) GRID_BAR(); } while (0)
#define x_in ((const float*)karg(0))
#define PROJ ((bf16*)(F.ws + WS_PROJ))
#define H ((bf16*)(F.ws + WS_H))
#define YCAT ((bf16*)(F.ws + WS_YCAT))
template <int BODY, int l>
__device__ __forceinline__ void layer_phases(Frame& F, const Args& args, const int lo, const int hi, const XcdBarrier& bar) {
        constexpr int pb = 2 + 10 * l;

        if (PHON(2) && IN(pb + 0)) REP(2) {
            REFRESH();
            ProjProb P; P.A = F.ws + WS_H8; P.Bt = F.ws + WS_WIN + (size_t)l * NPROJ * DM; P.O = PROJ; P.pos = (const int*)karg(2); P.G = F.G; P.c = F.vcu;
            gk::run<ProjProb, true>(F.lds, P, (DUPN(2) == 2 && rep_ == 0) ? XMODE : 0);
        REPBAR(2); } SEAM(pb + 0);
        if (PHON(3) && IN(pb + 1)) REP(3) {
            REFRESH();
            { const int gw = F.vcu * NWAVES + F.wave; if (gw >= 1024 && gw < 1024 + 32) fox_cumsum(F, gw - 1024); if (gw < 512) fox_norms(F, gw, l); }
            REFRESH();
            REFRESH();
            if (SUBON(1)) { S5EProb P; P.proj = PROJ; P.Ebt = (const bf16*)(F.ws + WS_S5E) + (size_t)l * 8 * 256 * 1024; P.xloc = (float*)(F.ws + WS_XLOC); P.G = F.G; P.c = F.G - 1 - F.vcu; gk::run(F.lds, P); }
            REFRESH();
            if (SUBON(0)) hg::h1_phase(F, l, PROJ, (const float*)karg(10), (bf16*)(F.ws + WS_HST), (float*)(F.ws + WS_HDEC), F.ctl + CW_HGQ + 8 * (2 * l + 0) + 4 * rep_);
        REPBAR(3); } SEAM(pb + 1);
        if (PHON(4) && IN(pb + 2)) REP(4) { REFRESH(); s5_scan(F, args, l); REFRESH(); hg_scan(F); REPBAR(4); } SEAM(pb + 2);
        if (PHON(5) && IN(pb + 3)) REP(5) {
            REFRESH();
            if (SUBON(1)) { S5FMProb P; P.proj = PROJ; P.xin = (const bf16*)(F.ws + WS_XIN); P.Fbt = (const bf16*)(F.ws + WS_S5F) + (size_t)l * 8 * 1024 * 256; P.Mbt = (const bf16*)(F.ws + WS_S5M) + (size_t)l * 8 * 1024 * 1024;
              P.ygelu = (bf16*)(F.ws + WS_YGELU); P.G = F.G; P.c = F.vcu; gk::run(F.lds, P); }
            REFRESH();
            if (SUBON(0)) hg::h3_phase(F, l, PROJ, (const float*)karg(10), (const bf16*)(F.ws + WS_HST2), (const float*)karg(11) + l * 64, YCAT, F.ctl + CW_HGQ + 8 * (2 * l + 1) + 4 * rep_);
        REPBAR(5); } SEAM(pb + 3);
        if (PHON(6) && IN(pb + 4)) REP(6) {
            REFRESH();
            if (SUBON(1)) { GluProb P; P.A = (const bf16*)(F.ws + WS_YGELU); P.Bt = (const bf16*)(F.ws + WS_GLU) + (size_t)l * 512 * 256; P.pitchA = 256; P.pitchB = 256; P.O = YCAT; P.G = F.G; P.c = F.vcu; gk::run(F.lds, P); }
            REFRESH();
            const float lam_init = 0.8f - 0.6f * expf(-0.3f * (float)l);
            float lam;
            { const float* q1 = (const float*)karg(12) + l * 32; const float* k1 = (const float*)karg(13) + l * 32; const float* q2 = (const float*)karg(14) + l * 32; const float* k2 = (const float*)karg(15) + l * 32;
              float s1 = 0.f, s2 = 0.f; for (int i = 0; i < 32; ++i) { s1 += q1[i] * k1[i]; s2 += q2[i] * k2[i]; } lam = expf(s1) - expf(s2) + lam_init; }
            const float* fbias = (const float*)(F.ws + WS_FBIAS); const float* subln = (const float*)karg(16) + l * 64; bf16* proj_ = PROJ; bf16* ycat_ = YCAT; const unsigned* qkn_ = F.ctl + CW_QKN + 64 * l;
            for (int v = F.vcu; v < 256; v += F.G) {
                const int bh = v >> 3, s = v & 7, b = bh >> 2, h = bh & 3;
                if (SUBON(2)) att::unit<1>(b, h, 15 - s, proj_, fbias, qkn_, ycat_, lam, lam_init, subln, (LAS char*)F.lds);
                if (SUBON(0)) att::unit<0>(b, h, 15 - s, proj_, fbias, qkn_, ycat_, lam, lam_init, subln, (LAS char*)F.lds);
                if (SUBON(2)) att::unit<1>(b, h, s, proj_, fbias, qkn_, ycat_, lam, lam_init, subln, (LAS char*)F.lds);
                if (SUBON(0)) att::unit<0>(b, h, s, proj_, fbias, qkn_, ycat_, lam, lam_init, subln, (LAS char*)F.lds);
            }
        REPBAR(6); } SEAM(pb + 4);
        if (PHON(7) && IN(pb + 5)) REP(7) {
            REFRESH();
            PlainProb P; P.A = YCAT; P.Bt = (const bf16*)(F.ws + WS_WOUT) + (size_t)l * DM * DM; P.pitchA = DM; P.pitchB = DM; P.O = (bf16*)(F.ws + WS_Y2); P.ldc = DM; P.nM = NT / 256; P.nN = 4; P.G = F.G; P.c = F.vcu;
            gk::run(F.lds, P);
        REPBAR(7); } SEAM(pb + 5);
        if (PHON(8) && IN(pb + 6)) REP(8) { REFRESH(); p8_post_router(F, args, l, l == 0 ? x_in : (const float*)karg(32), DUPN(8) == 2 && rep_ == 0); REPBAR(8); } SEAM(pb + 6);
        if (PHON(9) && IN(pb + 7)) REP(9) {
            REFRESH();
            moe_tables(F, F.ctl + CW_CNT + 64 * l);
            Moe1Prob P; P.h8 = (const unsigned char*)(F.ws + WS_H8); P.w1t = (const unsigned char*)(F.ws + WS_W1T) + (size_t)l * 32 * 2048 * 1024; P.b1 = (const float*)karg(29) + (size_t)l * 32 * 2048; P.lists = (const int*)(F.ws + WS_LISTS);
            P.act = (unsigned char*)(F.ws + WS_ACT); P.CTL = F.CTL; P.G = F.G; P.c = F.vcu; gk::run<Moe1Prob, true>(F.lds, P, (DUPN(9) == 2 && rep_ == 0) ? XMODE : 0);
        REPBAR(9); } SEAM(pb + 7);
        if (PHON(10) && IN(pb + 8)) REP(10) {
            REFRESH();
            moe_tables(F, F.ctl + CW_CNT + 64 * l);
            Moe2Prob P; P.act = (const unsigned char*)(F.ws + WS_ACT); P.w2t = (const unsigned char*)(F.ws + WS_W2T) + (size_t)l * 32 * 1024 * 1024; P.b2 = (const float*)karg(31) + (size_t)l * 32 * 1024; P.wslot = (const float*)(F.ws + WS_WSLOT);
            P.yk = F.ws + WS_YK; P.CTL = F.CTL; P.G = F.G; P.c = F.vcu; gk::run<Moe2Prob, true>(F.lds, P, (DUPN(10) == 2 && rep_ == 0) ? XMODE : 0);
        REPBAR(10); } SEAM(pb + 8);
        if (PHON(11) && IN(pb + 9)) REP(11) { REFRESH(); p11_combine(F, args, l); REPBAR(11); } SEAM(pb + 9);
    }
template <int BODY>
__global__ void __launch_bounds__(NTHR, 2) mk_fwd(Args args) {
    extern __shared__ __attribute__((aligned(16))) unsigned char lds_raw[];
    Frame F;
    F.lds = (LAS unsigned char*)lds_raw; F.CTL = (volatile LAS unsigned*)(F.lds + LDSCTL_OFF);
    F.G = gridDim.x; { const int bx = blockIdx.x; F.vcu = (F.G % 8 == 0) ? (bx % 8) * (F.G / 8) + bx / 8 : bx; }
    REFRESH();
    for (int u = F.tid; u < (LDS_BYTES - LDSCTL_OFF) / 4; u += NTHR) ((LAS unsigned*)(F.lds + LDSCTL_OFF))[u] = 0u;
    __syncthreads();
    XcdBarrier bar; bar.bar = F.ctl + CW_BAR; bar.x = 0; bar.st = F.CTL;
#if MK_ONE_LAUNCH
    bar = xcd_barrier_post(F.ctl + CW_BAR, F.CTL);
#endif
    const int lo = args.ph_lo, hi = args.ph_hi;
    if (PHON(0) && IN(0)) REP(0) { REFRESH(); p0_prologue(F, args); REPBAR(0); } SEAM(0);
    if (PHON(1) && IN(1)) REP(1) { REFRESH(); p1_norm1(F, args, 0, x_in); REFRESH(); s5_fill_m(F); REPBAR(1); } SEAM(1);
    layer_phases<BODY, 0>(F, args, lo, hi, bar);
    layer_phases<BODY, 1>(F, args, lo, hi, bar);
}
#undef IN
#undef SEAM
#undef x_in
#undef PROJ
#undef H
#undef YCAT

extern "C" void kernel_launch(void* const* d_in, const int* in_sizes, int n_in, void* d_out, int out_size, void* d_ws, size_t ws_size, hipStream_t stream) {
    static int grid = 0;
    if (grid == 0) {
        if (n_in != 32 || out_size != NT * DM || ws_size < WS_END) { fprintf(stderr, "kernel_launch: unexpected problem (n_in %d, out %d, ws %zu)\n", n_in, out_size, ws_size); grid = -1; return; }
        int dev = 0, cus = 0, per_cu = 0;
        if (hipGetDevice(&dev) != hipSuccess || hipDeviceGetAttribute(&cus, hipDeviceAttributeMultiprocessorCount, dev) != hipSuccess) { grid = -1; return; }
#if MK_ONE_LAUNCH
        const void* kfn[1] = {(const void*)mk_fwd<-1>};
#else
        const void* kfn[12] = {(const void*)mk_fwd<0>, (const void*)mk_fwd<1>, (const void*)mk_fwd<2>, (const void*)mk_fwd<3>, (const void*)mk_fwd<4>, (const void*)mk_fwd<5>, (const void*)mk_fwd<6>, (const void*)mk_fwd<7>,
                               (const void*)mk_fwd<8>, (const void*)mk_fwd<9>, (const void*)mk_fwd<10>, (const void*)mk_fwd<11>};
#endif
        for (const void* f : kfn) if (hipFuncSetAttribute(f, hipFuncAttributeMaxDynamicSharedMemorySize, LDS_BYTES) != hipSuccess) { fprintf(stderr, "kernel_launch: hipFuncSetAttribute failed\n"); grid = -1; return; }
        if (hipOccupancyMaxActiveBlocksPerMultiprocessor(&per_cu, kfn[0], NTHR, LDS_BYTES) != hipSuccess || per_cu < 1) fprintf(stderr, "kernel_launch: occupancy query says %d\n", per_cu);
        (void)hipGetLastError();
        grid = cus;
    }
    if (grid < 0) return;
    (void)hipMemsetAsync((char*)d_ws + WS_CTL, 0, CTL_BYTES, stream);
    Args a{};
    for (int i = 0; i < 32; ++i) a.in[i] = d_in[i];
    a.out = (float*)d_out; a.ws = (unsigned char*)d_ws;
#if MK_ONE_LAUNCH
    a.ph_lo = 0; a.ph_hi = NPH;
    hipLaunchKernelGGL(mk_fwd<-1>, dim3(grid), dim3(NTHR), LDS_BYTES, stream, a);
#else
    for (int p = 0; p < NPH; ++p) {
        a.ph_lo = p; a.ph_hi = p + 1;
        const int body = p < 2 ? p : 2 + (p - 2) % 10;
        switch (body) {
#define MK_CASE(n) case n: hipLaunchKernelGGL(mk_fwd<n>, dim3(grid), dim3(NTHR), LDS_BYTES, stream, a); break;
            MK_CASE(0) MK_CASE(1) MK_CASE(2) MK_CASE(3) MK_CASE(4) MK_CASE(5) MK_CASE(6) MK_CASE(7) MK_CASE(8) MK_CASE(9) MK_CASE(10) MK_CASE(11)
#undef MK_CASE
        }
    }
#endif
}
```

```cpp
#include <hip/hip_runtime.h>
#include <cstdio>
#include <cstdint>
#include <cmath>

#ifndef MK_ONE_LAUNCH
#define MK_ONE_LAUNCH 1
#endif

#define GAS __attribute__((address_space(1)))
#define LAS __attribute__((address_space(3)))
typedef unsigned short bf16;
typedef short bf16x8 __attribute__((ext_vector_type(8)));
typedef short s16x4 __attribute__((ext_vector_type(4)));
typedef float f32x2 __attribute__((ext_vector_type(2)));
typedef float f32x4 __attribute__((ext_vector_type(4)));
typedef float f32x16 __attribute__((ext_vector_type(16)));
typedef unsigned u32x2 __attribute__((ext_vector_type(2)));
typedef unsigned u32x4 __attribute__((ext_vector_type(4)));

constexpr int NB = 8, SEQ = 4096, DM = 1024, NT = NB * SEQ, DEPTH = 2;
constexpr int NPROJ = 3328, INCOLS = 3332;
constexpr int C_FQ = 0, C_FK = 256, C_FV = 512, C_HQ = 768, C_HF = 1280, C_HI = 1792, C_HG = 2048, C_DQ = 2304, C_DK = 2560, C_DV = 2816, C_SU = 3072;
constexpr int NEXP = 32, TOPK = 4;
constexpr float EPS = 1e-6f;
constexpr float LOG2E = 1.4426950408889634f;
constexpr int NWAVES = 8, NTHR = 512;
constexpr int S5L = 32, S5ROWS = NT / S5L;
constexpr int HGC = 64, HGUNITS = NB * 4 * (SEQ / HGC);

constexpr size_t MiB = 1u << 20;
constexpr size_t WS_CTL = 0, CTL_BYTES = 1 * MiB;
constexpr size_t WS_WIN = 2 * MiB;
constexpr size_t WS_WOUT = 16 * MiB;
constexpr size_t WS_GLU = 20 * MiB;
constexpr size_t WS_MOD = 21 * MiB;
constexpr size_t WS_KTAU = 22 * MiB;
constexpr size_t WS_LOGF = 23 * MiB;
constexpr size_t WS_FBIAS = 24 * MiB;
constexpr size_t WS_HDEC = 25 * MiB;
constexpr size_t WS_TOKPOS = 26 * MiB;
constexpr size_t WS_XIN = 27 * MiB;
constexpr size_t WS_XLOC = 32 * MiB;
constexpr size_t WS_LISTS = 40 * MiB;
constexpr size_t WS_WSLOT = 44 * MiB;
constexpr size_t WS_S5E = 48 * MiB;
constexpr size_t WS_S5F = 56 * MiB;
constexpr size_t WS_S5M = 64 * MiB;
constexpr size_t WS_YGELU = 96 * MiB;
constexpr size_t WS_H = 112 * MiB;
constexpr size_t WS_YCAT = 176 * MiB;
constexpr size_t WS_Y2 = 240 * MiB;
constexpr size_t WS_HST = 304 * MiB;
constexpr size_t WS_PROJ = 368 * MiB;
constexpr size_t WS_W1T = 576 * MiB;
constexpr size_t WS_W2T = 832 * MiB;
constexpr size_t WS_ACT = 960 * MiB;
constexpr size_t WS_YK = 1220 * MiB;
constexpr size_t WS_X1 = 1480 * MiB;
constexpr size_t WS_X2 = 1544 * MiB;
constexpr size_t WS_HST2 = 1608 * MiB;
constexpr size_t WS_H8 = 1672 * MiB;
constexpr size_t WS_KTAU4 = 1704 * MiB;
constexpr size_t WS_END = 1708 * MiB;
constexpr int CW_CNT_DUMMY = 1024;
constexpr int CW_BAR = 4096;
constexpr int CW_QKN = 768;
constexpr int CW_HGQ = 640;
constexpr int CW_CNT = 256;

constexpr int LDS_RING = 131072;
constexpr int LDSCTL_OFF = 139264;
constexpr int LDS_BYTES = 163840;
constexpr int LDS_AUX = 131072;
constexpr int AUX_LIST = LDS_AUX, AUX_BIAS = LDS_AUX + 1024, AUX_GATE = LDS_AUX + 3072;
constexpr int LDS_STASH = LDSCTL_OFF + 4096;

__device__ __forceinline__ unsigned f2bf(float f) { unsigned u = __builtin_bit_cast(unsigned, f); return (u + 0x7fffu + ((u >> 16) & 1u)) >> 16; }
__device__ __forceinline__ unsigned pk2(float lo, float hi) { unsigned r; asm("v_cvt_pk_bf16_f32 %0, %1, %2" : "=v"(r) : "v"(lo), "v"(hi)); return r; }
__device__ __forceinline__ float bflo(unsigned w) { return __builtin_bit_cast(float, w << 16); }
__device__ __forceinline__ float bfhi(unsigned w) { return __builtin_bit_cast(float, w & 0xffff0000u); }
__device__ __forceinline__ float bf2f(bf16 v) { return __builtin_bit_cast(float, (unsigned)v << 16); }
#define DPP_F(old, v, ctrl, rm) __builtin_bit_cast(float, __builtin_amdgcn_update_dpp(__builtin_bit_cast(int, (float)(old)), __builtin_bit_cast(int, (float)(v)), (ctrl), (rm), 0xf, false))
__device__ __forceinline__ float wave_sum(float v) {
    v += DPP_F(0.f, v, 0xB1, 0xf);
    v += DPP_F(0.f, v, 0x4E, 0xf);
    v += DPP_F(0.f, v, 0x141, 0xf);
    v += DPP_F(0.f, v, 0x140, 0xf);
    v += DPP_F(0.f, v, 0x142, 0xa);
    v += DPP_F(0.f, v, 0x143, 0xc);
    return __builtin_bit_cast(float, __builtin_amdgcn_readlane(__builtin_bit_cast(int, v), 63));
}
__device__ __forceinline__ float wave_max(float v) {
    v = fmaxf(v, DPP_F(v, v, 0xB1, 0xf));
    v = fmaxf(v, DPP_F(v, v, 0x4E, 0xf));
    v = fmaxf(v, DPP_F(v, v, 0x141, 0xf));
    v = fmaxf(v, DPP_F(v, v, 0x140, 0xf));
    v = fmaxf(v, DPP_F(v, v, 0x142, 0xa));
    v = fmaxf(v, DPP_F(v, v, 0x143, 0xc));
    return __builtin_bit_cast(float, __builtin_amdgcn_readlane(__builtin_bit_cast(int, v), 63));
}
__device__ __forceinline__ float sigmoidf_(float x) { return __builtin_amdgcn_rcpf(1.0f + __expf(-x)); }
__device__ __forceinline__ float siluf_(float x) { return x * __builtin_amdgcn_rcpf(1.0f + __expf(-x)); }
__device__ __forceinline__ float gelu_tanh(float x) { const float u = 0.7978845608028654f * (x + 0.044715f * x * x * x); return x * __builtin_amdgcn_rcpf(1.0f + __expf(-2.0f * u)); }
__device__ __forceinline__ float clamp448(float x) { return __builtin_amdgcn_fmed3f(x, -448.0f, 448.0f); }
__device__ __forceinline__ unsigned pk4_fp8_nc(float a, float b, float c, float d) {
    int w = 0; w = __builtin_amdgcn_cvt_pk_fp8_f32(a, b, w, false); w = __builtin_amdgcn_cvt_pk_fp8_f32(c, d, w, true); return (unsigned)w; }
__device__ __forceinline__ unsigned pk4_fp8(float a, float b, float c, float d) {
    int w = 0; w = __builtin_amdgcn_cvt_pk_fp8_f32(clamp448(a), clamp448(b), w, false); w = __builtin_amdgcn_cvt_pk_fp8_f32(clamp448(c), clamp448(d), w, true); return (unsigned)w; }
constexpr float F8_SW = 256.0f, F8_SH = 16.0f, F8_SA = 4.0f, F8_SY = 64.0f;
#define LDS_WAIT() asm volatile("s_waitcnt lgkmcnt(0)" ::: "memory")
#define VM_WAIT() asm volatile("s_waitcnt vmcnt(0)" ::: "memory")

#define XB_TMO      128
#define XB_XCNT(j)  (256  + 64 * (j))
#define XB_XSUB(j)  (1280 + 64 * (j))
#define XB_XGEN(j)  (2304 + 64 * (j))
#define XB_TOP      3328
#define XB_TOPGEN   3392
#define XCD_BAR_WORDS 3456
#define XB_SPIN_CAP (1u << 18)
__device__ __forceinline__ unsigned xb_ld(unsigned* p)              { return __hip_atomic_load(p, __ATOMIC_RELAXED, __HIP_MEMORY_SCOPE_AGENT); }
__device__ __forceinline__ unsigned xb_add(unsigned* p, unsigned v) { return __hip_atomic_fetch_add(p, v, __ATOMIC_RELAXED, __HIP_MEMORY_SCOPE_AGENT); }
__device__ __forceinline__ unsigned xb_xcc_id() { return (unsigned)__builtin_amdgcn_s_getreg((3 << 11) | 20) & 0xFu; }
#define XB_SPIN(cond, bar) do { unsigned _sp = 0; while (cond) { __builtin_amdgcn_s_sleep(1); \
    if ((++_sp & 255u) == 0u) { if (xb_ld(&(bar)[XB_TMO])) break; if (_sp > XB_SPIN_CAP) { atomicAdd(&(bar)[XB_TMO], 1u); break; } } } } while (0)
struct XcdBarrier { unsigned* bar; unsigned x; volatile LAS unsigned* st; };
__device__ __forceinline__ XcdBarrier xcd_barrier_post(unsigned* bar, volatile LAS unsigned* st) {
    XcdBarrier b; b.bar = bar; b.x = xb_xcc_id(); b.st = st;
    if (threadIdx.x == 0) (void)xb_add(&bar[XB_XCNT(b.x)], 1u);
    return b;
}
__device__ __forceinline__ void xcd_barrier_complete(unsigned* bar, unsigned x, unsigned& nloc, unsigned& nx) {
    const unsigned G = gridDim.x * gridDim.y * gridDim.z;
    unsigned sum, cnt, mine, sp = 0u;
    for (;;) {
        sum = 0u; cnt = 0u; mine = 0u;
#pragma unroll
        for (unsigned j = 0; j < 16; ++j) { const unsigned c = xb_ld(&bar[XB_XCNT(j)]); sum += c; cnt += (c > 0u) ? 1u : 0u; mine = (j == x) ? c : mine; }
        if (sum == G) break;
        __builtin_amdgcn_s_sleep(1);
        if ((++sp & 255u) == 0u) { if (xb_ld(&bar[XB_TMO])) break; if (sp > XB_SPIN_CAP) { atomicAdd(&bar[XB_TMO], 1u); break; } }
    }
    nloc = mine > 0u ? mine : 1u; nx = cnt > 0u ? cnt : 1u;
}
__device__ __forceinline__ void xcd_barrier(const XcdBarrier& b) {
    asm volatile("s_waitcnt vmcnt(0)" ::: "memory");
    __syncthreads();
    if (threadIdx.x == 0) {
        unsigned* bar = b.bar;
        __builtin_amdgcn_s_waitcnt(0);
        unsigned nloc = b.st[0], nx = b.st[1];
        if (nloc == 0u) { xcd_barrier_complete(bar, b.x, nloc, nx); b.st[0] = nloc; b.st[1] = nx; }
        const unsigned old = xb_add(&bar[XB_XSUB(b.x)], 1u);
        const unsigned gen = old / nloc;
        if (old + 1u == (gen + 1u) * nloc) {
            __builtin_amdgcn_fence(__ATOMIC_RELEASE, "agent");
            asm volatile("s_waitcnt vmcnt(0)" ::: "memory");
            const unsigned og = xb_add(&bar[XB_TOP], 1u);
            const unsigned tg = og / nx;
            if (og + 1u == (tg + 1u) * nx) xb_add(&bar[XB_TOPGEN], 1u);
            else XB_SPIN(xb_ld(&bar[XB_TOPGEN]) == tg, bar);
            __builtin_amdgcn_fence(__ATOMIC_ACQUIRE, "agent");
            xb_add(&bar[XB_XGEN(b.x)], 1u);
            asm volatile("s_waitcnt vmcnt(0)" ::: "memory");
        } else {
            XB_SPIN(xb_ld(&bar[XB_XGEN(b.x)]) == gen, bar);
            __builtin_amdgcn_fence(__ATOMIC_ACQUIRE, "agent");
            asm volatile("s_waitcnt vmcnt(0)" ::: "memory");
        }
    }
    __syncthreads();
}

struct Args { const void* in[32]; float* out; unsigned char* ws; int ph_lo, ph_hi, pad0, pad1; };
struct Frame {
    LAS unsigned char* lds; volatile LAS unsigned* CTL; unsigned* ctl;
    int tid, lane, wave, vcu, G;
    unsigned char* ws;
};

__device__ __forceinline__ const void* karg(int k) { asm volatile("" : "+s"(k)); typedef const void* cvp_t; return ((const __attribute__((address_space(4))) cvp_t*)__builtin_amdgcn_kernarg_segment_ptr())[k]; }
#define REFRESH() do { F.ws = (unsigned char*)karg(33); int t_ = threadIdx.x; asm volatile("" : "+v"(t_)); F.tid = t_; F.lane = t_ & 63; F.wave = __builtin_amdgcn_readfirstlane(t_ >> 6); F.ctl = (unsigned*)(F.ws + WS_CTL); } while (0)

namespace gk {
constexpr int BM = 256, BK = 64, HALF = 128, HTB = HALF * BK * 2, STAGE_BYTES = 8 * HTB;
__host__ __device__ __forceinline__ int lds_byte(int r, int c) { const int st = (r >> 4) * 2 + (c >> 5), rr = r & 15, cc = c & 31, ob = rr * 64 + cc * 2; return st * 1024 + (ob ^ (((ob >> 9) & 1) << 5)); }
__host__ __device__ __forceinline__ void stage_rc(int b, int& R, int& C) { const int st = b / 1024, sb = b % 1024, swz = sb ^ (((sb >> 9) & 1) << 5); R = (st >> 1) * 16 + swz / 64; C = (st & 1) * 32 + (swz % 64) / 2; }
__host__ __device__ __forceinline__ int perm32(int rho) { const int n = rho >> 4, i = rho & 15; return 8 * (i >> 2) + 4 * n + (i & 3); }
struct Unit { int pm, pn, e, rows, nt, epi, rt, kind, par; };
typedef f32x4 Acc[2][2][4][2];
__device__ __forceinline__ unsigned cvt_pk_bf16(float lo, float hi) { unsigned r; asm volatile("v_cvt_pk_bf16_f32 %0, %1, %2" : "=v"(r) : "v"(lo), "v"(hi)); return r; }

template <int OFF> __device__ __forceinline__ void dma16(const char* sbase, unsigned voff, unsigned ldsbase) {
    asm volatile("s_add_u32 m0, %2, %3\n\ts_nop 0\n\tglobal_load_lds_dwordx4 %0, %1" :: "v"(voff), "s"(sbase), "s"(ldsbase), "i"(OFF) : "memory", "scc", "m0"); }
__device__ __forceinline__ void stage_coords(int tid, int i, int& R, int& C, int& Rb) { int t2 = tid; asm volatile("" : "+v"(t2)); stage_rc(t2 * 16 + i * 8192, R, C); Rb = (R & ~31) + perm32(R & 31); }
typedef int v4i_t __attribute__((ext_vector_type(4)));
typedef int v8i_t __attribute__((ext_vector_type(8)));
__device__ __forceinline__ v8i_t cat8(bf16x8 lo, bf16x8 hi) { const v4i_t a = __builtin_bit_cast(v4i_t, lo), b = __builtin_bit_cast(v4i_t, hi); return __builtin_shufflevector(a, b, 0, 1, 2, 3, 4, 5, 6, 7); }
template <class P, bool F8 = false>
__device__ __forceinline__ void run(LAS unsigned char* lds, const P& pr, const int xmode = 0) {
    int tid_ = threadIdx.x; asm volatile("" : "+v"(tid_));
    const int tid = tid_, wid = __builtin_amdgcn_readfirstlane(tid >> 6), lane = tid & 63, wr = wid >> 2, wc = wid & 3, fr = lane & 15, fq = lane >> 4;
    const unsigned ldsbw = (unsigned)(uintptr_t)lds + (unsigned)wid * 1024u;
    volatile LAS unsigned* stash = (volatile LAS unsigned*)(lds + LDS_STASH) + tid;
    const int aoff = lds_byte(wr * 64 + fr, fq * 8), boff = lds_byte(wc * 32 + fr, fq * 8);
#define GK_SA(b, h) (((b) * 2 + (h)) * HTB)
#define GK_SB(b, h) ((4 + (b) * 2 + (h)) * HTB)
#define GK_STAGE(bufoff, gbase, v0, v1) do { if (xmode != 3) { dma16<(bufoff)>((const char*)(gbase), (v0), ldsbw); dma16<(bufoff) + 8192>((const char*)(gbase), (v1), ldsbw); } } while (0)
#define GK_LDA(dst, b, h) do { if constexpr (F8) { _Pragma("unroll") for (int m = 0; m < 4; ++m) dst##8[m] = cat8(*(const LAS bf16x8*)(lds + GK_SA(b, h) + aoff + m * 2048), *(const LAS bf16x8*)(lds + GK_SA(b, h) + aoff + m * 2048 + 1024)); } \
        else { _Pragma("unroll") for (int m = 0; m < 4; ++m) _Pragma("unroll") for (int k = 0; k < 2; ++k) dst[m][k] = *(const LAS bf16x8*)(lds + GK_SA(b, h) + aoff + m * 2048 + k * 1024); } } while (0)
#define GK_LDB(dst, b, h) do { if constexpr (F8) { _Pragma("unroll") for (int n = 0; n < 2; ++n) dst##8[n] = cat8(*(const LAS bf16x8*)(lds + GK_SB(b, h) + boff + n * 2048), *(const LAS bf16x8*)(lds + GK_SB(b, h) + boff + n * 2048 + 1024)); } \
        else { _Pragma("unroll") for (int n = 0; n < 2; ++n) _Pragma("unroll") for (int k = 0; k < 2; ++k) dst[n][k] = *(const LAS bf16x8*)(lds + GK_SB(b, h) + boff + n * 2048 + k * 1024); } } while (0)
#define GK_MMA(ai, bj, At, Bt) do { if (xmode == 2) break; __builtin_amdgcn_s_setprio(1); \
        if constexpr (F8) { _Pragma("unroll") for (int m = 0; m < 4; ++m) _Pragma("unroll") for (int n = 0; n < 2; ++n) \
            asm volatile("v_mfma_f32_16x16x128_f8f6f4 %0, %1, %2, %0" : "+v"(acc[ai][bj][m][n]) : "v"(Bt##8[n]), "v"(At##8[m])); } \
        else { _Pragma("unroll") for (int m = 0; m < 4; ++m) _Pragma("unroll") for (int n = 0; n < 2; ++n) _Pragma("unroll") for (int k = 0; k < 2; ++k) \
            acc[ai][bj][m][n] = __builtin_amdgcn_mfma_f32_16x16x32_bf16(Bt[n][k], At[m][k], acc[ai][bj][m][n], 0, 0, 0); } \
        __builtin_amdgcn_s_setprio(0); } while (0)
#define GK_PIECE(off, gbase, v) do { if (xmode != 3) dma16<(off)>((const char*)(gbase), (v), ldsbw); } while (0)
#define GK_NOP_ (void)0
#define GK_MMA3(ai, bj, At, Bt, S0, S1, S2) do { __builtin_amdgcn_s_setprio(1); \
        if constexpr (F8) { _Pragma("unroll") for (int q = 0; q < 8; ++q) { const int m = q >> 1, n = q & 1; \
            if (xmode != 2) asm volatile("v_mfma_f32_16x16x128_f8f6f4 %0, %1, %2, %0" : "+v"(acc[ai][bj][m][n]) : "v"(Bt##8[n]), "v"(At##8[m])); \
            if (q == 1) { S0; } if (q == 3) { S1; } if (q == 5) { S2; } } } \
        else { _Pragma("unroll") for (int q = 0; q < 16; ++q) { const int m = q >> 2, n = (q >> 1) & 1, k = q & 1; \
            if (xmode != 2) acc[ai][bj][m][n] = __builtin_amdgcn_mfma_f32_16x16x32_bf16(Bt[n][k], At[m][k], acc[ai][bj][m][n], 0, 0, 0); \
            if (q == 3) { S0; } if (q == 7) { S1; } if (q == 11) { S2; } } } \
        __builtin_amdgcn_s_setprio(0); } while (0)
#define GK_WAIT_V(n) asm volatile("s_waitcnt vmcnt(" #n ")" ::: "memory")
#define GK_WAIT_L(n) asm volatile("s_waitcnt lgkmcnt(" #n ")" ::: "memory")
#define GK_BAR __builtin_amdgcn_s_barrier()
#define GK_SCHED __builtin_amdgcn_sched_barrier(0)
#define GK_ZERO() do { _Pragma("unroll") for (int a = 0; a < 2; ++a) _Pragma("unroll") for (int b = 0; b < 2; ++b) _Pragma("unroll") for (int m = 0; m < 4; ++m) _Pragma("unroll") for (int n = 0; n < 2; ++n) acc[a][b][m][n] = (f32x4){0.f, 0.f, 0.f, 0.f}; } while (0)
    Unit cur, nxt; int ui = 0;
    if (!pr.next(0, cur)) return;
    cur.par = 0;
    Acc acc; GK_ZERO();
    bf16x8 At[4][2], B0[2][2], B1[2][2]; v8i_t At8[4], B08[2], B18[2];
    (void)At; (void)B0; (void)B1; (void)At8; (void)B08; (void)B18;
    const char *cA, *cB; unsigned cvA[2][2], cvB[2]; unsigned ckA, ckB, chB;
    pr.setupA(cur, tid, cA, cvA, ckA); pr.setupB(cur, tid, cB, cvB, ckB, chB);
    GK_STAGE(GK_SB(0, 0), cB, cvB[0], cvB[1]); GK_STAGE(GK_SB(0, 1), cB + chB, cvB[0], cvB[1]); GK_STAGE(GK_SA(0, 0), cA, cvA[0][0], cvA[0][1]); GK_STAGE(GK_SA(0, 1), cA, cvA[1][0], cvA[1][1]);
    if (wr == 1) GK_BAR;
    GK_WAIT_V(2); GK_BAR;
    GK_STAGE(GK_SB(1, 0), cB + ckB, cvB[0], cvB[1]); GK_STAGE(GK_SA(1, 0), cA + ckA, cvA[0][0], cvA[0][1]); GK_STAGE(GK_SB(1, 1), cB + chB + ckB, cvB[0], cvB[1]);
    GK_WAIT_V(6); GK_BAR;
    for (;;) {
        const bool has_next = pr.next(ui + 1, nxt);
        nxt.par = (ui + 1) & 1;
        if constexpr (P::AUX != 0) pr.aux_issue(cur, nxt, has_next, wid, lane, (unsigned)(uintptr_t)lds);
        const char *nA = cA, *nB = cB; unsigned nkA = ckA, nkB = ckB, nhB = chB;
        {
            unsigned nvA[2][2] = {{cvA[0][0], cvA[0][1]}, {cvA[1][0], cvA[1][1]}}, nvB[2] = {cvB[0], cvB[1]};
            if (has_next) { if constexpr (P::AUX != 1) pr.setupA(nxt, tid, nA, nvA, nkA); pr.setupB(nxt, tid, nB, nvB, nkB, nhB); }
            if constexpr (P::AUX != 1) { stash[0] = nvA[0][0]; stash[512] = nvA[0][1]; stash[1024] = nvA[1][0]; stash[1536] = nvA[1][1]; }
            stash[2048] = nvB[0]; stash[2560] = nvB[1];
        }
        const int nt = cur.nt;
        for (int t = 0; t < nt; t += 2) {
            const bool last = (t == nt - 2);
            const char* a1 = cA + (size_t)((unsigned)(t + 1) * ckA);
            const char* a2 = last ? nA : cA + (size_t)((unsigned)(t + 2) * ckA); const char* b2 = last ? nB : cB + (size_t)((unsigned)(t + 2) * ckB);
            const unsigned k2A = last ? nkA : ckA, k2B = last ? nkB : ckB, h2B = last ? nhB : chB;
            const char* a3 = a2 + k2A; const char* b3 = b2 + k2B;
            unsigned wA00 = cvA[0][0], wA01 = cvA[0][1], wA10 = cvA[1][0], wA11 = cvA[1][1], wB0 = cvB[0], wB1 = cvB[1];
            if (last) { wA00 = stash[0]; wA01 = stash[512]; wA10 = stash[1024]; wA11 = stash[1536]; wB0 = stash[2048]; wB1 = stash[2560]; }
            GK_LDB(B0, 0, 0); GK_LDB(B1, 0, 1); GK_SCHED; GK_LDA(At, 0, 0);
            GK_WAIT_V(6); GK_BAR;
            GK_MMA3(0, 0, At, B0, GK_PIECE(GK_SA(1, 1), a1, cvA[1][0]), GK_PIECE(GK_SA(1, 1) + 8192, a1, cvA[1][1]), GK_NOP_); GK_MMA(0, 1, At, B1); GK_BAR; GK_SCHED;
            GK_LDA(At, 0, 1);
            GK_WAIT_V(2); GK_BAR;
            GK_MMA3(1, 0, At, B0, GK_PIECE(GK_SB(0, 0), b2, wB0), GK_PIECE(GK_SB(0, 0) + 8192, b2, wB1), GK_PIECE(GK_SB(0, 1), b2 + h2B, wB0));
            GK_MMA3(1, 1, At, B1, GK_PIECE(GK_SB(0, 1) + 8192, b2 + h2B, wB1), GK_PIECE(GK_SA(0, 0), a2, wA00), GK_PIECE(GK_SA(0, 0) + 8192, a2, wA01)); GK_BAR; GK_SCHED;
            GK_LDB(B0, 1, 0); GK_LDB(B1, 1, 1); GK_SCHED; GK_LDA(At, 1, 0);
            GK_WAIT_V(6); GK_BAR;
            GK_MMA3(0, 0, At, B0, GK_PIECE(GK_SA(0, 1), a2, wA10), GK_PIECE(GK_SA(0, 1) + 8192, a2, wA11), GK_NOP_); GK_MMA(0, 1, At, B1); GK_BAR; GK_SCHED;
            GK_LDA(At, 1, 1);
            GK_WAIT_V(2); GK_BAR;
            GK_MMA3(1, 0, At, B0, GK_PIECE(GK_SB(1, 0), b3, wB0), GK_PIECE(GK_SB(1, 0) + 8192, b3, wB1), GK_PIECE(GK_SB(1, 1), b3 + h2B, wB0));
            GK_MMA3(1, 1, At, B1, GK_PIECE(GK_SB(1, 1) + 8192, b3 + h2B, wB1), GK_PIECE(GK_SA(1, 0), a3, wA00), GK_PIECE(GK_SA(1, 0) + 8192, a3, wA01)); GK_BAR; GK_SCHED;
            if constexpr (P::AUX == 1) { if (t == 0) { unsigned nvA[2][2]; pr.lateA(nxt, has_next, tid, lds, nvA); stash[0] = nvA[0][0]; stash[512] = nvA[0][1]; stash[1024] = nvA[1][0]; stash[1536] = nvA[1][1]; } }
        }
        if constexpr (F8) asm volatile("s_nop 15\n\ts_nop 15" ::: "memory");
        if (cur.epi) { if (wr == 0) GK_BAR; if (xmode != 1) pr.epi(acc, cur, wr, wc, fr, fq); }
        if (!has_next) break;
        if (cur.epi) GK_ZERO();
        const int had_epi = cur.epi;
        cur = nxt; cA = nA; cB = nB; ckA = nkA; ckB = nkB; chB = nhB;
        cvA[0][0] = stash[0]; cvA[0][1] = stash[512]; cvA[1][0] = stash[1024]; cvA[1][1] = stash[1536]; cvB[0] = stash[2048]; cvB[1] = stash[2560];
        ++ui;
        if (had_epi) { if (wr == 1) GK_BAR; }
    }
    GK_WAIT_V(0);
    if (!cur.epi) { if (wr == 0) GK_BAR; }
    GK_BAR;
}
}

__device__ __forceinline__ bool reg_order(int i, int G, int c, int nM, int nN, int& pm, int& pn) {
    const long L = (long)i * G + c; if (L >= (long)nM * nN) return false;
    const int nig = 8 * nN, gid = (int)(L / nig), r = (int)(L % nig); pm = gid * 8 + (r % 8); pn = r / 8; return true;
}
struct RegAB {
    static constexpr int AUX = 0;
    const bf16* A; const bf16* Bt; int pitchA, pitchB;
    __device__ __forceinline__ void setupA(const gk::Unit& u, int tid, const char*& base, unsigned (&vo)[2][2], unsigned& kstep) const {
        base = (const char*)A + (size_t)u.pm * 256 * pitchA * 2; kstep = 128;
#pragma unroll
        for (int h = 0; h < 2; ++h)
#pragma unroll
            for (int i = 0; i < 2; ++i) { int R_, C_, Rb_; gk::stage_coords(tid, i, R_, C_, Rb_); (void)R_; (void)Rb_; vo[h][i] = (unsigned)((h * 128 + R_) * pitchA + C_) * 2u; }
    }
    __device__ __forceinline__ void setupB(const gk::Unit& u, int tid, const char*& base, unsigned (&vo)[2], unsigned& kstep, unsigned& hstep) const {
        base = (const char*)Bt + (size_t)u.pn * 256 * pitchB * 2; kstep = 128; hstep = 128u * pitchB * 2u;
#pragma unroll
        for (int i = 0; i < 2; ++i) { int R_, C_, Rb_; gk::stage_coords(tid, i, R_, C_, Rb_); (void)R_; (void)Rb_; vo[i] = (unsigned)(Rb_ * pitchB + C_) * 2u; }
    }
};

struct ProjProb {
    static constexpr int AUX = 0;
    const unsigned char* A; const unsigned char* Bt; bf16* O; const int* pos; int G, c;
    __device__ __forceinline__ bool next(int i, gk::Unit& u) const { int n8 = 8; asm volatile("" : "+s"(n8)); u.nt = n8; u.epi = 1; u.e = 0; u.rows = 256; u.rt = 0; u.kind = 0; return reg_order(i, G, c, NT / 256, NPROJ / 256, u.pm, u.pn); }
    __device__ __forceinline__ void setupA(const gk::Unit& u, int tid, const char*& base, unsigned (&vo)[2][2], unsigned& kstep) const {
        base = (const char*)A + (size_t)u.pm * 256 * DM; kstep = 128;
#pragma unroll
        for (int h = 0; h < 2; ++h)
#pragma unroll
            for (int i = 0; i < 2; ++i) { int R_, C_, Rb_; gk::stage_coords(tid, i, R_, C_, Rb_); (void)Rb_; vo[h][i] = (unsigned)((h * 128 + R_) * DM + C_ * 2); }
    }
    __device__ __forceinline__ void setupB(const gk::Unit& u, int tid, const char*& base, unsigned (&vo)[2], unsigned& kstep, unsigned& hstep) const {
        base = (const char*)Bt + (size_t)u.pn * 256 * DM; kstep = 128; hstep = 128u * DM;
#pragma unroll
        for (int i = 0; i < 2; ++i) { int R_, C_, Rb_; gk::stage_coords(tid, i, R_, C_, Rb_); (void)R_; vo[i] = (unsigned)(Rb_ * DM + C_ * 2); }
    }
    __device__ __forceinline__ void epi(const gk::Acc& acc, const gk::Unit& u, int wr, int wc, int fr, int fq) const {
        int row0 = u.pm * 256 + wr * 64 + fr, col0 = u.pn * 256 + wc * 32 + 8 * fq; asm volatile("" : "+v"(row0), "+v"(col0));
        const bool rope = (u.pn == 9 || u.pn == 10) && (fq == 0);
        const float sc = ((u.pn == 0) ? 0.125f * LOG2E : ((u.pn == 9) ? 0.17677669529663687f * LOG2E : 1.0f)) * (1.0f / (F8_SW * F8_SH));
#pragma unroll
        for (int ai = 0; ai < 2; ++ai)
#pragma unroll
            for (int m = 0; m < 4; ++m) {
                const int row = row0 + ai * 128 + m * 16;
                float cs[4], sn[4];
                if (u.pn == 9 || u.pn == 10) {
                    const float p = (float)pos[row];
#pragma unroll
                    for (int j = 0; j < 4; ++j) { const float inv = (j == 0) ? 1.0f : (j == 1 ? 0.03760603093086394f : (j == 2 ? 0.0014142135623730951f : 5.318295896944989e-05f)); __sincosf(p * inv, &sn[j], &cs[j]); }
                }
                bf16* rowp = O + (size_t)row * NPROJ + col0;
#pragma unroll
                for (int bj = 0; bj < 2; ++bj) {
                    f32x4 v0 = acc[ai][bj][m][0], v1 = acc[ai][bj][m][1];
                    if (rope) {
#pragma unroll
                        for (int j = 0; j < 4; ++j) { const float x1 = v0[j], x2 = v1[j]; v0[j] = x1 * cs[j] - x2 * sn[j]; v1[j] = x2 * cs[j] + x1 * sn[j]; }
                    }
                    v0 = v0 * sc; v1 = v1 * sc;
                    u32x4 w; w.x = gk::cvt_pk_bf16(v0[0], v0[1]); w.y = gk::cvt_pk_bf16(v0[2], v0[3]); w.z = gk::cvt_pk_bf16(v1[0], v1[1]); w.w = gk::cvt_pk_bf16(v1[2], v1[3]);
                    *(u32x4*)(rowp + bj * 128) = w;
                }
            }
    }
};
struct PlainProb : RegAB {
    bf16* O; int ldc, nM, nN, G, c;
    __device__ __forceinline__ bool next(int i, gk::Unit& u) const { u.nt = pitchA / 64; u.epi = 1; u.e = 0; u.rows = 256; u.rt = 0; u.kind = 0; return reg_order(i, G, c, nM, nN, u.pm, u.pn); }
    __device__ __forceinline__ void epi(const gk::Acc& acc, const gk::Unit& u, int wr, int wc, int fr, int fq) const {
        int row0 = u.pm * 256 + wr * 64 + fr, col0 = u.pn * 256 + wc * 32 + 8 * fq; asm volatile("" : "+v"(row0), "+v"(col0));
#pragma unroll
        for (int ai = 0; ai < 2; ++ai)
#pragma unroll
            for (int m = 0; m < 4; ++m) {
                bf16* rowp = O + (size_t)(row0 + ai * 128 + m * 16) * ldc + col0;
#pragma unroll
                for (int bj = 0; bj < 2; ++bj) {
                    const f32x4 v0 = acc[ai][bj][m][0], v1 = acc[ai][bj][m][1];
                    u32x4 w; w.x = gk::cvt_pk_bf16(v0[0], v0[1]); w.y = gk::cvt_pk_bf16(v0[2], v0[3]); w.z = gk::cvt_pk_bf16(v1[0], v1[1]); w.w = gk::cvt_pk_bf16(v1[2], v1[3]);
                    *(u32x4*)(rowp + bj * 128) = w;
                }
            }
    }
};
struct GluProb : RegAB {
    bf16* O; int G, c;
    __device__ __forceinline__ bool next(int i, gk::Unit& u) const { int n4 = 4; asm volatile("" : "+s"(n4)); u.nt = n4; u.epi = 1; u.e = 0; u.rows = 256; u.rt = 0; u.kind = 0; return reg_order(i, G, c, NT / 256, 2, u.pm, u.pn); }
    __device__ __forceinline__ void epi(const gk::Acc& acc, const gk::Unit& u, int wr, int wc, int fr, int fq) const {
        int row0 = u.pm * 256 + wr * 64 + fr, col0 = u.pn * 256 + wc * 32 + 8 * fq; asm volatile("" : "+v"(row0), "+v"(col0));
#pragma unroll
        for (int ai = 0; ai < 2; ++ai)
#pragma unroll
            for (int m = 0; m < 4; ++m) {
                bf16* rowp = O + (size_t)(row0 + ai * 128 + m * 16) * DM + 768 + (col0 >> 1);
#pragma unroll
                for (int bj = 0; bj < 2; ++bj) {
                    const f32x4 v0 = acc[ai][bj][m][0], v1 = acc[ai][bj][m][1];
                    u32x2 w; w.x = pk2(v0[0] * sigmoidf_(v0[1]), v0[2] * sigmoidf_(v0[3])); w.y = pk2(v1[0] * sigmoidf_(v1[1]), v1[2] * sigmoidf_(v1[3]));
                    *(u32x2*)(rowp + bj * 64) = w;
                }
                __builtin_amdgcn_sched_barrier(0);
            }
    }
};
__device__ __forceinline__ void s5_setupA(const bf16* proj, int pair, int pm, int tid, const char*& base, unsigned (&vo)[2][2], unsigned& kstep) {
    base = (const char*)proj + ((size_t)pm * 256 * S5L * NPROJ + C_SU + pair * 32) * 2; kstep = 2u * NPROJ * 2u;
#pragma unroll
    for (int h = 0; h < 2; ++h)
#pragma unroll
        for (int i = 0; i < 2; ++i) { int R_, C_, Rb_; gk::stage_coords(tid, i, R_, C_, Rb_); (void)R_; (void)Rb_; vo[h][i] = (unsigned)(((h * 128 + R_) * S5L + (C_ >> 5)) * NPROJ + (C_ & 31)) * 2u; }
}
struct S5EProb {
    static constexpr int AUX = 0;
    const bf16* proj; const bf16* Ebt; float* xloc; int G, c;
    __device__ __forceinline__ bool next(int i, gk::Unit& u) const { const int L = i * G + c; if (L >= 32) return false; u.e = L >> 2; u.pm = L & 3; u.pn = 0; u.nt = 16; u.epi = 1; u.rows = 256; u.rt = 0; u.kind = 0; return true; }
    __device__ __forceinline__ void setupA(const gk::Unit& u, int tid, const char*& base, unsigned (&vo)[2][2], unsigned& kstep) const { s5_setupA(proj, u.e, u.pm, tid, base, vo, kstep); }
    __device__ __forceinline__ void setupB(const gk::Unit& u, int tid, const char*& base, unsigned (&vo)[2], unsigned& kstep, unsigned& hstep) const {
        base = (const char*)Ebt + (size_t)u.e * 256 * 1024 * 2; kstep = 128; hstep = 128u * 1024u * 2u;
#pragma unroll
        for (int i = 0; i < 2; ++i) { int R_, C_, Rb_; gk::stage_coords(tid, i, R_, C_, Rb_); (void)R_; (void)Rb_; vo[i] = (unsigned)(Rb_ * 1024 + C_) * 2u; }
    }
    __device__ __forceinline__ void epi(const gk::Acc& acc, const gk::Unit& u, int wr, int wc, int fr, int fq) const {
        int row0 = u.pm * 256 + wr * 64 + fr, col0 = wc * 32 + 8 * fq; asm volatile("" : "+v"(row0), "+v"(col0));
#pragma unroll
        for (int ai = 0; ai < 2; ++ai)
#pragma unroll
            for (int m = 0; m < 4; ++m) {
                float* rowp = xloc + (size_t)(row0 + ai * 128 + m * 16) * 2048 + u.e * 256 + col0;
#pragma unroll
                for (int bj = 0; bj < 2; ++bj) { *(f32x4*)(rowp + bj * 128) = acc[ai][bj][m][0]; *(f32x4*)(rowp + bj * 128 + 4) = acc[ai][bj][m][1]; }
            }
    }
};
struct S5FMProb {
    static constexpr int AUX = 0;
    const bf16* proj; const bf16* xin; const bf16* Fbt; const bf16* Mbt; bf16* ygelu; int G, c;
    __device__ __forceinline__ bool next(int i, gk::Unit& u) const {
        const int L = (i >> 1) * G + c; if (L >= 128) return false;
        u.e = L >> 4; u.pm = (L >> 2) & 3; u.pn = L & 3; u.kind = i & 1; u.epi = u.kind; u.nt = u.kind ? 4 * (u.pn + 1) : 4; u.rows = 256; u.rt = 0; return true;
    }
    __device__ __forceinline__ void setupA(const gk::Unit& u, int tid, const char*& base, unsigned (&vo)[2][2], unsigned& kstep) const {
        if (u.kind) { s5_setupA(proj, u.e, u.pm, tid, base, vo, kstep); }
        else { base = (const char*)xin + ((size_t)u.pm * 256 * 2048 + u.e * 256) * 2; kstep = 128;
#pragma unroll
            for (int h = 0; h < 2; ++h)
#pragma unroll
                for (int i = 0; i < 2; ++i) { int R_, C_, Rb_; gk::stage_coords(tid, i, R_, C_, Rb_); (void)R_; (void)Rb_; vo[h][i] = (unsigned)((h * 128 + R_) * 2048 + C_) * 2u; } }
    }
    __device__ __forceinline__ void setupB(const gk::Unit& u, int tid, const char*& base, unsigned (&vo)[2], unsigned& kstep, unsigned& hstep) const {
        const int pitch = u.kind ? 1024 : 256;
        base = (const char*)(u.kind ? Mbt : Fbt) + ((size_t)u.e * 1024 + u.pn * 256) * pitch * 2; kstep = 128; hstep = 128u * pitch * 2u;
#pragma unroll
        for (int i = 0; i < 2; ++i) { int R_, C_, Rb_; gk::stage_coords(tid, i, R_, C_, Rb_); (void)R_; (void)Rb_; vo[i] = (unsigned)(Rb_ * pitch + C_) * 2u; }
    }
    __device__ __forceinline__ void epi(const gk::Acc& acc, const gk::Unit& u, int wr, int wc, int fr, int fq) const {
        int row0 = u.pm * 256 + wr * 64 + fr; asm volatile("" : "+v"(row0));
#pragma unroll
        for (int bj = 0; bj < 2; ++bj) {
            const int ncol = u.pn * 256 + bj * 128 + wc * 32 + 8 * fq, t = ncol >> 5, c32 = ncol & 31;
#pragma unroll
            for (int ai = 0; ai < 2; ++ai)
#pragma unroll
                for (int m = 0; m < 4; ++m) {
                    const int row = row0 + ai * 128 + m * 16;
                    const f32x4 v0 = acc[ai][bj][m][0], v1 = acc[ai][bj][m][1];
                    u32x4 w; w.x = pk2(gelu_tanh(v0[0]), gelu_tanh(v0[1])); w.y = pk2(gelu_tanh(v0[2]), gelu_tanh(v0[3])); w.z = pk2(gelu_tanh(v1[0]), gelu_tanh(v1[1])); w.w = pk2(gelu_tanh(v1[2]), gelu_tanh(v1[3]));
                    *(u32x4*)(ygelu + ((size_t)row * S5L + t) * 256 + u.e * 32 + c32) = w;
                    __builtin_amdgcn_sched_barrier(0);
                }
        }
    }
};
__device__ __forceinline__ void moe_tables(Frame& F, const unsigned* cnt) {
    if (F.wave == 0) {
        const int c = (F.lane < 32) ? (int)cnt[F.lane] : 0;
        const int tl = (c + 255) >> 8;
        int ps = c, pt = tl;
#pragma unroll
        for (int o = 1; o < 32; o <<= 1) { const int a = __shfl_up(ps, o), b = __shfl_up(pt, o); if (F.lane >= o) { ps += a; pt += b; } }
        if (F.lane < 32) { F.CTL[16 + F.lane + 1] = (unsigned)pt; F.CTL[64 + F.lane + 1] = (unsigned)ps; F.CTL[128 + F.lane] = (unsigned)c; }
        if (F.lane == 0) { F.CTL[16] = 0u; F.CTL[64] = 0u; }
    }
    __syncthreads();
    {
        const int ntl = (int)F.CTL[16 + 32];
        for (int tl = F.tid; tl < ntl; tl += NTHR) { int e = 0;
#pragma unroll
            for (int st = 16; st >= 1; st >>= 1) if ((int)F.CTL[16 + e + st] <= tl) e += st;
            F.CTL[256 + tl] = (unsigned)e; }
    }
    __syncthreads();
}
__device__ __forceinline__ bool moe_next(volatile LAS unsigned* CTL, int i, int G, int c, int nct, gk::Unit& u) {
    const int L = i * G + c, tl = L / nct; u.pn = L % nct;
    if (tl >= (int)CTL[16 + 32]) return false;
    const int e = __builtin_amdgcn_readfirstlane((int)CTL[256 + tl]);
    u.e = e; u.rt = tl - (int)CTL[16 + e]; u.rows = (int)CTL[128 + e] - 256 * u.rt; if (u.rows > 256) u.rows = 256;
    u.pm = (int)CTL[64 + e] + 256 * u.rt;
    u.nt = 16; u.epi = 1; u.kind = 0; return true;
}
struct Moe1Prob {
    static constexpr int AUX = 1;
    const unsigned char* h8; const unsigned char* w1t; const float* b1; const int* lists; unsigned char* act; volatile LAS unsigned* CTL; LAS unsigned char* lds; int G, c;
    __device__ __forceinline__ void aux_issue(const gk::Unit& cur, const gk::Unit& nxt, bool has_next, int wid, int lane, unsigned ldsb) const {
        if (wid == 0) { if (has_next) { const int off = __builtin_amdgcn_readfirstlane(nxt.e * NT + 256 * nxt.rt); gk::dma16<0>((const char*)(lists + off), (unsigned)lane * 16u, ldsb + AUX_LIST); } }
        else if (wid == 1) { const int off = __builtin_amdgcn_readfirstlane(cur.e * 2048 + cur.pn * 256); gk::dma16<0>((const char*)(b1 + off), (unsigned)lane * 16u, ldsb + AUX_BIAS + cur.par * 1024); }
    }
    __device__ __forceinline__ void lateA(const gk::Unit& u, bool has_next, int tid, LAS unsigned char* l, unsigned (&vo)[2][2]) const {
        const LAS int* li = (const LAS int*)(l + AUX_LIST); const int rows = has_next ? u.rows : 1;
#pragma unroll
        for (int h = 0; h < 2; ++h)
#pragma unroll
            for (int i = 0; i < 2; ++i) { int R_, C_, Rb_; gk::stage_coords(tid, i, R_, C_, Rb_); (void)Rb_; const int r = h * 128 + R_; const int tk = has_next ? li[r < rows ? r : 0] : 0; vo[h][i] = (unsigned)((tk >> 2) * DM + C_ * 2); }
    }
    __device__ __forceinline__ bool next(int i, gk::Unit& u) const { const bool ok = moe_next(CTL, i, G, c, 8, u); int n8 = 8; asm volatile("" : "+s"(n8)); u.nt = n8; return ok; }
    __device__ __forceinline__ void setupA(const gk::Unit& u, int tid, const char*& base, unsigned (&vo)[2][2], unsigned& kstep) const {
        base = (const char*)h8; kstep = 128;
        const int* li = lists + (size_t)u.e * NT + 256 * u.rt;
#pragma unroll
        for (int h = 0; h < 2; ++h)
#pragma unroll
            for (int i = 0; i < 2; ++i) { int R_, C_, Rb_; gk::stage_coords(tid, i, R_, C_, Rb_); (void)Rb_; const int r = h * 128 + R_; const int tk = li[r < u.rows ? r : 0]; vo[h][i] = (unsigned)((tk >> 2) * DM + C_ * 2); }
    }
    __device__ __forceinline__ void setupB(const gk::Unit& u, int tid, const char*& base, unsigned (&vo)[2], unsigned& kstep, unsigned& hstep) const {
        base = (const char*)w1t + ((size_t)u.e * 2048 + u.pn * 256) * 1024; kstep = 128; hstep = 128u * 1024u;
#pragma unroll
        for (int i = 0; i < 2; ++i) { int R_, C_, Rb_; gk::stage_coords(tid, i, R_, C_, Rb_); (void)R_; vo[i] = (unsigned)(Rb_ * 1024 + C_ * 2); }
    }
    __device__ __forceinline__ void epi(const gk::Acc& acc, const gk::Unit& u, int wr, int wc, int fr, int fq) const {
        int r0 = wr * 64 + fr, col0 = u.pn * 256 + wc * 32 + 8 * fq; asm volatile("" : "+v"(r0), "+v"(col0));
        constexpr float US = 1.0f / (F8_SW * F8_SH);
        f32x4 bv[2][2];
#pragma unroll
        for (int bj = 0; bj < 2; ++bj)
#pragma unroll
            for (int n = 0; n < 2; ++n) bv[bj][n] = *(const LAS f32x4*)(lds + AUX_BIAS + u.par * 1024 + (wc * 32 + 8 * fq + bj * 128 + 4 * n) * 4);
#pragma unroll
        for (int ai = 0; ai < 2; ++ai)
#pragma unroll
            for (int m = 0; m < 4; ++m) {
                const int r = r0 + ai * 128 + m * 16;
                if (r < u.rows) {
                    unsigned char* rowp = act + (size_t)(u.pm + r) * DM + (col0 >> 1);
#pragma unroll
                    for (int bj = 0; bj < 2; ++bj) {
                        const f32x4 v0 = acc[ai][bj][m][0] * US + bv[bj][0], v1 = acc[ai][bj][m][1] * US + bv[bj][1];
                        float o[4];
#pragma unroll
                        for (int j = 0; j < 4; ++j) { const float gl = fminf(j < 2 ? v0[2 * j] : v1[2 * j - 4], 7.0f); float ln = j < 2 ? v0[2 * j + 1] : v1[2 * j - 3]; ln = __builtin_amdgcn_fmed3f(ln, -7.0f, 7.0f);
                            o[j] = (gl * __builtin_amdgcn_rcpf(1.0f + __builtin_amdgcn_exp2f((-1.702f * LOG2E) * gl))) * __builtin_fmaf(ln, F8_SA, F8_SA); }
                        *(unsigned*)(rowp + bj * 64) = pk4_fp8_nc(o[0], o[1], o[2], o[3]);
                    }
                }
                __builtin_amdgcn_sched_barrier(0);
            }
    }
};
struct Moe2Prob {
    static constexpr int AUX = 2;
    const unsigned char* act; const unsigned char* w2t; const float* b2; const float* wslot; unsigned char* yk; volatile LAS unsigned* CTL; LAS unsigned char* lds; int G, c;
    __device__ __forceinline__ void aux_issue(const gk::Unit& cur, const gk::Unit& nxt, bool has_next, int wid, int lane, unsigned ldsb) const {
        (void)nxt; (void)has_next;
        if (wid == 1) { const int off = __builtin_amdgcn_readfirstlane(cur.e * 1024 + cur.pn * 256); gk::dma16<0>((const char*)(b2 + off), (unsigned)lane * 16u, ldsb + AUX_BIAS + cur.par * 1024); }
        else if (wid == 2) { const int off = __builtin_amdgcn_readfirstlane(cur.e * NT + 256 * cur.rt); gk::dma16<0>((const char*)(wslot + off), (unsigned)lane * 16u, ldsb + AUX_GATE + cur.par * 1024); }
    }
    __device__ __forceinline__ bool next(int i, gk::Unit& u) const { const bool ok = moe_next(CTL, i, G, c, 4, u); int n8 = 8; asm volatile("" : "+s"(n8)); u.nt = n8; return ok; }
    __device__ __forceinline__ void setupA(const gk::Unit& u, int tid, const char*& base, unsigned (&vo)[2][2], unsigned& kstep) const {
        base = (const char*)act + (size_t)u.pm * DM; kstep = 128;
#pragma unroll
        for (int h = 0; h < 2; ++h)
#pragma unroll
            for (int i = 0; i < 2; ++i) { int R_, C_, Rb_; gk::stage_coords(tid, i, R_, C_, Rb_); (void)Rb_; vo[h][i] = (unsigned)((h * 128 + R_) * DM + C_ * 2); }
    }
    __device__ __forceinline__ void setupB(const gk::Unit& u, int tid, const char*& base, unsigned (&vo)[2], unsigned& kstep, unsigned& hstep) const {
        base = (const char*)w2t + ((size_t)u.e * 1024 + u.pn * 256) * 1024; kstep = 128; hstep = 128u * 1024u;
#pragma unroll
        for (int i = 0; i < 2; ++i) { int R_, C_, Rb_; gk::stage_coords(tid, i, R_, C_, Rb_); (void)R_; vo[i] = (unsigned)(Rb_ * 1024 + C_ * 2); }
    }
    __device__ __forceinline__ void epi(const gk::Acc& acc, const gk::Unit& u, int wr, int wc, int fr, int fq) const {
        int r0 = wr * 64 + fr, col0 = u.pn * 256 + wc * 32 + 8 * fq; asm volatile("" : "+v"(r0), "+v"(col0));
        constexpr float US = 1.0f / (F8_SW * F8_SA);
        f32x4 bv[2][2];
#pragma unroll
        for (int bj = 0; bj < 2; ++bj)
#pragma unroll
            for (int n = 0; n < 2; ++n) bv[bj][n] = *(const LAS f32x4*)(lds + AUX_BIAS + u.par * 1024 + (wc * 32 + 8 * fq + bj * 128 + 4 * n) * 4);
        float gwv[2][4];
#pragma unroll
        for (int ai = 0; ai < 2; ++ai)
#pragma unroll
            for (int m = 0; m < 4; ++m) { const int r = r0 + ai * 128 + m * 16; gwv[ai][m] = *(const LAS float*)(lds + AUX_GATE + u.par * 1024 + r * 4); }
#pragma unroll
        for (int ai = 0; ai < 2; ++ai)
#pragma unroll
            for (int m = 0; m < 4; ++m) {
                const int r = r0 + ai * 128 + m * 16;
                if (r < u.rows) {
                    const float gw = gwv[ai][m];
                    unsigned char* rowp = yk + (size_t)(u.pm + r) * DM + col0;
#pragma unroll
                    for (int bj = 0; bj < 2; ++bj) {
                        const f32x4 v0 = (acc[ai][bj][m][0] * US + bv[bj][0]) * (gw * F8_SY), v1 = (acc[ai][bj][m][1] * US + bv[bj][1]) * (gw * F8_SY);
                        *(u32x2*)(rowp + bj * 128) = (u32x2){pk4_fp8(v0[0], v0[1], v0[2], v0[3]), pk4_fp8(v1[0], v1[1], v1[2], v1[3])};
                    }
                }
            }
    }
};

namespace att {
__device__ __forceinline__ void glds16(const void* gsrc, unsigned lds_dst) {
    asm volatile("s_mov_b32 m0, %1\n\ts_nop 0\n\tglobal_load_lds_dwordx4 %0, off" :: "v"(gsrc), "s"(lds_dst) : "memory", "m0"); }
__device__ __forceinline__ void glds4(const void* gsrc, unsigned lds_dst) {
    asm volatile("s_mov_b32 m0, %1\n\ts_nop 0\n\tglobal_load_lds_dword %0, off" :: "v"(gsrc), "s"(lds_dst) : "memory", "m0"); }
typedef short v4i16_t __attribute__((ext_vector_type(4)));
__device__ __forceinline__ s16x4 vtr(const LAS char* p) { return __builtin_bit_cast(s16x4, __builtin_amdgcn_ds_read_tr16_b64_v4i16((LAS v4i16_t*)p)); }
__device__ __forceinline__ int crow(int r, int hi) { return (r & 3) + 8 * (r >> 2) + 4 * hi; }
__device__ __forceinline__ float swapmax(float m) { auto rr = __builtin_amdgcn_permlane32_swap(__float_as_uint(m), __float_as_uint(m), false, false); return fmaxf(__uint_as_float(rr[0]), __uint_as_float(rr[1])); }
__device__ __forceinline__ float swapadd(float m) { auto rr = __builtin_amdgcn_permlane32_swap(__float_as_uint(m), __float_as_uint(m), false, false); return __uint_as_float(rr[0]) + __uint_as_float(rr[1]); }
constexpr int SLOTB = 8192, LDS_K = 0, LDS_V = 3 * SLOTB, LDS_B = 6 * SLOTB;
__device__ __forceinline__ bf16x8 packp(const f32x16& p, int s) {
    u32x4 w; w.x = gk::cvt_pk_bf16(p[8 * s + 0], p[8 * s + 1]); w.y = gk::cvt_pk_bf16(p[8 * s + 2], p[8 * s + 3]); w.z = gk::cvt_pk_bf16(p[8 * s + 4], p[8 * s + 5]); w.w = gk::cvt_pk_bf16(p[8 * s + 6], p[8 * s + 7]);
    return __builtin_bit_cast(bf16x8, w);
}
__device__ __forceinline__ float softmax_step(f32x16& p0, f32x16& p1, float& m, float& l) {
    float rm = p0[0];
#pragma unroll
    for (int r = 1; r < 16; ++r) rm = fmaxf(rm, p0[r]);
#pragma unroll
    for (int r = 0; r < 16; ++r) rm = fmaxf(rm, p1[r]);
    rm = swapmax(rm);
    const float mn = fmaxf(m, rm), alpha = __builtin_amdgcn_exp2f(m - mn); m = mn;
    float s = 0.f;
#pragma unroll
    for (int r = 0; r < 16; ++r) { p0[r] = __builtin_amdgcn_exp2f(p0[r] - mn); s += p0[r]; }
#pragma unroll
    for (int r = 0; r < 16; ++r) { p1[r] = __builtin_amdgcn_exp2f(p1[r] - mn); s += p1[r]; }
    l = l * alpha + s;
    return alpha;
}
template <int THR>
__device__ __forceinline__ bool softmax_ref(f32x16& a0, f32x16& a1, f32x16& negm, float& ref, float& l, float& alpha, bool first) {
    float rm = a0[0];
#pragma unroll
    for (int r = 1; r < 16; ++r) rm = fmaxf(rm, a0[r]);
#pragma unroll
    for (int r = 0; r < 16; ++r) rm = fmaxf(rm, a1[r]);
    rm = swapmax(rm);
    bool resc = false; alpha = 1.0f;
    if (first || __any(rm > (float)THR)) {
        const float dl = first ? rm : fmaxf(rm, 0.0f);
        ref += dl; alpha = first ? 1.0f : __builtin_amdgcn_exp2f(-dl); l *= alpha; resc = !first;
#pragma unroll
        for (int r = 0; r < 16; ++r) { a0[r] -= dl; a1[r] -= dl; negm[r] = -ref; }
    }
    float s = 0.f;
#pragma unroll
    for (int r = 0; r < 16; ++r) { a0[r] = __builtin_amdgcn_exp2f(a0[r]); s += a0[r]; }
#pragma unroll
    for (int r = 0; r < 16; ++r) { a1[r] = __builtin_amdgcn_exp2f(a1[r]); s += a1[r]; }
    l += s;
    return resc;
}
template <int MODE>
__device__ __forceinline__ void unit(int b, int h, int qb, const bf16* proj, const float* fbias, const unsigned* qkn, bf16* ycat, float lam, float lam_init, const float* subln, LAS char* shm) {
    int tid_ = threadIdx.x; asm volatile("" : "+v"(tid_));
    const int tid = tid_, lane = tid & 63, r32 = lane & 31, hi = lane >> 5; const int wid = __builtin_amdgcn_readfirstlane(tid >> 6);
    constexpr int QC = MODE ? C_DQ : C_FQ, KC = MODE ? C_DK : C_FK, VC = MODE ? C_DV : C_FV, NDMA = MODE ? 2 : 3;
    const long rowbase = (long)b * SEQ; const int q0 = qb * 256;
    const bf16* Qw = proj + (rowbase + q0 + wid * 32) * NPROJ + QC + h * 64;
    const int krow = wid * 8 + (lane >> 3);
    const bf16* ksrc = proj + (rowbase + krow) * NPROJ + KC + h * 64 + (((lane & 7) ^ ((krow >> 1) & 7)) * 8);
    const bf16* vsrc = proj + (rowbase + 16 * (wid & 3) + (lane >> 2)) * NPROJ + VC + h * 64 + (wid >> 2) * 32 + (lane & 3) * 8;
    const float* bsrc = fbias + (size_t)(b * 4 + h) * SEQ + lane;
    const unsigned lds0 = (unsigned)(uintptr_t)shm;
    const unsigned kdst = lds0 + LDS_K + wid * 1024, vdst = lds0 + LDS_V + wid * 1024, bdst = lds0 + LDS_B + wid * 768;
    const int NTL = (q0 + 256) / 64;
    bf16x8 qr[4];
#pragma unroll
    for (int d0 = 0; d0 < 4; ++d0) qr[d0] = *reinterpret_cast<const bf16x8*>(&Qw[(long)r32 * NPROJ + d0 * 16 + hi * 8]);
#define ATT_ISSUE(t, slot) do { glds16(ksrc + (long)(t) * 64 * NPROJ, (unsigned)__builtin_amdgcn_readfirstlane(kdst + (slot) * SLOTB)); \
        glds16(vsrc + (long)(t) * 64 * NPROJ, (unsigned)__builtin_amdgcn_readfirstlane(vdst + (slot) * SLOTB)); \
        if (MODE == 0) glds4(bsrc + (t) * 64, (unsigned)__builtin_amdgcn_readfirstlane(bdst + (slot) * 256)); } while (0)
    int T0 = 0;
    if (MODE == 0) {
        const float qn = __uint_as_float(qkn[(b * 4 + h) * 2]), kn = __uint_as_float(qkn[(b * 4 + h) * 2 + 1]);
        const float* bb = fbias + (size_t)(b * 4 + h) * SEQ;
        const float thresh = bb[q0] - 64.0f - 2.0f * qn * kn;
        const float be = (lane < NTL) ? bb[64 * lane + 63] : INFINITY;
        const unsigned long long msk = __ballot(be >= thresh);
        T0 = __builtin_amdgcn_readfirstlane(__ffsll((long long)msk) - 1);
        if (T0 > NTL - 4) T0 = NTL - 4;
        if (T0 < 0) T0 = 0;
    }
    ATT_ISSUE(T0, 0); ATT_ISSUE(T0 + 1, 1);
    const LAS char* kp0 = shm + LDS_K + r32 * 128; const int ksw = (r32 >> 1) & 7;
#define ATT_KOFF(d0) ((((2 * (d0) + hi) ^ ksw)) * 16)
    const LAS char* vp0 = shm + LDS_V + ((lane >> 4) & 1) * 32 + (lane & 3) * 8 + (4 * hi + ((lane & 15) >> 2)) * 64;
    const LAS char* bp0 = shm + LDS_B + wid * 768 + hi * 16;
    float m1 = MODE ? 0.f : -1e30f, l1 = 0.f, m2 = MODE ? 0.f : -1e30f, l2 = 0.f;
    f32x16 o1[2], o2[2], ngA = f32x16{}, ngB = f32x16{};
    f32x16 o1_dummy; (void)o1_dummy;
    o1[0] = f32x16{}; o1[1] = f32x16{}; o2[0] = f32x16{}; o2[1] = f32x16{};
    const int qrel = wid * 32 + r32;
    int slot = 0;
    for (int t = T0; t < NTL; ++t) {
        if (t + 1 < NTL) { if (MODE == 0) asm volatile("s_waitcnt vmcnt(3)" ::: "memory"); else asm volatile("s_waitcnt vmcnt(2)" ::: "memory"); }
        else asm volatile("s_waitcnt vmcnt(0)" ::: "memory");
        __builtin_amdgcn_s_barrier();
        asm volatile("" ::: "memory");
        if (t + 2 < NTL) { const int s2 = (slot == 0) ? 2 : slot - 1; ATT_ISSUE(t + 2, s2); }
        const LAS char* kp = kp0 + slot * SLOTB; const LAS char* vp = vp0 + slot * SLOTB;
        const int jb = t - (NTL - 4);
        if (MODE == 0) {
            f32x16 p0, p1;
            const LAS char* bp = bp0 + slot * 256;
#pragma unroll
            for (int g = 0; g < 4; ++g) { const f32x4 a = *(const LAS f32x4*)(bp + g * 32), c = *(const LAS f32x4*)(bp + 128 + g * 32);
#pragma unroll
                for (int j = 0; j < 4; ++j) { p0[4 * g + j] = a[j]; p1[4 * g + j] = c[j]; } }
            bf16x8 kfr[4][2];
#pragma unroll
            for (int d0 = 0; d0 < 4; ++d0) { kfr[d0][0] = *(const LAS bf16x8*)(kp + ATT_KOFF(d0)); kfr[d0][1] = *(const LAS bf16x8*)(kp + ATT_KOFF(d0) + 4096); }
            __builtin_amdgcn_sched_barrier(0);
#pragma unroll
            for (int d0 = 0; d0 < 4; ++d0) { p0 = __builtin_amdgcn_mfma_f32_32x32x16_bf16(kfr[d0][0], qr[d0], p0, 0, 0, 0); p1 = __builtin_amdgcn_mfma_f32_32x32x16_bf16(kfr[d0][1], qr[d0], p1, 0, 0, 0); }
            if (jb >= 0) {
#pragma unroll
                for (int r = 0; r < 16; ++r) { const int kv = 64 * jb + crow(r, hi); if (kv > qrel) p0[r] = -INFINITY; if (kv + 32 > qrel) p1[r] = -INFINITY; }
            }
            bf16x8 vfr[4][2];
#pragma unroll
            for (int ks = 0; ks < 4; ++ks)
#pragma unroll
                for (int d0 = 0; d0 < 2; ++d0) { const s16x4 lo = vtr(vp + d0 * 4096 + ks * 1024), hh = vtr(vp + d0 * 4096 + ks * 1024 + 512); vfr[ks][d0] = (bf16x8){lo[0], lo[1], lo[2], lo[3], hh[0], hh[1], hh[2], hh[3]}; }
            __builtin_amdgcn_sched_barrier(0);
            const float al = softmax_step(p0, p1, m1, l1);
#pragma unroll
            for (int d = 0; d < 2; ++d)
#pragma unroll
                for (int r = 0; r < 16; ++r) o1[d][r] *= al;
#pragma unroll
            for (int ks = 0; ks < 4; ++ks) { const bf16x8 pf = (ks < 2) ? packp(p0, ks) : packp(p1, ks - 2);
#pragma unroll
                for (int d0 = 0; d0 < 2; ++d0) o1[d0] = __builtin_amdgcn_mfma_f32_32x32x16_bf16(vfr[ks][d0], pf, o1[d0], 0, 0, 0); }
        } else {
            f32x16 a0 = ngA, a1 = ngA, b0 = ngB, b1 = ngB;
            bf16x8 kfr[4][2];
#pragma unroll
            for (int d0 = 0; d0 < 4; ++d0) { kfr[d0][0] = *(const LAS bf16x8*)(kp + ATT_KOFF(d0)); kfr[d0][1] = *(const LAS bf16x8*)(kp + ATT_KOFF(d0) + 4096); }
            __builtin_amdgcn_sched_barrier(0);
#pragma unroll
            for (int d0 = 0; d0 < 2; ++d0) { a0 = __builtin_amdgcn_mfma_f32_32x32x16_bf16(kfr[d0][0], qr[d0], a0, 0, 0, 0); a1 = __builtin_amdgcn_mfma_f32_32x32x16_bf16(kfr[d0][1], qr[d0], a1, 0, 0, 0);
                b0 = __builtin_amdgcn_mfma_f32_32x32x16_bf16(kfr[d0 + 2][0], qr[d0 + 2], b0, 0, 0, 0); b1 = __builtin_amdgcn_mfma_f32_32x32x16_bf16(kfr[d0 + 2][1], qr[d0 + 2], b1, 0, 0, 0); }
            if (jb >= 0) {
#pragma unroll
                for (int r = 0; r < 16; ++r) { const int kv = 64 * jb + crow(r, hi); if (kv > qrel) { a0[r] = -INFINITY; b0[r] = -INFINITY; } if (kv + 32 > qrel) { a1[r] = -INFINITY; b1[r] = -INFINITY; } }
            }
            bf16x8 vfr[4][2];
#pragma unroll
            for (int ks = 0; ks < 4; ++ks)
#pragma unroll
                for (int d0 = 0; d0 < 2; ++d0) { const s16x4 lo = vtr(vp + d0 * 4096 + ks * 1024), hh = vtr(vp + d0 * 4096 + ks * 1024 + 512); vfr[ks][d0] = (bf16x8){lo[0], lo[1], lo[2], lo[3], hh[0], hh[1], hh[2], hh[3]}; }
            __builtin_amdgcn_sched_barrier(0);
            float al1, al2;
            const bool r1 = softmax_ref<8>(a0, a1, ngA, m1, l1, al1, t == T0), r2 = softmax_ref<8>(b0, b1, ngB, m2, l2, al2, t == T0);
            if (r1) {
#pragma unroll
                for (int d = 0; d < 2; ++d)
#pragma unroll
                    for (int r = 0; r < 16; ++r) o1[d][r] *= al1;
            }
            if (r2) {
#pragma unroll
                for (int d = 0; d < 2; ++d)
#pragma unroll
                    for (int r = 0; r < 16; ++r) o2[d][r] *= al2;
            }
#pragma unroll
            for (int ks = 0; ks < 4; ++ks) { const bf16x8 pa = (ks < 2) ? packp(a0, ks) : packp(a1, ks - 2), pb = (ks < 2) ? packp(b0, ks) : packp(b1, ks - 2);
#pragma unroll
                for (int d0 = 0; d0 < 2; ++d0) { o1[d0] = __builtin_amdgcn_mfma_f32_32x32x16_bf16(vfr[ks][d0], pa, o1[d0], 0, 0, 0); o2[d0] = __builtin_amdgcn_mfma_f32_32x32x16_bf16(vfr[ks][d0], pb, o2[d0], 0, 0, 0); } }
        }
        slot = (slot == 2) ? 0 : slot + 1;
    }
#undef ATT_ISSUE
#undef ATT_KOFF
    const float lt1 = swapadd(l1), inv1 = 1.0f / lt1;
    bf16* orow = ycat + (size_t)(rowbase + q0 + wid * 32 + r32) * DM + (MODE ? 512 : 0) + h * 64;
    if (MODE == 0) {
#pragma unroll
        for (int d0 = 0; d0 < 2; ++d0)
#pragma unroll
            for (int g = 0; g < 4; ++g) { u32x2 w; w.x = pk2(o1[d0][4 * g] * inv1, o1[d0][4 * g + 1] * inv1); w.y = pk2(o1[d0][4 * g + 2] * inv1, o1[d0][4 * g + 3] * inv1);
                *(u32x2*)(orow + d0 * 32 + 8 * g + 4 * hi) = w; }
    } else {
        const float lt2 = swapadd(l2), inv2 = lam / lt2;
        float ss = 0.f;
#pragma unroll
        for (int d0 = 0; d0 < 2; ++d0)
#pragma unroll
            for (int r = 0; r < 16; ++r) { const float y = o1[d0][r] * inv1 - o2[d0][r] * inv2; o1[d0][r] = y; ss += y * y; }
        ss = swapadd(ss);
        const float rs = rsqrtf(ss * (1.0f / 64.0f) + EPS) * (1.0f - lam_init);
#pragma unroll
        for (int d0 = 0; d0 < 2; ++d0)
#pragma unroll
            for (int g = 0; g < 4; ++g) { const f32x4 gg = *(const f32x4*)(subln + d0 * 32 + 8 * g + 4 * hi);
                u32x2 w; w.x = pk2(o1[d0][4 * g] * rs * gg[0], o1[d0][4 * g + 1] * rs * gg[1]); w.y = pk2(o1[d0][4 * g + 2] * rs * gg[2], o1[d0][4 * g + 3] * rs * gg[3]);
                *(u32x2*)(orow + d0 * 32 + 8 * g + 4 * hi) = w; }
    }
    asm volatile("s_waitcnt lgkmcnt(0)\n\ts_barrier" ::: "memory");
}
}

namespace hg {
constexpr int LD = 132, LDV = 68, LDB = 136;
constexpr int OFF_GA = 0, OFF_KT = 64 * LD * 4, OFF_QT = 2 * 64 * LD * 4, OFF_VV = 3 * 64 * LD * 4 + 1024, OFF_TOT = OFF_VV + 64 * LDV * 4, OFF_E31 = OFF_TOT + 2048, OFF_LB = OFF_E31 + 512, OFF_Q = OFF_LB + 2048;
__device__ __forceinline__ float rcp_(float x) { return __builtin_amdgcn_rcpf(x); }
struct Pre1 { u32x2 xf[4]; u32x4 v; };
struct Pre3 { u32x2 xf[4], xq[4]; u32x4 v, g; u32x4 si[2]; };
__device__ __forceinline__ void issue1(Pre1& P, const bf16* proj, int u, int tid) {
    const int c = u & 63, h = (u >> 6) & 3, b = u >> 8, t = tid >> 3, q = tid & 7; const bf16* r = proj + ((size_t)b * SEQ + c * 64 + t) * NPROJ;
#pragma unroll
    for (int cc = 0; cc < 4; ++cc) P.xf[cc] = *(const u32x2*)(r + C_HF + h * 128 + 32 * cc + 4 * q);
    P.v = *(const u32x4*)(r + C_HI + h * 64 + 8 * q);
}
__device__ __forceinline__ void issue3(Pre3& P, const bf16* proj, const bf16* hst, int u, int tid) {
    const int c = u & 63, h = (u >> 6) & 3, b = u >> 8, t = tid >> 3, q = tid & 7; const bf16* r = proj + ((size_t)b * SEQ + c * 64 + t) * NPROJ;
#pragma unroll
    for (int cc = 0; cc < 4; ++cc) { P.xf[cc] = *(const u32x2*)(r + C_HF + h * 128 + 32 * cc + 4 * q); P.xq[cc] = *(const u32x2*)(r + C_HQ + h * 128 + 32 * cc + 4 * q); }
    P.v = *(const u32x4*)(r + C_HI + h * 64 + 8 * q); P.g = *(const u32x4*)(r + C_HG + h * 64 + 8 * q);
#pragma unroll
    for (int j = 0; j < 2; ++j) P.si[j] = *(const u32x4*)(hst + (size_t)u * 8192 + (tid & 127) * 64 + (tid >> 7) * 16 + 8 * j);
}
__device__ __forceinline__ void common(LAS float* GA, LAS float* KT, LAS float* TOT, const LAS float* LB, const u32x2 (&xf)[4], int h, int tid) {
    { const int t = tid >> 3, q = tid & 7;
#pragma unroll
      for (int cc = 0; cc < 4; ++cc) { const int k = 32 * cc + 4 * q; const f32x4 lb = *(const LAS f32x4*)(LB + h * 128 + k);
          const float x[4] = {bflo(xf[cc].x), bfhi(xf[cc].x), bflo(xf[cc].y), bfhi(xf[cc].y)}; f32x4 g, om;
#pragma unroll
          for (int e = 0; e < 4; ++e) { const float ex = __expf(-fminf(fmaxf(x[e], -30.0f), 30.0f)); const float s = rcp_(1.0f + ex), s1 = ex * s;
              g[e] = __logf(lb[e] + (1.0f - lb[e]) * s); om[e] = (1.0f - lb[e]) * s1; }
          *(LAS f32x4*)(GA + t * LD + k) = g; *(LAS f32x4*)(KT + t * LD + k) = om; } }
    __syncthreads();
    const int kk = tid & 127, part = tid >> 7;
    float a[16]; float run = 0.f;
#pragma unroll
    for (int i = 0; i < 16; ++i) { run += GA[(16 * part + i) * LD + kk]; a[i] = run; }
    TOT[part * 128 + kk] = run;
    __syncthreads();
    float off = 0.f;
#pragma unroll
    for (int p = 0; p < 3; ++p) if (p < part) off += TOT[p * 128 + kk];
#pragma unroll
    for (int i = 0; i < 16; ++i) GA[(16 * part + i) * LD + kk] = a[i] + off;
    __syncthreads();
}
__device__ __forceinline__ void store_v(LAS float* VV, const u32x4 w, int tid) {
    const int t = tid >> 3, v0 = (tid & 7) * 8; LAS float* d = VV + t * LDV + v0;
    *(LAS f32x4*)d = (f32x4){bflo(w.x), bfhi(w.x), bflo(w.y), bfhi(w.y)}; *(LAS f32x4*)(d + 4) = (f32x4){bflo(w.z), bfhi(w.z), bflo(w.w), bfhi(w.w)};
}
__device__ __forceinline__ void lb_table(Frame& F, int l, const float* hgl) {
    LAS float* LB = (LAS float*)(F.lds + OFF_LB);
    LB[F.tid] = (l == 0) ? 0.0f : 1.0f / (1.0f + __expf(hgl[F.tid] - hgl[512 + F.tid]));
    __syncthreads();
}
__device__ __forceinline__ unsigned q_issue(Frame& F, unsigned* qc) { unsigned v = 0u; if (F.tid == 0) v = __hip_atomic_fetch_add(qc, 1u, __ATOMIC_RELAXED, __HIP_MEMORY_SCOPE_AGENT); return v; }
__device__ __forceinline__ void q_publish(Frame& F, unsigned v) { if (F.tid == 0) *(volatile LAS unsigned*)(F.lds + OFF_Q) = v; }
__device__ __forceinline__ int q_read(Frame& F) { return (int)*(volatile LAS unsigned*)(F.lds + OFF_Q); }
__device__ __forceinline__ void h1_phase(Frame& F, int l, const bf16* proj, const float* hgl, bf16* hst, float* hdec, unsigned* qc) {
    LAS float* SL = (LAS float*)(F.lds + OFF_QT);
    LAS float* GA = (LAS float*)(F.lds + OFF_GA); LAS float* KT = (LAS float*)(F.lds + OFF_KT); LAS float* VV = (LAS float*)(F.lds + OFF_VV); LAS float* TOT = (LAS float*)(F.lds + OFF_TOT);
    const LAS float* LB = (const LAS float*)(F.lds + OFF_LB);
    const int tid = F.tid;
    { const unsigned q0 = q_issue(F, qc); q_publish(F, q0); } lb_table(F, l, hgl);
    int u = q_read(F);
    __syncthreads();
    Pre1 P; if (u < HGUNITS) issue1(P, proj, u, tid);
    while (u < HGUNITS) {
        const int h = (u >> 6) & 3;
        const unsigned qv = q_issue(F, qc);
        common(GA, KT, TOT, LB, P.xf, h, tid);
        { const int t = tid >> 3, q = tid & 7;
#pragma unroll
          for (int cc = 0; cc < 4; ++cc) { const int k = 32 * cc + 4 * q; const f32x4 g31 = *(const LAS f32x4*)(GA + 31 * LD + k), gt = *(const LAS f32x4*)(GA + t * LD + k); f32x4 kt = *(const LAS f32x4*)(KT + t * LD + k);
#pragma unroll
              for (int e = 0; e < 4; ++e) kt[e] *= __expf(g31[e] - gt[e]);
              *(LAS f32x4*)(KT + t * LD + k) = kt; } }
        store_v(VV, P.v, tid);
        if (tid < 128) hdec[(size_t)u * 128 + tid] = __expf(GA[63 * LD + tid]);
        q_publish(F, qv);
        __syncthreads();
        const int un = q_read(F);
        if (un < HGUNITS) issue1(P, proj, un, tid);
        const int lane = F.lane, i = lane & 15, kk = lane >> 4, kb = 16 * F.wave;
#pragma unroll
        for (int vt = 0; vt < 4; ++vt) {
            f32x4 acc = (f32x4){0.f, 0.f, 0.f, 0.f};
#pragma unroll
            for (int s0 = 0; s0 < 64; s0 += 16)
#pragma unroll
                for (int m = 0; m < 4; ++m) { const int s = s0 + 4 * kk + m; acc = __builtin_amdgcn_mfma_f32_16x16x4f32(KT[s * LD + kb + i], VV[s * LDV + 16 * vt + i], acc, 0, 0, 0); }
#pragma unroll
            for (int r = 0; r < 4; ++r) { const int k = kb + 4 * kk + r; SL[k * LDV + 16 * vt + i] = acc[r] * __expf(GA[63 * LD + k] - GA[31 * LD + k]); }
        }
        __syncthreads();
        { const int k = tid >> 2, vq = (tid & 3) * 16; const LAS float* sp = SL + k * LDV + vq;
          const f32x4 a = *(const LAS f32x4*)sp, b = *(const LAS f32x4*)(sp + 4), c = *(const LAS f32x4*)(sp + 8), d = *(const LAS f32x4*)(sp + 12);
          bf16* dst = hst + (size_t)u * 8192 + k * 64 + vq;
          *(u32x4*)dst = (u32x4){pk2(a[0], a[1]), pk2(a[2], a[3]), pk2(b[0], b[1]), pk2(b[2], b[3])}; *(u32x4*)(dst + 8) = (u32x4){pk2(c[0], c[1]), pk2(c[2], c[3]), pk2(d[0], d[1]), pk2(d[2], d[3])}; }
        u = un;
    }
}
__device__ __forceinline__ void h3_phase(Frame& F, int l, const bf16* proj, const float* hgl, const bf16* hst, const float* normg, bf16* ycat, unsigned* qc) {
    LAS float* GA = (LAS float*)(F.lds + OFF_GA); LAS float* KT = (LAS float*)(F.lds + OFF_KT); LAS bf16* QTb = (LAS bf16*)(F.lds + OFF_QT); LAS bf16* KTb = QTb + 64 * LDB; LAS float* VV = (LAS float*)(F.lds + OFF_VV);
    LAS float* TOT = (LAS float*)(F.lds + OFF_TOT); LAS float* E31 = (LAS float*)(F.lds + OFF_E31); const LAS float* LB = (const LAS float*)(F.lds + OFF_LB);
    const int tid = F.tid;
    { const unsigned q0 = q_issue(F, qc); q_publish(F, q0); } lb_table(F, l, hgl);
    int u = q_read(F);
    __syncthreads();
    Pre3 P; if (u < HGUNITS) issue3(P, proj, hst, u, tid);
    float ng[8];
#pragma unroll
    for (int j = 0; j < 8; ++j) ng[j] = normg[(tid & 7) * 8 + j];
    while (u < HGUNITS) {
        const int c = u & 63, h = (u >> 6) & 3, b = u >> 8; const size_t row0 = (size_t)b * SEQ + c * 64;
        const unsigned qv = q_issue(F, qc);
        common(GA, KT, TOT, LB, P.xf, h, tid);
        { const int t = tid >> 3, q = tid & 7;
#pragma unroll
          for (int cc = 0; cc < 4; ++cc) { const int k = 32 * cc + 4 * q; const f32x4 g31 = *(const LAS f32x4*)(GA + 31 * LD + k), gt = *(const LAS f32x4*)(GA + t * LD + k); f32x4 kt = *(const LAS f32x4*)(KT + t * LD + k), qt;
              const float x[4] = {bflo(P.xq[cc].x), bfhi(P.xq[cc].x), bflo(P.xq[cc].y), bfhi(P.xq[cc].y)};
#pragma unroll
              for (int e = 0; e < 4; ++e) { const float d = gt[e] - g31[e], ed = __expf(d); qt[e] = x[e] * rcp_(1.0f + __expf(-x[e])) * ed; kt[e] *= rcp_(ed); }
              *(LAS u32x2*)(QTb + t * LDB + k) = (u32x2){pk2(qt[0], qt[1]), pk2(qt[2], qt[3])}; *(LAS u32x2*)(KTb + t * LDB + k) = (u32x2){pk2(kt[0], kt[1]), pk2(kt[2], kt[3])}; } }
        if (tid < 128) E31[tid] = __expf(GA[31 * LD + tid]);
        store_v(VV, P.v, tid);
        const u32x4 gate = P.g;
        __syncthreads();
        LAS bf16* SIt = (LAS bf16*)GA;
        { const int k = tid & 127, vb = (tid >> 7) * 16; const float sc = E31[k];
#pragma unroll
          for (int j = 0; j < 2; ++j) { const unsigned w4[4] = {P.si[j].x, P.si[j].y, P.si[j].z, P.si[j].w};
#pragma unroll
              for (int e = 0; e < 8; ++e) SIt[(vb + 8 * j + e) * LDB + k] = (bf16)f2bf(((e & 1) ? bfhi(w4[e >> 1]) : bflo(w4[e >> 1])) * sc); } }
        q_publish(F, qv);
        __syncthreads();
        const int un = q_read(F);
        if (un < HGUNITS) issue3(P, proj, hst, un, tid);
        const int lane = F.lane, i = lane & 15, kk = lane >> 4, w = F.wave, tt = (w < 4) ? w : 7 - w, vh = w >> 2;
        f32x4 o[2]; o[0] = (f32x4){0.f, 0.f, 0.f, 0.f}; o[1] = o[0];
        for (int j = 0; j <= tt; ++j) {
            f32x4 at = (f32x4){0.f, 0.f, 0.f, 0.f};
#pragma unroll
            for (int st = 0; st < 4; ++st) { const bf16x8 a8 = *(const LAS bf16x8*)(KTb + (16 * j + i) * LDB + 32 * st + 8 * kk), b8 = *(const LAS bf16x8*)(QTb + (16 * tt + i) * LDB + 32 * st + 8 * kk);
                at = __builtin_amdgcn_mfma_f32_16x16x32_bf16(a8, b8, at, 0, 0, 0); }
            if (j == tt) {
#pragma unroll
                for (int r = 0; r < 4; ++r) if (4 * kk + r > i) at[r] = 0.f;
            }
#pragma unroll
            for (int vt = 0; vt < 2; ++vt)
#pragma unroll
                for (int m = 0; m < 4; ++m) o[vt] = __builtin_amdgcn_mfma_f32_16x16x4f32(VV[(16 * j + 4 * kk + m) * LDV + 32 * vh + 16 * vt + i], at[m], o[vt], 0, 0, 0);
        }
#pragma unroll
        for (int st = 0; st < 4; ++st) { const bf16x8 b8 = *(const LAS bf16x8*)(QTb + (16 * tt + i) * LDB + 32 * st + 8 * kk);
#pragma unroll
            for (int vt = 0; vt < 2; ++vt) o[vt] = __builtin_amdgcn_mfma_f32_16x16x32_bf16(*(const LAS bf16x8*)(SIt + (32 * vh + 16 * vt + i) * LDB + 32 * st + 8 * kk), b8, o[vt], 0, 0, 0); }
        __syncthreads();
        LAS float* OUT = KT;
#pragma unroll
        for (int vt = 0; vt < 2; ++vt) *(LAS f32x4*)(OUT + (16 * tt + i) * LDV + 32 * vh + 16 * vt + 4 * kk) = o[vt];
        __syncthreads();
        { const int t = tid >> 3, v0 = (tid & 7) * 8;
          const f32x4 va = *(const LAS f32x4*)(OUT + t * LDV + v0), vb = *(const LAS f32x4*)(OUT + t * LDV + v0 + 4);
          const float vals[8] = {va[0], va[1], va[2], va[3], vb[0], vb[1], vb[2], vb[3]}; float ss = 0.f;
#pragma unroll
          for (int j = 0; j < 8; ++j) ss += vals[j] * vals[j];
          ss += __shfl_xor(ss, 1); ss += __shfl_xor(ss, 2); ss += __shfl_xor(ss, 4);
          const float rs = rsqrtf(ss * (1.0f / 64.0f) + EPS);
          const unsigned gww[4] = {gate.x, gate.y, gate.z, gate.w};
          float y[8];
#pragma unroll
          for (int j = 0; j < 8; ++j) { const float gx = (j & 1) ? bfhi(gww[j >> 1]) : bflo(gww[j >> 1]); y[j] = vals[j] * rs * ng[j] * gx * rcp_(1.0f + __expf(-gx)); }
          u32x4 wv; wv.x = pk2(y[0], y[1]); wv.y = pk2(y[2], y[3]); wv.z = pk2(y[4], y[5]); wv.w = pk2(y[6], y[7]);
          *(u32x4*)(ycat + (row0 + t) * DM + 256 + h * 64 + v0) = wv; }
        __syncthreads();
        u = un;
    }
}
}

struct S5P { const float *a_re, *a_im, *log_step, *b_re, *b_im, *c_re, *c_im, *d; };
__device__ __forceinline__ void s5_pow(const S5P& P, int g, int n, float p, float& pr, float& pi) {
    const float dt = __expf(P.log_step[g]); const float lr = fminf(P.a_re[g * 64 + n], -1e-4f), li = P.a_im[g * 64 + n];
    const float mag = expf(lr * dt * p); float s, c; sincosf(li * dt * p, &s, &c); pr = mag * c; pi = mag * s;
}
__device__ __forceinline__ void s5_z(const S5P& P, int g, int n, float& zr, float& zi) {
    const float dt = __expf(P.log_step[g]); const float lr = fminf(P.a_re[g * 64 + n], -1e-4f), li = P.a_im[g * 64 + n];
    const float mag = expf(lr * dt); float s, c; sincosf(li * dt, &s, &c); const float ar = mag * c, ai = mag * s, den = lr * lr + li * li;
    zr = ((ar - 1.0f) * lr + ai * li) / den; zi = (ai * lr - (ar - 1.0f) * li) / den;
}

__device__ __forceinline__ void transpose_tile(const float* W, int N, int K, int k0, int n0src, bf16* WT, int mode, int n0dst, LAS float* scr, int lane) {
#pragma unroll
    for (int i = 0; i < 16; ++i) { const int kk = 4 * i + (lane >> 4), nn = (lane & 15) * 4;
        const f32x4 v = *(const f32x4*)(W + (size_t)(k0 + kk) * N + n0src + nn);
        scr[kk * 65 + nn] = v[0]; scr[kk * 65 + nn + 1] = v[1]; scr[kk * 65 + nn + 2] = v[2]; scr[kk * 65 + nn + 3] = v[3]; }
    LDS_WAIT(); asm volatile("" ::: "memory");
    const int c = lane & 7;
#pragma unroll
    for (int p = 0; p < 8; ++p) { const int n = (lane >> 3) + 8 * p; const LAS float* s = scr + (8 * c) * 65 + n;
        u32x4 o; o.x = pk2(s[0], s[65]); o.y = pk2(s[2 * 65], s[3 * 65]); o.z = pk2(s[4 * 65], s[5 * 65]); o.w = pk2(s[6 * 65], s[7 * 65]);
        int drow = n0dst + n; if (mode == 2) { const int ns = n0src + n; drow = 2 * (ns & 255) + (ns >> 8); }
        *(u32x4*)(WT + (size_t)drow * K + k0 + 8 * c) = o; }
    LDS_WAIT(); asm volatile("" ::: "memory");
}
struct F8Item { const float* src; unsigned char* dst; int N; };
__device__ __forceinline__ void f8_item(Frame& F, int it, F8Item& I) {
    constexpr int I_W1 = 64 * 8 * 8, I_W2 = 64 * 8 * 4;
    int r = it;
    if (r < I_W1) { const int m = r / 64, q = r % 64, nb = q & 7, kb = q >> 3; I.N = 2048;
        I.src = (const float*)karg(28) + (size_t)m * 1024 * 2048 + (size_t)(kb * 128) * 2048 + nb * 256; I.dst = F.ws + WS_W1T + (size_t)m * 2048 * 1024 + (size_t)(nb * 256) * 1024 + kb * 128; return; }
    r -= I_W1;
    if (r < I_W2) { const int m = r / 32, q = r % 32, nb = q & 3, kb = q >> 2; I.N = 1024;
        I.src = (const float*)karg(30) + (size_t)m * 1024 * 1024 + (size_t)(kb * 128) * 1024 + nb * 256; I.dst = F.ws + WS_W2T + (size_t)m * 1024 * 1024 + (size_t)(nb * 256) * 1024 + kb * 128; return; }
    r -= I_W2;
    { const int m = r / 104, q = r % 104, nb = q % 13, kb = q / 13; const int nd = nb * 256, ns = nd < 768 ? nd : nd + 4; I.N = INCOLS;
      I.src = (const float*)karg(7) + (size_t)m * 1024 * INCOLS + (size_t)(kb * 128) * INCOLS + ns; I.dst = F.ws + WS_WIN + (size_t)m * NPROJ * 1024 + (size_t)nd * 1024 + kb * 128; }
}
__device__ __forceinline__ void f8_load(const F8Item& I, f32x4 (&tv)[16], int wave, int lane) {
#pragma unroll
    for (int i = 0; i < 16; ++i) tv[i] = __builtin_nontemporal_load((const f32x4*)(I.src + (size_t)(16 * wave + i) * I.N + 4 * lane));
}
__device__ __forceinline__ void f8_store(const F8Item& I, const f32x4 (&tv)[16], LAS unsigned char* T, int wave, int lane, int tid) {
#pragma unroll
    for (int e = 0; e < 4; ++e) { u32x4 o;
        o.x = pk4_fp8(tv[0][e] * F8_SW, tv[1][e] * F8_SW, tv[2][e] * F8_SW, tv[3][e] * F8_SW);
        o.y = pk4_fp8(tv[4][e] * F8_SW, tv[5][e] * F8_SW, tv[6][e] * F8_SW, tv[7][e] * F8_SW);
        o.z = pk4_fp8(tv[8][e] * F8_SW, tv[9][e] * F8_SW, tv[10][e] * F8_SW, tv[11][e] * F8_SW);
        o.w = pk4_fp8(tv[12][e] * F8_SW, tv[13][e] * F8_SW, tv[14][e] * F8_SW, tv[15][e] * F8_SW);
        *(LAS u32x4*)(T + (4 * lane + e) * 144 + 16 * wave) = o; }
    __syncthreads();
    { const int n = tid >> 1, h = tid & 1;
#pragma unroll
      for (int c = 0; c < 4; ++c) { const u32x4 v = *(const LAS u32x4*)(T + n * 144 + 64 * h + 16 * c); *(u32x4*)(I.dst + (size_t)n * 1024 + 64 * h + 16 * c) = v; } }
    __syncthreads();
}
__device__ __forceinline__ void p0_prologue(Frame& F, const Args& a) {
    LAS float* scr = (LAS float*)(F.lds + F.wave * 17408);
    const int gw = F.vcu * NWAVES + F.wave, NGW = F.G * NWAVES;
    const float* w_out = (const float*)karg(8); const float* glu = (const float*)karg(25);
    bf16* wout_t = (bf16*)(F.ws + WS_WOUT); bf16* glu_t = (bf16*)(F.ws + WS_GLU);
    { constexpr int NIT = 64 * 8 * 8 + 64 * 8 * 4 + 2 * 8 * 13;
      LAS unsigned char* T = (LAS unsigned char*)F.lds;
      F8Item cur, nxt; f32x4 tv[16];
      int it = F.vcu;
      if (it < NIT) { f8_item(F, it, cur); f8_load(cur, tv, F.wave, F.lane); }
      while (it < NIT) {
          f32x4 tw[16];
#pragma unroll
          for (int i = 0; i < 16; ++i) tw[i] = tv[i];
          const int itn = it + F.G;
          if (itn < NIT) { f8_item(F, itn, nxt); f8_load(nxt, tv, F.wave, F.lane); }
          f8_store(cur, tw, T, F.wave, F.lane, F.tid);
          cur = nxt; it = itn;
      } }
    constexpr int I_WOUT = 2 * 16 * 16, I_GLU = 2 * 4 * 8;
    constexpr int NITEMS = I_WOUT + I_GLU;
    for (int it = gw; it < NITEMS; it += NGW) {
        int r = it;
        if (r < I_WOUT) { const int m = r / (16 * 16), q = r % (16 * 16), kb = q / 16, nb = q % 16; transpose_tile(w_out + (size_t)m * 1024 * 1024, 1024, 1024, kb * 64, nb * 64, wout_t + (size_t)m * 1024 * 1024, 0, nb * 64, scr, F.lane); continue; } r -= I_WOUT;
        { const int m = r / 32, q = r % 32, kb = q / 8, nb = q % 8; transpose_tile(glu + (size_t)m * 256 * 512, 512, 256, kb * 64, nb * 64, glu_t + (size_t)m * 512 * 256, 2, 0, scr, F.lane); }
    }
    __syncthreads();
    {
        const float* cc = (const float*)karg(1); const float* ada_w = (const float*)karg(3); const float* ada_b = (const float*)karg(4); float* mod = (float*)(F.ws + WS_MOD);
        LAS float* cs = (LAS float*)F.lds;
        LAS float* red = (LAS float*)(F.lds + 32768);
        for (int i = F.tid; i < 8192; i += NTHR) cs[i] = siluf_(cc[i]);
        __syncthreads();
        for (int it = F.vcu; it < 2 * 96; it += F.G) {
            const int l = it / 96, n0 = (it % 96) * 64, n = n0 + F.lane;
            float acc[8] = {0.f, 0.f, 0.f, 0.f, 0.f, 0.f, 0.f, 0.f};
            const float* wp = ada_w + (size_t)l * 1024 * 6144 + (size_t)(128 * F.wave) * 6144 + n;
#pragma unroll 8
            for (int k = 0; k < 128; ++k) { const float w = wp[(size_t)k * 6144];
#pragma unroll
                for (int b = 0; b < 8; ++b) acc[b] += cs[b * 1024 + 128 * F.wave + k] * w; }
#pragma unroll
            for (int b = 0; b < 8; ++b) red[(F.wave * 8 + b) * 64 + F.lane] = acc[b];
            __syncthreads();
            { const int b = F.tid >> 6, ln = F.tid & 63; float s = ada_b[l * 6144 + n0 + ln];
#pragma unroll
              for (int w = 0; w < 8; ++w) s += red[(w * 8 + b) * 64 + ln];
              mod[((size_t)l * 8 + b) * 6144 + n0 + ln] = s; }
            __syncthreads();
        }
    }
    {
        const int gt = F.vcu * NTHR + F.tid, NGT = F.G * NTHR;
        float* ktau = (float*)(F.ws + WS_KTAU4); bf16* Ebt = (bf16*)(F.ws + WS_S5E); bf16* Fbt = (bf16*)(F.ws + WS_S5F);
        for (int it4 = gt; it4 < 4 * 2 * 16 * 32 * 16; it4 += NGT) {
            const int it = it4 & 16383, nq = it4 >> 14;
            const int h = it & 15, tau = (it >> 4) & 31, g = (it >> 9) & 15, l = it >> 13;
            S5P P{(const float*)karg(17) + l * 1024, (const float*)karg(18) + l * 1024, (const float*)karg(19) + l * 16, (const float*)karg(20) + l * 16384, (const float*)karg(21) + l * 16384,
                  (const float*)karg(22) + l * 16384, (const float*)karg(23) + l * 16384, (const float*)karg(24) + l * 256};
            float acc[16];
#pragma unroll
            for (int j = 0; j < 16; ++j) acc[j] = 0.f;
            for (int n = 16 * nq; n < 16 * nq + 16; ++n) {
                float pr, pi, zr, zi; s5_pow(P, g, n, (float)tau, pr, pi); s5_z(P, g, n, zr, zi);
                const float cr = P.c_re[(g * 16 + h) * 64 + n], ci = P.c_im[(g * 16 + h) * 64 + n];
                const float qr = pr * zr - pi * zi, qi = pr * zi + pi * zr;
                const float tr = cr * qr - ci * qi, ti = cr * qi + ci * qr;
                const float* br = P.b_re + (g * 64 + n) * 16; const float* bi = P.b_im + (g * 64 + n) * 16;
#pragma unroll
                for (int j = 0; j < 16; ++j) acc[j] += tr * br[j] - ti * bi[j];
            }
            if (tau == 0 && nq == 0) acc[h] += P.d[g * 16 + h];
            float* o = ktau + (size_t)it4 * 16;
#pragma unroll
            for (int j = 0; j < 16; ++j) o[j] = acc[j];
        }
        for (int it = gt; it < 2 * 16 * 64 * 32; it += NGT) {
            const int s = it & 31, n = (it >> 5) & 63, g = (it >> 11) & 15, l = it >> 15, pair = g >> 1, gs = g & 1;
            S5P P{(const float*)karg(17) + l * 1024, (const float*)karg(18) + l * 1024, (const float*)karg(19) + l * 16, (const float*)karg(20) + l * 16384, (const float*)karg(21) + l * 16384,
                  (const float*)karg(22) + l * 16384, (const float*)karg(23) + l * 16384, (const float*)karg(24) + l * 256};
            float pr, pi, zr, zi; s5_pow(P, g, n, (float)(31 - s), pr, pi); s5_z(P, g, n, zr, zi);
            const float qr = pr * zr - pi * zi, qi = pr * zi + pi * zr;
            const float* br = P.b_re + (g * 64 + n) * 16; const float* bi = P.b_im + (g * 64 + n) * 16;
            bf16* e0 = Ebt + (((size_t)(l * 8 + pair) * 256) + gs * 128 + 2 * n) * 1024 + s * 32;
            unsigned wr_[8], wi_[8];
#pragma unroll
            for (int j = 0; j < 8; ++j) { const float vr0 = qr * br[2 * j] - qi * bi[2 * j], vi0 = qr * bi[2 * j] + qi * br[2 * j], vr1 = qr * br[2 * j + 1] - qi * bi[2 * j + 1], vi1 = qr * bi[2 * j + 1] + qi * br[2 * j + 1];
                wr_[j] = pk2(vr0, vr1); wi_[j] = pk2(vi0, vi1); }
            const u32x4 z4 = (u32x4){0u, 0u, 0u, 0u};
            *(u32x4*)(e0 + gs * 16) = (u32x4){wr_[0], wr_[1], wr_[2], wr_[3]}; *(u32x4*)(e0 + gs * 16 + 8) = (u32x4){wr_[4], wr_[5], wr_[6], wr_[7]};
            *(u32x4*)(e0 + 1024 + gs * 16) = (u32x4){wi_[0], wi_[1], wi_[2], wi_[3]}; *(u32x4*)(e0 + 1024 + gs * 16 + 8) = (u32x4){wi_[4], wi_[5], wi_[6], wi_[7]};
            *(u32x4*)(e0 + (1 - gs) * 16) = z4; *(u32x4*)(e0 + (1 - gs) * 16 + 8) = z4; *(u32x4*)(e0 + 1024 + (1 - gs) * 16) = z4; *(u32x4*)(e0 + 1024 + (1 - gs) * 16 + 8) = z4;
        }
        for (int it = gt; it < 2 * 16 * 64 * 32; it += NGT) {
            const int n = it & 63, t = (it >> 6) & 31, g = (it >> 11) & 15, l = it >> 15, pair = g >> 1, gs = g & 1;
            S5P P{(const float*)karg(17) + l * 1024, (const float*)karg(18) + l * 1024, (const float*)karg(19) + l * 16, (const float*)karg(20) + l * 16384, (const float*)karg(21) + l * 16384,
                  (const float*)karg(22) + l * 16384, (const float*)karg(23) + l * 16384, (const float*)karg(24) + l * 256};
            float pr, pi; s5_pow(P, g, n, (float)(t + 1), pr, pi);
            bf16* f0 = Fbt + ((size_t)(l * 8 + pair) * 1024 + t * 32) * 256 + gs * 128 + 2 * n;
#pragma unroll
            for (int h = 0; h < 16; ++h) { const float cr = P.c_re[(g * 16 + h) * 64 + n], ci = P.c_im[(g * 16 + h) * 64 + n];
                const float wr = cr * pr - ci * pi, wi = cr * pi + ci * pr;
                *(unsigned*)(f0 + (size_t)(gs * 16 + h) * 256) = pk2(wr, -wi);
                *(unsigned*)(f0 + (size_t)((1 - gs) * 16 + h) * 256) = 0u; }
        }
    }
}
__device__ __forceinline__ void s5_fill_m(Frame& F) {
    const int gt = F.vcu * NTHR + F.tid, NGT = F.G * NTHR;
    const float* ktau = (const float*)(F.ws + WS_KTAU4); bf16* Mbt = (bf16*)(F.ws + WS_S5M);
    for (int it = gt; it < 2 * 8 * 1024 * 128; it += NGT) {
        const int kc = it & 127, np = (it >> 7) & 1023, pair = (it >> 17) & 7, l = it >> 20;
        const int k0 = kc * 8, s = k0 >> 5, gs = (k0 >> 4) & 1, hp = k0 & 15, t = np >> 5, gsp = (np >> 4) & 1, h = np & 15;
        u32x4 o = (u32x4){0u, 0u, 0u, 0u};
        if (gs == gsp && s <= t) { const float* kp = ktau + ((((size_t)(l * 16 + pair * 2 + gs) * 32) + (t - s)) * 16 + h) * 16 + hp;
            f32x4 a = *(const f32x4*)kp, b = *(const f32x4*)(kp + 4);
#pragma unroll
            for (int q = 1; q < 4; ++q) { a += *(const f32x4*)(kp + (size_t)q * 262144); b += *(const f32x4*)(kp + (size_t)q * 262144 + 4); }
            o.x = pk2(a[0], a[1]); o.y = pk2(a[2], a[3]); o.z = pk2(b[0], b[1]); o.w = pk2(b[2], b[3]); }
        *(u32x4*)(Mbt + (size_t)it * 8) = o;
    }
}

struct RowVec { f32x4 v[4]; };
__device__ __forceinline__ RowVec load_vec(const float* p, int lane) { RowVec r; const f32x4* q = (const f32x4*)p + lane;
#pragma unroll
    for (int j = 0; j < 4; ++j) r.v[j] = q[64 * j];
    return r; }
__device__ __forceinline__ float sumsq(const RowVec& r) { float s = 0.f;
#pragma unroll
    for (int j = 0; j < 4; ++j) s += (r.v[j][0] * r.v[j][0] + r.v[j][1] * r.v[j][1]) + (r.v[j][2] * r.v[j][2] + r.v[j][3] * r.v[j][3]);
    return wave_sum(s); }
__device__ __forceinline__ void store_bf16_row(bf16* p, const RowVec& r, int lane) { u32x2* q = (u32x2*)p + lane;
#pragma unroll
    for (int j = 0; j < 4; ++j) { u32x2 w; w.x = pk2(r.v[j][0], r.v[j][1]); w.y = pk2(r.v[j][2], r.v[j][3]); q[64 * j] = w; } }
__device__ __forceinline__ RowVec load_vec_bf16(const bf16* p, int lane) { RowVec r; const u32x2* q = (const u32x2*)p + lane;
#pragma unroll
    for (int j = 0; j < 4; ++j) { const u32x2 w = q[64 * j]; r.v[j] = (f32x4){bflo(w.x), bfhi(w.x), bflo(w.y), bfhi(w.y)}; }
    return r; }
struct Norm1Ctx { RowVec gm, sh; f32x4 wff[16]; f32x4 fb; };
__device__ __forceinline__ void norm1_setup(Norm1Ctx& cx, const Args& a, const float* mod, int l, int b, int lane) {
    const RowVec g = load_vec((const float*)karg(5) + (size_t)(l * 2 + 0) * DM, lane), sc = load_vec(mod + ((size_t)l * 8 + b) * 6144 + 1024, lane);
    cx.sh = load_vec(mod + ((size_t)l * 8 + b) * 6144, lane);
#pragma unroll
    for (int j = 0; j < 4; ++j) cx.gm.v[j] = g.v[j] * (sc.v[j] + 1.0f);
    const float* w_in = (const float*)karg(7) + (size_t)l * DM * INCOLS + 768;
#pragma unroll
    for (int j = 0; j < 4; ++j)
#pragma unroll
        for (int c = 0; c < 4; ++c) cx.wff[j * 4 + c] = *(const f32x4*)(w_in + (size_t)(4 * lane + 256 * j + c) * INCOLS);
    cx.fb = *(const f32x4*)((const float*)karg(9) + l * 4);
}
__device__ __forceinline__ void norm1_row(const Norm1Ctx& cx, const RowVec& x, unsigned char* hrow, float* logf_row, int lane) {
    const float rs = rsqrtf(sumsq(x) * (1.0f / DM) + EPS);
    RowVec h; f32x4 ff = (f32x4){0.f, 0.f, 0.f, 0.f};
#pragma unroll
    for (int j = 0; j < 4; ++j) { h.v[j] = x.v[j] * rs * cx.gm.v[j] + cx.sh.v[j];
#pragma unroll
        for (int c = 0; c < 4; ++c) ff += cx.wff[j * 4 + c] * h.v[j][c]; }
    { unsigned* q = (unsigned*)hrow + lane;
#pragma unroll
      for (int j = 0; j < 4; ++j) q[64 * j] = pk4_fp8(h.v[j][0] * F8_SH, h.v[j][1] * F8_SH, h.v[j][2] * F8_SH, h.v[j][3] * F8_SH); }
#pragma unroll
    for (int c = 0; c < 4; ++c) ff[c] = wave_sum(ff[c]);
    if (lane == 0) { f32x4 o;
#pragma unroll
        for (int c = 0; c < 4; ++c) { const float z = ff[c] + cx.fb[c]; o[c] = fminf(z, 0.f) - __logf(1.0f + __expf(-fabsf(z))); }
        *(f32x4*)logf_row = o; }
}
__device__ __forceinline__ void p1_norm1(Frame& F, const Args& a, int l, const float* xsrc) {
    const int gw = F.vcu * NWAVES + F.wave; const int row0 = gw * 16, b = row0 / SEQ;
    Norm1Ctx cx; norm1_setup(cx, a, (const float*)(F.ws + WS_MOD), l, b, F.lane);
    unsigned char* H = F.ws + WS_H8; float* logf = (float*)(F.ws + WS_LOGF);
    RowVec xn = load_vec(xsrc + (size_t)row0 * DM, F.lane);
#pragma unroll 1
    for (int r = 0; r < 16; ++r) { const int row = row0 + r; const RowVec x = xn; if (r < 15) xn = load_vec(xsrc + (size_t)(row + 1) * DM, F.lane); norm1_row(cx, x, H + (size_t)row * DM, logf + (size_t)row * 4, F.lane); }
}
__device__ __forceinline__ void fox_cumsum(Frame& F, int bh) {
    const float* logf = (const float*)(F.ws + WS_LOGF); float* fb = (float*)(F.ws + WS_FBIAS);
    const int b = bh >> 2, h = bh & 3, lane = F.lane;
    const float* src = logf + ((size_t)b * SEQ + 64 * lane) * 4 + h;
    float tot = 0.f;
#pragma unroll 16
    for (int i = 0; i < 64; ++i) tot += src[i * 4];
    float inc = tot;
#pragma unroll
    for (int o = 1; o < 64; o <<= 1) { const float t = __shfl_up(inc, o); if (lane >= o) inc += t; }
    float run = inc - tot;
    float* dst = fb + (size_t)bh * SEQ + 64 * lane;
#pragma unroll 16
    for (int i = 0; i < 64; ++i) { run += src[i * 4]; dst[i] = -run * LOG2E; }
}
__device__ __forceinline__ void fox_norms(Frame& F, int task, int l) {
    const int bh = task >> 4, ch = task & 15, b = bh >> 2, h = bh & 3, lane = F.lane;
    const bf16* base = (const bf16*)(F.ws + WS_PROJ) + ((size_t)b * SEQ + ch * 256 + lane * 4) * NPROJ + h * 64;
    float mq = 0.f, mk = 0.f;
#pragma unroll
    for (int i = 0; i < 4; ++i) {
        float sq = 0.f, sk = 0.f;
#pragma unroll
        for (int j = 0; j < 8; ++j) { const u32x4 wq = *(const u32x4*)(base + (size_t)i * NPROJ + C_FQ + 8 * j), wk = *(const u32x4*)(base + (size_t)i * NPROJ + C_FK + 8 * j);
            const unsigned a[4] = {wq.x, wq.y, wq.z, wq.w}, c[4] = {wk.x, wk.y, wk.z, wk.w};
#pragma unroll
            for (int e = 0; e < 4; ++e) { sq += bflo(a[e]) * bflo(a[e]) + bfhi(a[e]) * bfhi(a[e]); sk += bflo(c[e]) * bflo(c[e]) + bfhi(c[e]) * bfhi(c[e]); } }
        mq = fmaxf(mq, sq); mk = fmaxf(mk, sk);
    }
    mq = sqrtf(wave_max(mq)) * 1.001f; mk = sqrtf(wave_max(mk)) * 1.001f;
    if (lane == 0) { unsigned* w = F.ctl + CW_QKN + 64 * l + bh * 2; atomicMax(w, __float_as_uint(mq)); atomicMax(w + 1, __float_as_uint(mk)); }
}
__device__ __forceinline__ void hg_scan(Frame& F) {
    const bf16* hst = (const bf16*)(F.ws + WS_HST); bf16* hst2 = (bf16*)(F.ws + WS_HST2); const float* hdec = (const float*)(F.ws + WS_HDEC);
    const int gt = F.vcu * NTHR + F.tid, NGT = F.G * NTHR;
    for (int e = gt; e < 32 * 8192; e += NGT) {
        const int bh = e >> 13, kv = e & 8191, k = kv >> 6;
        float carry = 0.f;
        const bf16* p = hst + (size_t)bh * 64 * 8192 + kv; bf16* q = hst2 + (size_t)bh * 64 * 8192 + kv; const float* d = hdec + (size_t)bh * 64 * 128 + k;
#pragma unroll 16
        for (int c = 0; c < 64; ++c) { const float t = bf2f(p[(size_t)c * 8192]); q[(size_t)c * 8192] = (bf16)f2bf(carry); carry = d[c * 128] * carry + t; }
    }
}
__device__ __forceinline__ void s5_scan(Frame& F, const Args& a, int l) {
    const int gt = F.vcu * NTHR + F.tid;
    if (gt >= 8 * 16 * 64 * 8) return;
    const int lane = F.lane, seg = lane >> 3, gwv = gt >> 6, n = (gwv & 7) * 8 + (lane & 7), g = (gwv >> 3) & 15, b = gwv >> 7, pair = g >> 1, gs = g & 1;
    S5P P{(const float*)karg(17) + l * 1024, (const float*)karg(18) + l * 1024, (const float*)karg(19) + l * 16, nullptr, nullptr, nullptr, nullptr, nullptr};
    float ar, ai, br, bi; s5_pow(P, g, n, 32.0f, ar, ai); s5_pow(P, g, n, 512.0f, br, bi);
    const float* xl = (const float*)(F.ws + WS_XLOC) + ((size_t)b * 128 + seg * 16) * 2048 + pair * 256 + gs * 128 + 2 * n;
    bf16* xi = (bf16*)(F.ws + WS_XIN) + ((size_t)b * 128 + seg * 16) * 2048 + pair * 256 + gs * 128 + 2 * n;
    float lr[16], li[16]; float xr = 0.f, xim = 0.f;
#pragma unroll
    for (int j = 0; j < 16; ++j) { const f32x2 v = *(const f32x2*)(xl + (size_t)j * 2048); lr[j] = xr; li[j] = xim;
        const float nr = ar * xr - ai * xim + v[0], ni = ar * xim + ai * xr + v[1]; xr = nr; xim = ni; }
    float cr = 0.f, ci = 0.f;
#pragma unroll
    for (int sg = 1; sg < 8; ++sg) { const float tr = __shfl_up(xr, 8), ti = __shfl_up(xim, 8), pr_ = __shfl_up(cr, 8), pi_ = __shfl_up(ci, 8);
        if (seg == sg) { cr = br * pr_ - bi * pi_ + tr; ci = br * pi_ + bi * pr_ + ti; } }
    float pr = 1.f, pi = 0.f;
#pragma unroll
    for (int j = 0; j < 16; ++j) { *(unsigned*)(xi + (size_t)j * 2048) = pk2(lr[j] + pr * cr - pi * ci, li[j] + pr * ci + pi * cr);
        const float qr = pr * ar - pi * ai, qi = pr * ai + pi * ar; pr = qr; pi = qi; }
}
constexpr int RWB = 1032;
constexpr int RW_WC = 138496;
constexpr int RW_TOP = 2 * 32 * RWB * 2, RW_CV = RW_TOP + 4096;
constexpr int LDS_LG = LDS_STASH;
__device__ __forceinline__ void p8_post_router(Frame& F, const Args& a, int l, const float* xsrc, bool dummy) {
    const bf16* x2src = (const bf16*)(F.ws + WS_X2);
#define P8_LOADX(row_) ((l == 0) ? load_vec(xsrc + (size_t)(row_) * DM, lane) : load_vec_bf16(x2src + (size_t)(row_) * DM, lane))
    const int lane = F.lane, tid = F.tid;
    const int gw = F.vcu * NWAVES + F.wave; const int row0 = gw * 16, b = row0 / SEQ;
    const float* mod = (const float*)(F.ws + WS_MOD) + ((size_t)l * 8 + b) * 6144;
    const float* pre_g = (const float*)karg(5) + (size_t)(l * 2 + 1) * DM;
    LAS bf16* WTh = (LAS bf16*)F.lds; LAS bf16* WTl = WTh + 32 * RWB;
    LAS float* CV = (LAS float*)(F.lds + RW_CV);
    const bf16* Y2 = (const bf16*)(F.ws + WS_Y2);
    RowVec xn = P8_LOADX(row0); u32x2 yn[4];
    { const u32x2* yp = (const u32x2*)(Y2 + (size_t)row0 * DM) + lane;
#pragma unroll
      for (int j = 0; j < 4; ++j) yn[j] = __builtin_nontemporal_load(yp + 64 * j); }
    { const float* rw = (const float*)karg(26) + (size_t)l * DM * NEXP;
      for (int idx = tid; idx < 8192; idx += NTHR) { const int k = idx >> 3, eq = idx & 7; const f32x4 w = *(const f32x4*)(rw + (size_t)k * NEXP + 4 * eq); const float g = pre_g[k] * (mod[4096 + k] + 1.0f);
#pragma unroll
          for (int c4 = 0; c4 < 4; ++c4) { const float v = w[c4] * g; const unsigned hb = f2bf(v); const float lo = v - bf2f((bf16)hb); WTh[(4 * eq + c4) * RWB + k] = (bf16)hb; WTl[(4 * eq + c4) * RWB + k] = (bf16)f2bf(lo); } }
      { const int e = tid & 31, part = tid >> 5; float sacc = 0.f;
#pragma unroll 8
        for (int k = part * 64; k < part * 64 + 64; ++k) sacc += mod[3072 + k] * rw[(size_t)k * NEXP + e];
        CV[32 + part * 32 + e] = sacc; }
      if (tid < 32) ((LAS unsigned*)(F.lds + RW_WC))[tid] = 0u;
      __syncthreads();
      if (tid < 32) { float sacc = ((const float*)karg(27))[l * NEXP + tid];
#pragma unroll
          for (int p = 0; p < 16; ++p) sacc += CV[32 + p * 32 + tid];
          CV[tid] = sacc; } }
    __syncthreads();
    RowVec pg;
    { const RowVec pgv = load_vec((const float*)karg(6) + (size_t)(l * 2 + 0) * DM, lane), g1 = load_vec(mod + 2048, lane);
#pragma unroll
      for (int j = 0; j < 4; ++j) pg.v[j] = pgv.v[j] * g1.v[j]; }
    unsigned char* H8 = F.ws + WS_H8; bf16* xbuf = (bf16*)(F.ws + WS_X1);
    RowVec gm2, sh2s;
    { const RowVec pre = load_vec(pre_g, lane), sc2 = load_vec(mod + 4096, lane), sh2 = load_vec(mod + 3072, lane);
#pragma unroll
      for (int j = 0; j < 4; ++j) { gm2.v[j] = pre.v[j] * (sc2.v[j] + 1.0f) * F8_SH; sh2s.v[j] = sh2.v[j] * F8_SH; } }
    float rs2mine = 0.f;
#pragma unroll 1
    for (int rr = 0; rr < 16; ++rr) {
        const int row = row0 + rr;
        RowVec x = xn, y;
#pragma unroll
        for (int j = 0; j < 4; ++j) y.v[j] = (f32x4){bflo(yn[j].x), bfhi(yn[j].x), bflo(yn[j].y), bfhi(yn[j].y)};
        if (rr < 15) { xn = P8_LOADX(row + 1); const u32x2* yp = (const u32x2*)(Y2 + (size_t)(row + 1) * DM) + lane;
#pragma unroll
            for (int j = 0; j < 4; ++j) yn[j] = __builtin_nontemporal_load(yp + 64 * j); }
        const float rs = rsqrtf(sumsq(y) * (1.0f / DM) + EPS);
#pragma unroll
        for (int j = 0; j < 4; ++j) x.v[j] += y.v[j] * rs * pg.v[j];
        store_bf16_row(xbuf + (size_t)row * DM, x, lane);
        const float rs2 = rsqrtf(sumsq(x) * (1.0f / DM) + EPS);
        if (lane == rr) rs2mine = rs2;
        { unsigned* q = (unsigned*)(H8 + (size_t)row * DM) + lane;
#pragma unroll
          for (int j = 0; j < 4; ++j) { const f32x4 hv = x.v[j] * rs2 * gm2.v[j] + sh2s.v[j]; q[64 * j] = pk4_fp8(hv[0], hv[1], hv[2], hv[3]); } }
    }
    asm volatile("s_waitcnt vmcnt(0)" ::: "memory");
    f32x4 acc0 = (f32x4){0.f, 0.f, 0.f, 0.f}, acc1 = acc0;
    { const int i = lane & 15, kk = lane >> 4;
      const bf16* xa = xbuf + (size_t)(row0 + i) * DM + 8 * kk; const LAS bf16* wh = WTh + i * RWB + 8 * kk; const LAS bf16* wl = WTl + i * RWB + 8 * kk;
#pragma unroll 16
      for (int k0 = 0; k0 < DM; k0 += 32) { const bf16x8 av = *(const bf16x8*)(xa + k0);
          acc0 = __builtin_amdgcn_mfma_f32_16x16x32_bf16(av, *(const LAS bf16x8*)(wh + k0), acc0, 0, 0, 0); acc0 = __builtin_amdgcn_mfma_f32_16x16x32_bf16(av, *(const LAS bf16x8*)(wl + k0), acc0, 0, 0, 0);
          acc1 = __builtin_amdgcn_mfma_f32_16x16x32_bf16(av, *(const LAS bf16x8*)(wh + 16 * RWB + k0), acc1, 0, 0, 0); acc1 = __builtin_amdgcn_mfma_f32_16x16x32_bf16(av, *(const LAS bf16x8*)(wl + 16 * RWB + k0), acc1, 0, 0, 0); }
      LAS float* LG = (LAS float*)(F.lds + LDS_LG) + F.wave * (16 * 33);
#pragma unroll
      for (int r = 0; r < 4; ++r) { const int rowi = 4 * kk + r; const float sc = __shfl(rs2mine, rowi); LG[rowi * 33 + i] = acc0[r] * sc + CV[i]; LG[rowi * 33 + 16 + i] = acc1[r] * sc + CV[16 + i]; } }
    LDS_WAIT(); asm volatile("" ::: "memory");
    LAS unsigned* TOP = (LAS unsigned*)(F.lds + RW_TOP) + F.wave * 128;
    if (lane < 16) {
        const LAS float* LG = (const LAS float*)(F.lds + LDS_LG) + F.wave * (16 * 33) + lane * 33;
        float lg[32];
#pragma unroll
        for (int e = 0; e < 32; ++e) lg[e] = LG[e];
        unsigned used = 0u; float tv[4]; int te[4];
#pragma unroll
        for (int k = 0; k < 4; ++k) { float best = -INFINITY; int bi = 0;
#pragma unroll
            for (int e = 0; e < 32; ++e) { const bool ok = ((used >> e) & 1u) == 0u && lg[e] > best; best = ok ? lg[e] : best; bi = ok ? e : bi; }
            used |= 1u << bi; tv[k] = best; te[k] = bi; }
        float ws[4]; float sum = 0.f;
#pragma unroll
        for (int k = 0; k < 4; ++k) { ws[k] = __expf(tv[k] - tv[0]); sum += ws[k]; }
        const float inv = 1.0f / sum;
#pragma unroll
        for (int k = 0; k < 4; ++k) { TOP[4 * lane + k] = (unsigned)te[k]; TOP[64 + 4 * lane + k] = __float_as_uint(ws[k] * inv); }
    }
    LDS_WAIT(); asm volatile("" ::: "memory");
    const int myE = (int)TOP[lane]; const float myW = __uint_as_float(TOP[64 + lane]);
    unsigned long long mymask = 0ull, remaining = ~0ull;
#pragma unroll 1
    while (remaining) { const int src = __ffsll((long long)remaining) - 1; const int e0 = __builtin_amdgcn_readlane(myE, src); const unsigned long long m = __ballot(myE == e0); if (myE == e0) mymask = m; remaining &= ~m; }
    const int leader = __ffsll((long long)mymask) - 1, cntg = __popcll(mymask), rank = __popcll(mymask & ((1ull << lane) - 1ull));
    unsigned* cnt = F.ctl + (dummy ? CW_CNT_DUMMY : CW_CNT) + 64 * l;
    LAS unsigned* WC = (LAS unsigned*)(F.lds + RW_WC);
    int base = 0;
    if (lane == leader) base = (int)__hip_atomic_fetch_add(WC + myE, (unsigned)cntg, __ATOMIC_RELAXED, __HIP_MEMORY_SCOPE_WORKGROUP);
    __syncthreads();
    if (tid < 32) { const unsigned c = WC[tid]; unsigned gb = 0u; if (c) gb = __hip_atomic_fetch_add(cnt + tid, c, __ATOMIC_RELAXED, __HIP_MEMORY_SCOPE_AGENT); WC[32 + tid] = gb; }
    __syncthreads();
    base = __shfl(base, leader) + (int)WC[32 + myE];
    const int pos = base + rank, tokk = (row0 + (lane >> 2)) * 4 + (lane & 3);
    unsigned char* lw = F.ws + (dummy ? WS_ACT : 0);
    ((int*)(lw + WS_LISTS))[(size_t)myE * NT + pos] = tokk;
    ((float*)(lw + WS_WSLOT))[(size_t)myE * NT + pos] = myW;
    ((int*)(lw + WS_TOKPOS))[tokk] = myE * NT + pos;
    __syncthreads();
#undef P8_LOADX
}
__device__ __forceinline__ void p11_combine(Frame& F, const Args& a, int l) {
    const int lane = F.lane;
    const int gw = F.vcu * NWAVES + F.wave; const int row0 = gw * 16, b = row0 / SEQ;
    const float* mod = (const float*)(F.ws + WS_MOD) + ((size_t)l * 8 + b) * 6144;
    RowVec pg;
    { const RowVec pgv = load_vec((const float*)karg(6) + (size_t)(l * 2 + 1) * DM, lane), g2 = load_vec(mod + 5120, lane);
#pragma unroll
      for (int j = 0; j < 4; ++j) pg.v[j] = pgv.v[j] * g2.v[j]; }
    const unsigned* cnt = F.ctl + CW_CNT + 64 * l;
    int mybase; { const int c = (lane < 32) ? (int)cnt[lane] : 0; int ps = c;
#pragma unroll
        for (int o = 1; o < 32; o <<= 1) { const int t = __shfl_up(ps, o); if (lane >= o) ps += t; }
        mybase = ps - c; }
    const int* tokpos = (const int*)(F.ws + WS_TOKPOS); const unsigned char* YK = F.ws + WS_YK; const bf16* x1buf = (const bf16*)(F.ws + WS_X1); float* xbuf = (float*)karg(32); bf16* x2buf = (bf16*)(F.ws + WS_X2);
    Norm1Ctx cx; const bool nextl = (l + 1 < DEPTH);
    if (nextl) norm1_setup(cx, a, (const float*)(F.ws + WS_MOD), l + 1, b, lane);
    unsigned char* H = F.ws + WS_H8; float* logf = (float*)(F.ws + WS_LOGF);
    int myslot; { const int tp = tokpos[row0 * 4 + lane]; myslot = __shfl(mybase, tp >> 15) + (tp & 32767); }
    unsigned yn[4][4]; u32x2 xq[4];
#define P11_ISSUE(r_) do { _Pragma("unroll") for (int k = 0; k < 4; ++k) { const int slot = __shfl(myslot, 4 * (r_) + k); const unsigned* yp = (const unsigned*)(YK + (size_t)slot * DM) + lane; \
        _Pragma("unroll") for (int j = 0; j < 4; ++j) yn[k][j] = __builtin_nontemporal_load(yp + 64 * j); } { const u32x2* xp = (const u32x2*)(x1buf + (size_t)(row0 + (r_)) * DM) + lane; _Pragma("unroll") for (int j = 0; j < 4; ++j) xq[j] = __builtin_nontemporal_load(xp + 64 * j); } } while (0)
    P11_ISSUE(0);
#pragma unroll 1
    for (int r = 0; r < 16; ++r) {
        const int row = row0 + r;
        RowVec y, x;
#pragma unroll
        for (int j = 0; j < 4; ++j) { y.v[j] = (f32x4){0.f, 0.f, 0.f, 0.f}; x.v[j] = (f32x4){bflo(xq[j].x), bfhi(xq[j].x), bflo(xq[j].y), bfhi(xq[j].y)};
#pragma unroll
            for (int k = 0; k < 4; ++k) { const int w = (int)yn[k][j]; y.v[j] += (f32x4){__builtin_amdgcn_cvt_f32_fp8(w, 0), __builtin_amdgcn_cvt_f32_fp8(w, 1), __builtin_amdgcn_cvt_f32_fp8(w, 2), __builtin_amdgcn_cvt_f32_fp8(w, 3)}; } }
        if (r < 15) P11_ISSUE(r + 1);
        const float rs = rsqrtf(sumsq(y) * (1.0f / DM) + EPS);
#pragma unroll
        for (int j = 0; j < 4; ++j) x.v[j] += y.v[j] * rs * pg.v[j];
        if (nextl) store_bf16_row(x2buf + (size_t)row * DM, x, lane);
        else { f32x4* xo = (f32x4*)(xbuf + (size_t)row * DM) + lane;
#pragma unroll
          for (int j = 0; j < 4; ++j) xo[64 * j] = x.v[j]; }
        if (nextl) norm1_row(cx, x, H + (size_t)row * DM, logf + (size_t)row * 4, lane);
    }
#undef P11_ISSUE
}

constexpr int NPH = 22;
#ifndef PH_MASK
#define PH_MASK 0xFFF
#endif
#define PHON(id) ((((PH_MASK) >> (id)) & 1) && (BODY < 0 || BODY == (id)))
#ifndef SUB_MASK
#define SUB_MASK 0xFF
#endif
#define SUBON(id) (((SUB_MASK) >> (id)) & 1)
#ifndef DUP_MASK
#define DUP_MASK 0
#endif
#ifndef XMODE
#define XMODE 0
#endif
#define DUPN(id) ((((DUP_MASK) >> (id)) & 1) ? 2 : 1)
#define REP(id) for (int rep_ = 0; rep_ < DUPN(id); ++rep_)
#define REPBAR(id) do { if (DUPN(id) == 2 && rep_ == 0) GRID_BAR(); } while (0)
#define IN(k) (lo <= (k) && (k) < hi)
#if MK_ONE_LAUNCH
#define GRID_BAR() do { XcdBarrier b2_ = bar; asm volatile("" : "+s"(b2_.bar)); xcd_barrier(b2_); } while (0)
#else
#define GRID_BAR() do { } while (0)
#endif
#define SEAM(k) do { if (IN(k) && IN((k) + 1)) GRID_BAR(); } while (0)
#define x_in ((const float*)karg(0))
#define PROJ ((bf16*)(F.ws + WS_PROJ))
#define H ((bf16*)(F.ws + WS_H))
#define YCAT ((bf16*)(F.ws + WS_YCAT))
template <int BODY, int l>
__device__ __forceinline__ void layer_phases(Frame& F, const Args& args, const int lo, const int hi, const XcdBarrier& bar) {
        constexpr int pb = 2 + 10 * l;

        if (PHON(2) && IN(pb + 0)) REP(2) {
            REFRESH();
            ProjProb P; P.A = F.ws + WS_H8; P.Bt = F.ws + WS_WIN + (size_t)l * NPROJ * DM; P.O = PROJ; P.pos = (const int*)karg(2); P.G = F.G; P.c = F.vcu;
            gk::run<ProjProb, true>(F.lds, P, (DUPN(2) == 2 && rep_ == 0) ? XMODE : 0);
        REPBAR(2); } SEAM(pb + 0);
        if (PHON(3) && IN(pb + 1)) REP(3) {
            REFRESH();
            { const int gw = F.vcu * NWAVES + F.wave; if (gw >= 1024 && gw < 1024 + 32) fox_cumsum(F, gw - 1024); if (gw < 512) fox_norms(F, gw, l); }
            REFRESH();
            REFRESH();
            if (SUBON(1)) { S5EProb P; P.proj = PROJ; P.Ebt = (const bf16*)(F.ws + WS_S5E) + (size_t)l * 8 * 256 * 1024; P.xloc = (float*)(F.ws + WS_XLOC); P.G = F.G; P.c = F.G - 1 - F.vcu; gk::run(F.lds, P); }
            REFRESH();
            if (SUBON(0)) hg::h1_phase(F, l, PROJ, (const float*)karg(10), (bf16*)(F.ws + WS_HST), (float*)(F.ws + WS_HDEC), F.ctl + CW_HGQ + 8 * (2 * l + 0) + 4 * rep_);
        REPBAR(3); } SEAM(pb + 1);
        if (PHON(4) && IN(pb + 2)) REP(4) { REFRESH(); s5_scan(F, args, l); REFRESH(); hg_scan(F); REPBAR(4); } SEAM(pb + 2);
        if (PHON(5) && IN(pb + 3)) REP(5) {
            REFRESH();
            if (SUBON(1)) { S5FMProb P; P.proj = PROJ; P.xin = (const bf16*)(F.ws + WS_XIN); P.Fbt = (const bf16*)(F.ws + WS_S5F) + (size_t)l * 8 * 1024 * 256; P.Mbt = (const bf16*)(F.ws + WS_S5M) + (size_t)l * 8 * 1024 * 1024;
              P.ygelu = (bf16*)(F.ws + WS_YGELU); P.G = F.G; P.c = F.vcu; gk::run(F.lds, P); }
            REFRESH();
            if (SUBON(0)) hg::h3_phase(F, l, PROJ, (const float*)karg(10), (const bf16*)(F.ws + WS_HST2), (const float*)karg(11) + l * 64, YCAT, F.ctl + CW_HGQ + 8 * (2 * l + 1) + 4 * rep_);
        REPBAR(5); } SEAM(pb + 3);
        if (PHON(6) && IN(pb + 4)) REP(6) {
            REFRESH();
            if (SUBON(1)) { GluProb P; P.A = (const bf16*)(F.ws + WS_YGELU); P.Bt = (const bf16*)(F.ws + WS_GLU) + (size_t)l * 512 * 256; P.pitchA = 256; P.pitchB = 256; P.O = YCAT; P.G = F.G; P.c = F.vcu; gk::run(F.lds, P); }
            REFRESH();
            const float lam_init = 0.8f - 0.6f * expf(-0.3f * (float)l);
            float lam;
            { const float* q1 = (const float*)karg(12) + l * 32; const float* k1 = (const float*)karg(13) + l * 32; const float* q2 = (const float*)karg(14) + l * 32; const float* k2 = (const float*)karg(15) + l * 32;
              float s1 = 0.f, s2 = 0.f; for (int i = 0; i < 32; ++i) { s1 += q1[i] * k1[i]; s2 += q2[i] * k2[i]; } lam = expf(s1) - expf(s2) + lam_init; }
            const float* fbias = (const float*)(F.ws + WS_FBIAS); const float* subln = (const float*)karg(16) + l * 64; bf16* proj_ = PROJ; bf16* ycat_ = YCAT; const unsigned* qkn_ = F.ctl + CW_QKN + 64 * l;
            for (int v = F.vcu; v < 256; v += F.G) {
                const int bh = v >> 3, s = v & 7, b = bh >> 2, h = bh & 3;
                if (SUBON(2)) att::unit<1>(b, h, 15 - s, proj_, fbias, qkn_, ycat_, lam, lam_init, subln, (LAS char*)F.lds);
                if (SUBON(0)) att::unit<0>(b, h, 15 - s, proj_, fbias, qkn_, ycat_, lam, lam_init, subln, (LAS char*)F.lds);
                if (SUBON(2)) att::unit<1>(b, h, s, proj_, fbias, qkn_, ycat_, lam, lam_init, subln, (LAS char*)F.lds);
                if (SUBON(0)) att::unit<0>(b, h, s, proj_, fbias, qkn_, ycat_, lam, lam_init, subln, (LAS char*)F.lds);
            }
        REPBAR(6); } SEAM(pb + 4);
        if (PHON(7) && IN(pb + 5)) REP(7) {
            REFRESH();
            PlainProb P; P.A = YCAT; P.Bt = (const bf16*)(F.ws + WS_WOUT) + (size_t)l * DM * DM; P.pitchA = DM; P.pitchB = DM; P.O = (bf16*)(F.ws + WS_Y2); P.ldc = DM; P.nM = NT / 256; P.nN = 4; P.G = F.G; P.c = F.vcu;
            gk::run(F.lds, P);
        REPBAR(7); } SEAM(pb + 5);
        if (PHON(8) && IN(pb + 6)) REP(8) { REFRESH(); p8_post_router(F, args, l, l == 0 ? x_in : (const float*)karg(32), DUPN(8) == 2 && rep_ == 0); REPBAR(8); } SEAM(pb + 6);
        if (PHON(9) && IN(pb + 7)) REP(9) {
            REFRESH();
            moe_tables(F, F.ctl + CW_CNT + 64 * l);
            Moe1Prob P; P.h8 = (const unsigned char*)(F.ws + WS_H8); P.w1t = (const unsigned char*)(F.ws + WS_W1T) + (size_t)l * 32 * 2048 * 1024; P.b1 = (const float*)karg(29) + (size_t)l * 32 * 2048; P.lists = (const int*)(F.ws + WS_LISTS);
            P.act = (unsigned char*)(F.ws + WS_ACT); P.CTL = F.CTL; P.lds = F.lds; P.G = F.G; P.c = F.vcu; gk::run<Moe1Prob, true>(F.lds, P, (DUPN(9) == 2 && rep_ == 0) ? XMODE : 0);
        REPBAR(9); } SEAM(pb + 7);
        if (PHON(10) && IN(pb + 8)) REP(10) {
            REFRESH();
            if (!(PHON(9) && IN(pb + 7))) moe_tables(F, F.ctl + CW_CNT + 64 * l);
            Moe2Prob P; P.act = (const unsigned char*)(F.ws + WS_ACT); P.w2t = (const unsigned char*)(F.ws + WS_W2T) + (size_t)l * 32 * 1024 * 1024; P.b2 = (const float*)karg(31) + (size_t)l * 32 * 1024; P.wslot = (const float*)(F.ws + WS_WSLOT);
            P.yk = F.ws + WS_YK; P.CTL = F.CTL; P.lds = F.lds; P.G = F.G; P.c = F.vcu; gk::run<Moe2Prob, true>(F.lds, P, (DUPN(10) == 2 && rep_ == 0) ? XMODE : 0);
        REPBAR(10); } SEAM(pb + 8);
        if (PHON(11) && IN(pb + 9)) REP(11) { REFRESH(); p11_combine(F, args, l); REPBAR(11); } SEAM(pb + 9);
    }
template <int BODY>
__global__ void __launch_bounds__(NTHR, 2) mk_fwd(Args args) {
    extern __shared__ __attribute__((aligned(16))) unsigned char lds_raw[];
    Frame F;
    F.lds = (LAS unsigned char*)lds_raw; F.CTL = (volatile LAS unsigned*)(F.lds + LDSCTL_OFF);
    F.G = gridDim.x; { const int bx = blockIdx.x; F.vcu = (F.G % 8 == 0) ? (bx % 8) * (F.G / 8) + bx / 8 : bx; }
    REFRESH();
    for (int u = F.tid; u < (LDS_BYTES - LDSCTL_OFF) / 4; u += NTHR) ((LAS unsigned*)(F.lds + LDSCTL_OFF))[u] = 0u;
    __syncthreads();
    XcdBarrier bar; bar.bar = F.ctl + CW_BAR; bar.x = 0; bar.st = F.CTL;
#if MK_ONE_LAUNCH
    bar = xcd_barrier_post(F.ctl + CW_BAR, F.CTL);
#endif
    const int lo = args.ph_lo, hi = args.ph_hi;
    if (PHON(0) && IN(0)) REP(0) { REFRESH(); p0_prologue(F, args); REPBAR(0); } SEAM(0);
    if (PHON(1) && IN(1)) REP(1) { REFRESH(); p1_norm1(F, args, 0, x_in); REFRESH(); s5_fill_m(F); REPBAR(1); } SEAM(1);
    layer_phases<BODY, 0>(F, args, lo, hi, bar);
    layer_phases<BODY, 1>(F, args, lo, hi, bar);
}
#undef IN
#undef SEAM
#undef x_in
#undef PROJ
#undef H
#undef YCAT

extern "C" void kernel_launch(void* const* d_in, const int* in_sizes, int n_in, void* d_out, int out_size, void* d_ws, size_t ws_size, hipStream_t stream) {
    static int grid = 0;
    if (grid == 0) {
        if (n_in != 32 || out_size != NT * DM || ws_size < WS_END) { fprintf(stderr, "kernel_launch: unexpected problem (n_in %d, out %d, ws %zu)\n", n_in, out_size, ws_size); grid = -1; return; }
        int dev = 0, cus = 0, per_cu = 0;
        if (hipGetDevice(&dev) != hipSuccess || hipDeviceGetAttribute(&cus, hipDeviceAttributeMultiprocessorCount, dev) != hipSuccess) { grid = -1; return; }
#if MK_ONE_LAUNCH
        const void* kfn[1] = {(const void*)mk_fwd<-1>};
#else
        const void* kfn[12] = {(const void*)mk_fwd<0>, (const void*)mk_fwd<1>, (const void*)mk_fwd<2>, (const void*)mk_fwd<3>, (const void*)mk_fwd<4>, (const void*)mk_fwd<5>, (const void*)mk_fwd<6>, (const void*)mk_fwd<7>,
                               (const void*)mk_fwd<8>, (const void*)mk_fwd<9>, (const void*)mk_fwd<10>, (const void*)mk_fwd<11>};
#endif
        for (const void* f : kfn) if (hipFuncSetAttribute(f, hipFuncAttributeMaxDynamicSharedMemorySize, LDS_BYTES) != hipSuccess) { fprintf(stderr, "kernel_launch: hipFuncSetAttribute failed\n"); grid = -1; return; }
        if (hipOccupancyMaxActiveBlocksPerMultiprocessor(&per_cu, kfn[0], NTHR, LDS_BYTES) != hipSuccess || per_cu < 1) fprintf(stderr, "kernel_launch: occupancy query says %d\n", per_cu);
        (void)hipGetLastError();
        grid = cus;
    }
    if (grid < 0) return;
    (void)hipMemsetAsync((char*)d_ws + WS_CTL, 0, CTL_BYTES, stream);
    Args a{};
    for (int i = 0; i < 32; ++i) a.in[i] = d_in[i];
    a.out = (float*)d_out; a.ws = (unsigned char*)d_ws;
#if MK_ONE_LAUNCH
    a.ph_lo = 0; a.ph_hi = NPH;
    hipLaunchKernelGGL(mk_fwd<-1>, dim3(grid), dim3(NTHR), LDS_BYTES, stream, a);
#else
    for (int p = 0; p < NPH; ++p) {
        a.ph_lo = p; a.ph_hi = p + 1;
        const int body = p < 2 ? p : 2 + (p - 2) % 10;
        switch (body) {
#define MK_CASE(n) case n: hipLaunchKernelGGL(mk_fwd<n>, dim3(grid), dim3(NTHR), LDS_BYTES, stream, a); break;
            MK_CASE(0) MK_CASE(1) MK_CASE(2) MK_CASE(3) MK_CASE(4) MK_CASE(5) MK_CASE(6) MK_CASE(7) MK_CASE(8) MK_CASE(9) MK_CASE(10) MK_CASE(11)
#undef MK_CASE
        }
    }
#endif
}
```
